# Optimizing an MI355X kernel written in HIP

```python
import math
import jax, jax.numpy as jnp
from jax import lax
import numpy as np

D_MODEL = 1024
BATCH = 16
SEQ = 4096
DEPTH = 4

N_MEM = 256
A_HEADS = 4
A_QK_DIM = 64
A_V_DIM = 2 * A_QK_DIM
A_QK_COLS = A_HEADS * 2 * A_QK_DIM
A_WIDTH = A_HEADS * A_V_DIM
POOL_WINDOWS = (2, 4, 8, 16)
POOL_GROUPS = len(POOL_WINDOWS)
POOL_GROUP_DIM = (D_MODEL // 2) // POOL_GROUPS
POOL_WIDTH = POOL_GROUPS * POOL_GROUP_DIM
EVEN_IN = 2 * A_QK_COLS + A_WIDTH + POOL_WIDTH
EVEN_MIX = A_WIDTH + POOL_WIDTH
CONV_WIDTH = 3
CONV_DIM = D_MODEL
X_HEADS = 4
X_HEAD_DIM = D_MODEL // X_HEADS
D_FF = 4 * D_MODEL
REL_BUCKETS = 32
REL_MAX_EXACT = REL_BUCKETS // 2
REL_MAX_DIST = 128
Q_BLOCK = 128
N_EVEN = (DEPTH + 1) // 2
N_ODD = DEPTH // 2
EPS = 1e-6

kernel_name = "hybrid_diffattn_pool_shortconv_trunk"


def rms_norm(x, g):
    xf = x.astype(jnp.float32)
    y = xf * lax.rsqrt(jnp.mean(xf * xf, axis=-1, keepdims=True) + EPS)
    return (y * g.astype(jnp.float32)).astype(x.dtype)


def t5_bucket(n):
    small = n < REL_MAX_EXACT
    nf = jnp.maximum(n, 1).astype(jnp.float32)
    large = REL_MAX_EXACT + (jnp.log(nf / REL_MAX_EXACT)
                             / math.log(REL_MAX_DIST / REL_MAX_EXACT)
                             * (REL_BUCKETS - REL_MAX_EXACT)).astype(jnp.int32)
    large = jnp.minimum(large, REL_BUCKETS - 1)
    return jnp.where(small, n, large)


def diff_attention(q1, q2, k1, k2, v, lam, bias_dist):
    B, S = q1.shape[0], q1.shape[1]
    nb = S // Q_BLOCK
    scale = A_QK_DIM ** -0.5
    qb1 = q1.reshape(B, nb, Q_BLOCK, A_HEADS, A_QK_DIM).transpose(1, 0, 2, 3, 4)
    qb2 = q2.reshape(B, nb, Q_BLOCK, A_HEADS, A_QK_DIM).transpose(1, 0, 2, 3, 4)
    starts = jnp.arange(nb, dtype=jnp.int32) * Q_BLOCK
    kpos = jnp.arange(S, dtype=jnp.int32)

    def block(args):
        qa, qc, start = args
        qpos = start + jnp.arange(Q_BLOCK, dtype=jnp.int32)
        dist = qpos[:, None] - kpos[None, :]
        causal = dist >= 0
        bias = bias_dist[:, jnp.clip(dist, 0, S - 1)]

        def probs(q, k):
            s = jnp.einsum('bqhd,bkhd->bhqk', q, k).astype(jnp.float32) * scale + bias
            s = jnp.where(causal, s, -jnp.inf)
            return jax.nn.softmax(s, axis=-1)

        a = probs(qa, k1) - lam * probs(qc, k2)
        return jnp.einsum('bhqk,bkhd->bqhd', a.astype(v.dtype), v)

    out = lax.map(block, (qb1, qb2, starts))
    return out.transpose(1, 0, 2, 3, 4).reshape(B, S, A_HEADS, A_V_DIM)


def multi_scale_pool(u, pool_w, pool_scale):
    B, S = u.shape[0], u.shape[1]
    ug = u.reshape(B, S, POOL_GROUPS, POOL_GROUP_DIM).astype(jnp.float32)
    c = jnp.concatenate([jnp.zeros((B, 1, POOL_GROUPS, POOL_GROUP_DIM), jnp.float32),
                         jnp.cumsum(ug, axis=1)], axis=1)
    t = jnp.arange(S, dtype=jnp.int32)
    pooled = []
    for gi, w in enumerate(POOL_WINDOWS):
        cg = c[:, :, gi]
        cp = jnp.concatenate([jnp.zeros((B, w - 1, POOL_GROUP_DIM), jnp.float32), cg], axis=1)
        win_sum = cg[:, 1:] - cp[:, :S]
        count = jnp.minimum(t + 1, w).astype(jnp.float32)[None, :, None]
        pooled.append(win_sum / count - ug[:, :, gi])
    p = jnp.stack(pooled, axis=2).astype(u.dtype)
    y = jnp.einsum('bsgc,gcd->bsgd', p, pool_w) * pool_scale.reshape(POOL_GROUPS, POOL_GROUP_DIM)
    return y.reshape(B, S, POOL_WIDTH)


def even_mixer(h, w_in, w_out, lq1, lk1, lq2, lk2, subln_g, pool_w, pool_scale,
               bias_dist, lambda_init):
    B, S = h.shape[0], h.shape[1]
    proj = h @ w_in
    q = proj[..., :A_QK_COLS].reshape(B, S, A_HEADS, 2, A_QK_DIM)
    k = proj[..., A_QK_COLS:2 * A_QK_COLS].reshape(B, S, A_HEADS, 2, A_QK_DIM)
    v = proj[..., 2 * A_QK_COLS:2 * A_QK_COLS + A_WIDTH].reshape(B, S, A_HEADS, A_V_DIM)
    u = proj[..., 2 * A_QK_COLS + A_WIDTH:]
    lam = (jnp.exp(jnp.sum(lq1.astype(jnp.float32) * lk1.astype(jnp.float32)))
           - jnp.exp(jnp.sum(lq2.astype(jnp.float32) * lk2.astype(jnp.float32)))
           + lambda_init)
    o = diff_attention(q[..., 0, :], q[..., 1, :], k[..., 0, :], k[..., 1, :], v, lam, bias_dist)
    o = (rms_norm(o, subln_g) * (1.0 - lambda_init)).reshape(B, S, A_WIDTH)
    y = multi_scale_pool(u, pool_w, pool_scale)
    return jnp.concatenate([o, y], axis=-1) @ w_out


def odd_mixer(h, w_in, conv_w, w_out):
    S = h.shape[1]
    proj = h @ w_in
    b_gate = proj[..., :CONV_DIM]
    c_gate = proj[..., CONV_DIM:2 * CONV_DIM]
    z = c_gate * proj[..., 2 * CONV_DIM:]
    zp = jnp.pad(z, ((0, 0), (CONV_WIDTH - 1, 0), (0, 0)))
    y = zp[:, 0:S] * conv_w[0]
    for tap in range(1, CONV_WIDTH):
        y = y + zp[:, tap:tap + S] * conv_w[tap]
    return (b_gate * y) @ w_out


def cross_attention(h, mem_n, wq, wkv, wo):
    B, S = h.shape[0], h.shape[1]
    M = mem_n.shape[1]
    q = (h @ wq).reshape(B, S, X_HEADS, X_HEAD_DIM)
    kv = (mem_n @ wkv).reshape(B, M, 2, X_HEADS, X_HEAD_DIM)
    s = jnp.einsum('bshd,bmhd->bhsm', q, kv[:, :, 0]).astype(jnp.float32) * X_HEAD_DIM ** -0.5
    p = jax.nn.softmax(s, axis=-1)
    o = jnp.einsum('bhsm,bmhd->bshd', p.astype(h.dtype), kv[:, :, 1]).reshape(B, S, D_MODEL)
    return o @ wo


def sq_relu_mlp(h, w1, w2):
    a = jax.nn.relu(h @ w1)
    return (a * a) @ w2


def setup_inputs(seed: int = 0) -> dict:
    key = jax.random.key(seed)
    ks = iter(jax.random.split(key, 32))
    f32 = jnp.float32

    def nrm(shape, scale):
        return jax.random.normal(next(ks), shape, f32) * scale

    def gain(shape):
        return 1.0 + nrm(shape, 0.02)

    return {
        "x": nrm((BATCH, SEQ, D_MODEL), 1.0),
        "mem": nrm((BATCH, N_MEM, D_MODEL), 1.0),
        "rel_bias": nrm((REL_BUCKETS, A_HEADS), 0.5),
        "mem_norm_g": gain((D_MODEL,)),
        "norm_mix_g": gain((DEPTH, D_MODEL)),
        "norm_xattn_g": gain((DEPTH, D_MODEL)),
        "norm_mlp_g": gain((DEPTH, D_MODEL)),
        "final_norm_g": gain((D_MODEL,)),
        "ab_w_in": nrm((N_EVEN, D_MODEL, EVEN_IN), D_MODEL ** -0.5),
        "ab_w_out": nrm((N_EVEN, EVEN_MIX, D_MODEL), EVEN_MIX ** -0.5),
        "lambda_q1": nrm((N_EVEN, A_QK_DIM), 0.1),
        "lambda_k1": nrm((N_EVEN, A_QK_DIM), 0.1),
        "lambda_q2": nrm((N_EVEN, A_QK_DIM), 0.1),
        "lambda_k2": nrm((N_EVEN, A_QK_DIM), 0.1),
        "subln_g": gain((N_EVEN, A_V_DIM)),
        "pool_w": nrm((N_EVEN, POOL_GROUPS, POOL_GROUP_DIM, POOL_GROUP_DIM), POOL_GROUP_DIM ** -0.5),
        "pool_scale": 1.0 + nrm((N_EVEN, POOL_WIDTH), 0.1),
        "conv_w_in": nrm((N_ODD, D_MODEL, 3 * CONV_DIM), D_MODEL ** -0.5),
        "conv_w": nrm((N_ODD, CONV_WIDTH, CONV_DIM), CONV_WIDTH ** -0.5),
        "conv_w_out": nrm((N_ODD, CONV_DIM, D_MODEL), CONV_DIM ** -0.5),
        "xattn_wq": nrm((DEPTH, D_MODEL, D_MODEL), D_MODEL ** -0.5),
        "xattn_wkv": nrm((DEPTH, D_MODEL, 2 * D_MODEL), D_MODEL ** -0.5),
        "xattn_wo": nrm((DEPTH, D_MODEL, D_MODEL), D_MODEL ** -0.5),
        "mlp_w1": nrm((DEPTH, D_MODEL, D_FF), D_MODEL ** -0.5),
        "mlp_w2": nrm((DEPTH, D_FF, D_MODEL), D_FF ** -0.5),
    }


def reference(x, mem, rel_bias, mem_norm_g, norm_mix_g, norm_xattn_g, norm_mlp_g,
              final_norm_g, ab_w_in, ab_w_out, lambda_q1, lambda_k1, lambda_q2,
              lambda_k2, subln_g, pool_w, pool_scale, conv_w_in, conv_w, conv_w_out,
              xattn_wq, xattn_wkv, xattn_wo, mlp_w1, mlp_w2):
    S = x.shape[1]
    buckets = t5_bucket(jnp.arange(S, dtype=jnp.int32))
    bias_dist = rel_bias.astype(jnp.float32)[buckets].T
    mem_n = rms_norm(mem, mem_norm_g)
    h = x
    for l in range(DEPTH):
        i = l // 2
        hn = rms_norm(h, norm_mix_g[l])
        if l % 2 == 0:
            lambda_init = 0.8 - 0.6 * math.exp(-0.3 * l)
            h = h + even_mixer(hn, ab_w_in[i], ab_w_out[i], lambda_q1[i], lambda_k1[i],
                               lambda_q2[i], lambda_k2[i], subln_g[i], pool_w[i],
                               pool_scale[i], bias_dist, lambda_init)
        else:
            h = h + odd_mixer(hn, conv_w_in[i], conv_w[i], conv_w_out[i])
        h = h + cross_attention(rms_norm(h, norm_xattn_g[l]), mem_n,
                                xattn_wq[l], xattn_wkv[l], xattn_wo[l])
        h = h + sq_relu_mlp(rms_norm(h, norm_mlp_g[l]), mlp_w1[l], mlp_w2[l])
    return rms_norm(h, final_norm_g)
```

```cpp
#include <hip/hip_runtime.h>
#include <hip/hip_cooperative_groups.h>
#include <hip/hip_bf16.h>
#include <cstdio>
#include <cstdint>
#include <cmath>
namespace cg = cooperative_groups;
namespace pg8 {
#define PG8_LAS __attribute__((address_space(3)))
typedef unsigned short bf16_t;
typedef short bf16x8 __attribute__((ext_vector_type(8)));
typedef float f32x4 __attribute__((ext_vector_type(4)));
typedef unsigned u32x4 __attribute__((ext_vector_type(4)));
constexpr int BM = 256, BK = 64, HALF = 128, HTB = HALF * BK * 2  , STAGE_BYTES = 8 * HTB, NXCD = 8, WGM = 8;

__host__ __device__ __forceinline__ int lds_byte(int r, int c) { const int st = (r >> 4) * 2 + (c >> 5), rr = r & 15, cc = c & 31, ob = rr * 64 + cc * 2; return st * 1024 + (ob ^ (((ob >> 9) & 1) << 5)); }
__host__ __device__ __forceinline__ void stage_rc(int b, int& R, int& C) { const int st = b / 1024, sb = b % 1024, swz = sb ^ (((sb >> 9) & 1) << 5); R = (st >> 1) * 16 + swz / 64; C = (st & 1) * 32 + (swz % 64) / 2; }
__host__ __device__ __forceinline__ int perm32(int rho) { const int n = rho >> 4, i = rho & 15; return 8 * (i >> 2) + 4 * n + (i & 3); }

struct Unit { int pm, pn; };
struct Gemm { const bf16_t* A; const bf16_t* Bt; int M, N, K; };

struct StaticOrder {
    int nM, nN, nwg, G, c;
    __host__ __device__ void init(int M, int N, int G_, int c_) { nM = M / BM; nN = N / BM; nwg = nM * nN; G = G_; c = c_; }
    __host__ __device__ bool next(int i, Unit& u) const {
        const long L = (long)i * G + c; if (L >= nwg) return false;
        int wgid = (int)L; { const int q = nwg / NXCD, r = nwg % NXCD, xcd = wgid % NXCD, off = wgid / NXCD; wgid = (xcd < r ? xcd * (q + 1) : r * (q + 1) + (xcd - r) * q) + off; }
        const int nig = WGM * nN, gid = wgid / nig, fm = gid * WGM, gsz = (nM - fm) < WGM ? (nM - fm) : WGM;
        u.pm = fm + ((wgid % nig) % gsz); u.pn = (wgid % nig) / gsz; return true;
    }
    __device__ __forceinline__ void a_ready(const Unit&) const {}
    __device__ __forceinline__ void done(const Unit&) const {}
};

__device__ __forceinline__ unsigned cvt_pk_bf16(float lo, float hi) { unsigned r; asm volatile("v_cvt_pk_bf16_f32 %0, %1, %2" : "=v"(r) : "v"(lo), "v"(hi)); return r; }
typedef float f32x2 __attribute__((ext_vector_type(2)));
__device__ __forceinline__ float row_rstd(const float* ssq, int row) {
    const f32x4* p = (const f32x4*)(ssq + (size_t)row * 16);
    const f32x4 a = p[0], b = p[1], c = p[2], d = p[3];
    const float s = (((a[0] + a[1]) + (a[2] + a[3])) + ((b[0] + b[1]) + (b[2] + b[3]))) + (((c[0] + c[1]) + (c[2] + c[3])) + ((d[0] + d[1]) + (d[2] + d[3])));
    return __builtin_amdgcn_rsqf(s * (1.0f / 1024.0f) + 1e-6f);
}
template <int ACT  , bool SCALE> struct EpiProj {
    static constexpr bool PERM = true, AFTER_DRAIN = false;
    bf16_t* O; int ldc; const float* ssq; const PG8_LAS float* rsl; int pm0;
    __device__ __forceinline__ void operator()(const f32x4 (&acc)[2][2][4][2], const Unit& u, int wr, int wc, int fr, int fq) const {
        const int row0 = u.pm * BM + wr * 64 + fr, col0 = u.pn * BM + wc * 32 + 8 * fq;
#pragma unroll
        for (int ai = 0; ai < 2; ++ai)
#pragma unroll
            for (int m = 0; m < 4; ++m) { const int row = row0 + ai * HALF + m * 16; bf16_t* rowp = O + (size_t)row * ldc + col0;
                float sc = 1.f; if (SCALE) sc = rsl ? rsl[((u.pm - pm0) >> 3) * 256 + (row & 255)] : row_rstd(ssq, row);
#pragma unroll
                for (int bj = 0; bj < 2; ++bj) { f32x4 v0 = acc[ai][bj][m][0] * sc, v1 = acc[ai][bj][m][1] * sc;
                    if (ACT == 1) {
#pragma unroll
                        for (int j = 0; j < 4; ++j) { const float a = __builtin_fmaxf(v0[j], 0.f), b = __builtin_fmaxf(v1[j], 0.f); v0[j] = a * a; v1[j] = b * b; } }
                    u32x4 w; w.x = cvt_pk_bf16(v0[0], v0[1]); w.y = cvt_pk_bf16(v0[2], v0[3]); w.z = cvt_pk_bf16(v1[0], v1[1]); w.w = cvt_pk_bf16(v1[2], v1[3]);
                    __builtin_nontemporal_store(w, (u32x4*)(rowp + bj * HALF)); } }
    }
};
struct EpiResid {
    static constexpr bool PERM = true, AFTER_DRAIN = false;
    bf16_t* hb; float* ssq;
    __device__ __forceinline__ void operator()(const f32x4 (&acc)[2][2][4][2], const Unit& u, int wr, int wc, int fr, int fq) const {
        const int row0 = u.pm * BM + wr * 64 + fr, col0 = u.pn * BM + wc * 32 + 8 * fq;
        u32x4 hv[2][4][2];
#pragma unroll
        for (int ai = 0; ai < 2; ++ai)
#pragma unroll
            for (int m = 0; m < 4; ++m)
#pragma unroll
                for (int bj = 0; bj < 2; ++bj) hv[ai][m][bj] = *(const u32x4*)(hb + (size_t)(row0 + ai * HALF + m * 16) * 1024 + col0 + bj * HALF);
#pragma unroll
        for (int ai = 0; ai < 2; ++ai)
#pragma unroll
            for (int m = 0; m < 4; ++m) { const int row = row0 + ai * HALF + m * 16; float s = 0.f;
#pragma unroll
                for (int bj = 0; bj < 2; ++bj) { const size_t off = (size_t)row * 1024 + col0 + bj * HALF;
                    const u32x4 h4 = hv[ai][m][bj];
                    const f32x4 b0 = {__uint_as_float(h4.x << 16), __uint_as_float(h4.x & 0xffff0000u), __uint_as_float(h4.y << 16), __uint_as_float(h4.y & 0xffff0000u)};
                    const f32x4 b1 = {__uint_as_float(h4.z << 16), __uint_as_float(h4.z & 0xffff0000u), __uint_as_float(h4.w << 16), __uint_as_float(h4.w & 0xffff0000u)};
                    const f32x4 v0 = acc[ai][bj][m][0] + b0, v1 = acc[ai][bj][m][1] + b1;
                    u32x4 w; w.x = cvt_pk_bf16(v0[0], v0[1]); w.y = cvt_pk_bf16(v0[2], v0[3]); w.z = cvt_pk_bf16(v1[0], v1[1]); w.w = cvt_pk_bf16(v1[2], v1[3]);
                    *(u32x4*)(hb + off) = w;
                    s += ((v0[0] * v0[0] + v0[1] * v0[1]) + (v0[2] * v0[2] + v0[3] * v0[3])) + ((v1[0] * v1[0] + v1[1] * v1[1]) + (v1[2] * v1[2] + v1[3] * v1[3])); }
                s += __shfl_xor(s, 16); s += __shfl_xor(s, 32);
                if (fq == 0) ssq[(size_t)row * 16 + u.pn * 4 + wc] = s; }
    }
};
template <class Epi, class Sched, bool ALIGN_EPI = false, bool SP2 = false>
__device__ __forceinline__ void gemm_phase(PG8_LAS unsigned char* lds, const Gemm g, const Sched& S, const Epi& E) {
    int tid_ = threadIdx.x; asm volatile("" : "+v"(tid_));
    const int tid = tid_, wid = __builtin_amdgcn_readfirstlane(tid >> 6), lane = tid & 63, wr = wid >> 2, wc = wid & 3, fr = lane & 15, fq = lane >> 4;
    const int K = g.K, nt = K / BK;
    unsigned voffA[2], voffB[2];
#pragma unroll
    for (int i = 0; i < 2; ++i) { int R, C; stage_rc(tid * 16 + i * 8192, R, C); const int Rb = Epi::PERM ? ((R & ~31) + perm32(R & 31)) : R;
        voffA[i] = (unsigned)(R * K + C) * 2u; voffB[i] = (unsigned)(Rb * K + C) * 2u; }
    const size_t kstep = (size_t)(BK * 2);
    const size_t hstep = (size_t)HALF * K * 2;
    const size_t tstep = 2 * hstep;
    const unsigned ldsw = (unsigned)wid * 1024u;
    const int aoff = lds_byte(wr * 64 + fr, fq * 8), boff = lds_byte(wc * 32 + fr, fq * 8);
#define PG8_SA(b, h) (((b) * 2 + (h)) * HTB)
#define PG8_SB(b, h) ((4 + (b) * 2 + (h)) * HTB)
#define PG8_STAGE(bufoff, gbase, voff) do { _Pragma("unroll") for (int _i = 0; _i < 2; ++_i) \
        __builtin_amdgcn_global_load_lds((const unsigned*)((const char*)(gbase) + (voff)[_i]), (PG8_LAS unsigned*)(lds + (bufoff) + ldsw + _i * 8192), 16, 0, 0); } while (0)
#define PG8_LDA(dst, b, h) do { _Pragma("unroll") for (int m = 0; m < 4; ++m) _Pragma("unroll") for (int k = 0; k < 2; ++k) dst[m][k] = *(const PG8_LAS bf16x8*)(lds + PG8_SA(b, h) + aoff + m * 2048 + k * 1024); } while (0)
#define PG8_LDB(dst, b, h) do { _Pragma("unroll") for (int n = 0; n < 2; ++n) _Pragma("unroll") for (int k = 0; k < 2; ++k) dst[n][k] = *(const PG8_LAS bf16x8*)(lds + PG8_SB(b, h) + boff + n * 2048 + k * 1024); } while (0)
#define PG8_MMA(ai, bj, At, Bt) do { __builtin_amdgcn_s_setprio(1); _Pragma("unroll") for (int m = 0; m < 4; ++m) _Pragma("unroll") for (int n = 0; n < 2; ++n) _Pragma("unroll") for (int k = 0; k < 2; ++k) \
        acc[ai][bj][m][n] = __builtin_amdgcn_mfma_f32_16x16x32_bf16(Bt[n][k], At[m][k], acc[ai][bj][m][n], 0, 0, 0); __builtin_amdgcn_s_setprio(0); } while (0)
#define PG8_WAIT_V(n) asm volatile("s_waitcnt vmcnt(" #n ")" ::: "memory")
#define PG8_WAIT_L(n) asm volatile("s_waitcnt lgkmcnt(" #n ")" ::: "memory")
#define PG8_BAR __builtin_amdgcn_s_barrier()
#define PG8_SCHED __builtin_amdgcn_sched_barrier(0)
    Unit cur, nxt; int ui = 0;
    if (!S.next(0, cur)) return;
    f32x4 acc[2][2][4][2];
#pragma unroll
    for (int a = 0; a < 2; ++a)
#pragma unroll
        for (int b = 0; b < 2; ++b)
#pragma unroll
            for (int m = 0; m < 4; ++m)
#pragma unroll
                for (int n = 0; n < 2; ++n) acc[a][b][m][n] = (f32x4){0.f, 0.f, 0.f, 0.f};
    bf16x8 At[4][2], B0[2][2], B1[2][2];
    const char* cA = (const char*)g.A + (size_t)cur.pm * tstep; const char* cB = (const char*)g.Bt + (size_t)cur.pn * tstep;
    S.a_ready(cur);
    if constexpr (SP2) {
        PG8_STAGE(PG8_SB(0, 0), cB, voffB); PG8_STAGE(PG8_SB(0, 1), cB + hstep, voffB); PG8_STAGE(PG8_SA(0, 0), cA, voffA); PG8_STAGE(PG8_SA(0, 1), cA + hstep, voffA);
        if (wr == 1) PG8_BAR;
        PG8_WAIT_V(2); PG8_BAR;
        PG8_STAGE(PG8_SB(1, 0), cB + kstep, voffB); PG8_STAGE(PG8_SA(1, 0), cA + kstep, voffA); PG8_STAGE(PG8_SB(1, 1), cB + hstep + kstep, voffB);
        PG8_WAIT_V(6); PG8_BAR;
    } else {
        PG8_STAGE(PG8_SB(0, 0), cB, voffB); PG8_STAGE(PG8_SA(0, 0), cA, voffA); PG8_STAGE(PG8_SB(0, 1), cB + hstep, voffB); PG8_STAGE(PG8_SA(0, 1), cA + hstep, voffA);
        if (wr == 1) PG8_BAR;
        PG8_WAIT_V(4); PG8_BAR;
        PG8_STAGE(PG8_SB(1, 0), cB + kstep, voffB); PG8_STAGE(PG8_SA(1, 0), cA + kstep, voffA); PG8_STAGE(PG8_SB(1, 1), cB + hstep + kstep, voffB);
        PG8_WAIT_V(6); PG8_BAR;
    }
    for (;;) {
        const bool has_next = S.next(ui + 1, nxt);
        const char* nA = has_next ? (const char*)g.A + (size_t)nxt.pm * tstep : cA; const char* nB = has_next ? (const char*)g.Bt + (size_t)nxt.pn * tstep : cB;
        for (int t = 0; t < nt; t += 2) {
            const bool last = (t == nt - 2);
            const char* a1 = cA + (size_t)(t + 1) * kstep;
            const char* a2 = last ? nA : cA + (size_t)(t + 2) * kstep; const char* b2 = last ? nB : cB + (size_t)(t + 2) * kstep;
            const char* a3 = a2 + kstep; const char* b3 = b2 + kstep;
            if (last && has_next) S.a_ready(nxt);
            if constexpr (SP2) {
            PG8_LDB(B0, 0, 0); PG8_LDB(B1, 0, 1); PG8_SCHED; PG8_LDA(At, 0, 0); PG8_STAGE(PG8_SA(1, 1), a1 + hstep, voffA);
            PG8_WAIT_V(8); PG8_WAIT_L(0); PG8_BAR; PG8_MMA(0, 0, At, B0); PG8_MMA(0, 1, At, B1); PG8_BAR; PG8_SCHED;
            PG8_LDA(At, 0, 1); PG8_STAGE(PG8_SB(0, 0), b2, voffB); PG8_STAGE(PG8_SB(0, 1), b2 + hstep, voffB); PG8_STAGE(PG8_SA(0, 0), a2, voffA);
            PG8_WAIT_V(8); PG8_WAIT_L(0); PG8_BAR; PG8_MMA(1, 0, At, B0); PG8_MMA(1, 1, At, B1); PG8_BAR; PG8_SCHED;
            PG8_LDB(B0, 1, 0); PG8_LDB(B1, 1, 1); PG8_SCHED; PG8_LDA(At, 1, 0); PG8_STAGE(PG8_SA(0, 1), a2 + hstep, voffA);
            PG8_WAIT_V(8); PG8_WAIT_L(0); PG8_BAR; PG8_MMA(0, 0, At, B0); PG8_MMA(0, 1, At, B1); PG8_BAR; PG8_SCHED;
            PG8_LDA(At, 1, 1); PG8_STAGE(PG8_SB(1, 0), b3, voffB); PG8_STAGE(PG8_SB(1, 1), b3 + hstep, voffB); PG8_STAGE(PG8_SA(1, 0), a3, voffA);
            PG8_WAIT_V(8); PG8_WAIT_L(0); PG8_BAR; PG8_MMA(1, 0, At, B0); PG8_MMA(1, 1, At, B1); PG8_BAR; PG8_SCHED;
            } else {
            PG8_LDB(B0, 0, 0); PG8_SCHED; PG8_LDA(At, 0, 0); PG8_STAGE(PG8_SA(1, 1), a1 + hstep, voffA);
            PG8_WAIT_L(8); PG8_BAR; PG8_WAIT_L(0); PG8_MMA(0, 0, At, B0); PG8_BAR; PG8_SCHED;
            PG8_LDB(B1, 0, 1); PG8_STAGE(PG8_SB(0, 0), b2, voffB);
            PG8_BAR; PG8_WAIT_L(0); PG8_MMA(0, 1, At, B1); PG8_BAR;
            PG8_LDA(At, 0, 1); PG8_STAGE(PG8_SA(0, 0), a2, voffA);
            PG8_BAR; PG8_WAIT_L(0); PG8_MMA(1, 0, At, B0); PG8_BAR; PG8_SCHED;
            PG8_STAGE(PG8_SB(0, 1), b2 + hstep, voffB);
            PG8_WAIT_V(6); PG8_BAR; PG8_MMA(1, 1, At, B1); PG8_BAR;
            PG8_LDB(B0, 1, 0); PG8_SCHED; PG8_LDA(At, 1, 0); PG8_STAGE(PG8_SA(0, 1), a2 + hstep, voffA);
            PG8_WAIT_L(8); PG8_BAR; PG8_WAIT_L(0); PG8_MMA(0, 0, At, B0); PG8_BAR; PG8_SCHED;
            PG8_LDB(B1, 1, 1); PG8_STAGE(PG8_SB(1, 0), b3, voffB);
            PG8_BAR; PG8_WAIT_L(0); PG8_MMA(0, 1, At, B1); PG8_BAR;
            PG8_LDA(At, 1, 1); PG8_STAGE(PG8_SA(1, 0), a3, voffA);
            PG8_BAR; PG8_WAIT_L(0); PG8_MMA(1, 0, At, B0); PG8_BAR; PG8_SCHED;
            PG8_STAGE(PG8_SB(1, 1), b3 + hstep, voffB);
            PG8_WAIT_V(6); PG8_BAR; PG8_MMA(1, 1, At, B1); PG8_BAR;
            }
        }
        if constexpr (ALIGN_EPI) { if (wr == 0) PG8_BAR; }
        if constexpr (!Epi::AFTER_DRAIN) { E(acc, cur, wr, wc, fr, fq); S.done(cur); }
        if (!has_next) break;
#pragma unroll
        for (int a = 0; a < 2; ++a)
#pragma unroll
            for (int b = 0; b < 2; ++b)
#pragma unroll
                for (int m = 0; m < 4; ++m)
#pragma unroll
                    for (int n = 0; n < 2; ++n) acc[a][b][m][n] = (f32x4){0.f, 0.f, 0.f, 0.f};
        cur = nxt; cA = nA; cB = nB; ++ui;
        if constexpr (ALIGN_EPI) { if (wr == 1) PG8_BAR; }
    }
    PG8_WAIT_V(0);
    if constexpr (!ALIGN_EPI) { if (wr == 0) PG8_BAR; }
    PG8_BAR;
    if constexpr (Epi::AFTER_DRAIN) { E.fused(acc, cur, wr, wc, fr, fq, lds, wid, lane); S.done(cur); }
#undef PG8_SA
#undef PG8_SB
#undef PG8_STAGE
#undef PG8_LDA
#undef PG8_LDB
#undef PG8_MMA
#undef PG8_WAIT_V
#undef PG8_WAIT_L
#undef PG8_BAR
#undef PG8_SCHED
}
}
#include <hip/hip_bf16.h>
#include <cmath>
namespace attn_body {
using bf16=__hip_bfloat16;
using bf16x8=__attribute__((ext_vector_type(8)))short;
using s16x4=__attribute__((ext_vector_type(4)))short;
using f32x16=__attribute__((ext_vector_type(16)))float;
using u32x4=__attribute__((ext_vector_type(4)))unsigned;
constexpr int BATCH=16,SEQ=4096,D=64,PQ=2048,PO=1024;
constexpr int NW=8,QBLK=32,QB=QBLK*NW,KVBLK=64,NQB=SEQ/QB;
constexpr int ATTN_UNIT_ROWS=QB;
__device__ __forceinline__ int crow(int r,int hi){return (r&3)+8*(r>>2)+4*hi;}
#define SBAR() __builtin_amdgcn_sched_barrier(0)
__device__ __forceinline__ void cmask(f32x16&p0,f32x16&p1,int jb,int qrel,int hi,const __attribute__((address_space(3))) float*tab){
  asm volatile("s_nop 15\n\ts_nop 7":"+v"(p0),"+v"(p1));
  const __attribute__((address_space(3))) float*tp=tab+(qrel-64*jb-4*hi+256);
  #pragma unroll
  for(int r=0;r<16;++r){const int o=(r&3)+8*(r>>2); float a0=tp[-o], a1=tp[-o-32]; asm volatile("v_add_f32_e32 %0, %1, %0":"+v"(p0[r]):"v"(a0)); asm volatile("v_add_f32_e32 %0, %1, %0":"+v"(p1[r]):"v"(a1));}
}

constexpr int NSLOT=3, SLOTB=8192;
constexpr int LDS_K=0, LDS_V=NSLOT*SLOTB, LDS_WS=2*NSLOT*SLOTB, LDS_TAB=LDS_WS+NW*64*4, LDS_OST=LDS_TAB+3072, LDS_BYTES=LDS_OST+NW*4096;
constexpr float C2=0.125f*1.4426950408889634f;
__device__ __forceinline__ void glds16(const void*gsrc,unsigned lds_dst){unsigned keep;
  asm volatile("s_mov_b32 %0, m0\n\ts_mov_b32 m0, %2\n\ts_nop 0\n\tglobal_load_lds_dwordx4 %1, off\n\ts_mov_b32 m0, %0":"=&s"(keep):"v"(gsrc),"s"(lds_dst):"memory");}
__device__ __forceinline__ float max3f(float a,float b,float c){float r;asm("v_max3_f32 %0, %1, %2, %3":"=v"(r):"v"(a),"v"(b),"v"(c));return r;}
__device__ __forceinline__ float max2f(float a,float b){float r;asm("v_max_f32_e32 %0, %1, %2":"=v"(r):"v"(a),"v"(b));return r;}
__device__ __forceinline__ float fadd_s(float a,float b){float r;asm("v_add_f32_e32 %0, %1, %2":"=v"(r):"v"(a),"v"(b));return r;}
__device__ __forceinline__ float fsub_s(float a,float b){float r;asm("v_sub_f32_e32 %0, %1, %2":"=v"(r):"v"(a),"v"(b));return r;}
typedef float f32x2_t __attribute__((ext_vector_type(2))); typedef __bf16 bf16x2_t __attribute__((ext_vector_type(2)));
__device__ __forceinline__ unsigned cvtpk_s(float lo,float hi){f32x2_t v={lo,hi};bf16x2_t b=__builtin_convertvector(v,bf16x2_t);return __builtin_bit_cast(unsigned,b);}
#define WAIT_BAR(N) asm volatile("s_waitcnt vmcnt(" #N ") lgkmcnt(0)\n\ts_barrier":::"memory")

__device__ __forceinline__ void qkt(f32x16&p0,f32x16&p1,const char*Kslot,const bf16x8*qr,const f32x16&negm,int r32,int hi){
  const char*kb=Kslot+hi*1024+r32*16;
  #pragma unroll
  for(int d0=0;d0<4;++d0){
    const bf16x8 b0=*reinterpret_cast<const bf16x8*>(kb+d0*2048);
    const bf16x8 b1=*reinterpret_cast<const bf16x8*>(kb+d0*2048+512);
    if(d0==0){p0=__builtin_amdgcn_mfma_f32_32x32x16_bf16(b0,qr[0],negm,0,0,0);p1=__builtin_amdgcn_mfma_f32_32x32x16_bf16(b1,qr[0],negm,0,0,0);}
    else{p0=__builtin_amdgcn_mfma_f32_32x32x16_bf16(b0,qr[d0],p0,0,0,0);p1=__builtin_amdgcn_mfma_f32_32x32x16_bf16(b1,qr[d0],p1,0,0,0);}}
}
typedef __attribute__((address_space(3))) const char* lds_cptr;
typedef short v4i16_t __attribute__((ext_vector_type(4)));
__device__ __forceinline__ void kload8(bf16x8*kf,lds_cptr kp){
  kf[0]=*(const __attribute__((address_space(3))) bf16x8*)(kp);      kf[1]=*(const __attribute__((address_space(3))) bf16x8*)(kp+512);
  kf[2]=*(const __attribute__((address_space(3))) bf16x8*)(kp+2048); kf[3]=*(const __attribute__((address_space(3))) bf16x8*)(kp+2560);
  kf[4]=*(const __attribute__((address_space(3))) bf16x8*)(kp+4096); kf[5]=*(const __attribute__((address_space(3))) bf16x8*)(kp+4608);
  kf[6]=*(const __attribute__((address_space(3))) bf16x8*)(kp+6144); kf[7]=*(const __attribute__((address_space(3))) bf16x8*)(kp+6656);
}
__device__ __forceinline__ void kload2(bf16x8*kf,lds_cptr kp,int j){ kf[2*j]=*(const __attribute__((address_space(3))) bf16x8*)(kp+j*2048); kf[2*j+1]=*(const __attribute__((address_space(3))) bf16x8*)(kp+j*2048+512); }
__device__ __forceinline__ s16x4 vtr(lds_cptr p){ return __builtin_bit_cast(s16x4,__builtin_amdgcn_ds_read_tr16_b64_v4i16((__attribute__((address_space(3))) v4i16_t*)p)); }
__device__ __forceinline__ float rowmax(const f32x16&p0,const f32x16&p1){
  float a=max3f(p0[0],p0[1],p1[0]),b=max3f(p0[2],p0[3],p1[1]);a=max3f(a,p1[2],p1[3]);
  #pragma unroll
  for(int r=4;r<16;r+=4){a=max3f(a,p0[r],p0[r+1]);b=max3f(b,p0[r+2],p0[r+3]);a=max3f(a,p1[r],p1[r+1]);b=max3f(b,p1[r+2],p1[r+3]);}
  const float m=max2f(a,b);
  auto rr=__builtin_amdgcn_permlane32_swap(__float_as_uint(m),__float_as_uint(m),false,false);
  return max2f(__uint_as_float(rr[0]),__uint_as_float(rr[1]));
}
__device__ __forceinline__ void pv(f32x16*o,int vb,bf16x8 pa0,bf16x8 pa1,bf16x8 pa2,bf16x8 pa3){
  #pragma unroll
  for(int d0=0;d0<2;++d0){s16x4 lo[4],hi[4];
    #pragma unroll
    for(int ks=0;ks<4;++ks){
      asm volatile("ds_read_b64_tr_b16 %0,%1 offset:%c2":"=&v"(lo[ks]):"v"(vb),"i"(d0*4096+ks*1024):"memory");
      asm volatile("ds_read_b64_tr_b16 %0,%1 offset:%c2":"=&v"(hi[ks]):"v"(vb),"i"(d0*4096+ks*1024+512):"memory");}
    asm volatile("s_waitcnt lgkmcnt(0)":::"memory");SBAR();
    #define PK(k) (bf16x8){lo[k][0],lo[k][1],lo[k][2],lo[k][3],hi[k][0],hi[k][1],hi[k][2],hi[k][3]}
    o[d0]=__builtin_amdgcn_mfma_f32_32x32x16_bf16(pa0,PK(0),o[d0],0,0,0);
    o[d0]=__builtin_amdgcn_mfma_f32_32x32x16_bf16(pa1,PK(1),o[d0],0,0,0);
    o[d0]=__builtin_amdgcn_mfma_f32_32x32x16_bf16(pa2,PK(2),o[d0],0,0,0);
    o[d0]=__builtin_amdgcn_mfma_f32_32x32x16_bf16(pa3,PK(3),o[d0],0,0,0);
    #undef PK
  }
}

#ifndef ATTN_STORE16
#define ATTN_STORE16(p,v) (*(u32x4*)(p)=(v))
#endif
template<int THRL> __device__ __forceinline__ void attn_unit(int b,int qb,const bf16*Q,const bf16*__restrict__ K,const bf16*__restrict__ V,bf16*O,const __attribute__((address_space(3))) float*tab,char*shm){
  int tid_=threadIdx.x; asm volatile("":"+v"(tid_)); const int tid=tid_,lane=tid&63,r32=lane&31,hi=lane>>5; const int wid=__builtin_amdgcn_readfirstlane(tid>>6);
  const long rowbase=(long)b*SEQ; const int q0=qb*QB;
  const bf16*Qw=Q+(rowbase+q0+wid*QBLK)*PQ;
  const bf16*Kh=K+rowbase*PQ,*Vh=V+rowbase*PQ;
  const unsigned lds0=(unsigned)(uintptr_t)shm;
  float*wsf=(float*)(shm+LDS_WS)+wid*64;
  const bf16*ksrc=Kh+(long)lane*PQ+wid*8;
  const bf16*vsrc=Vh+(long)(16*(wid&3)+(lane>>2))*PQ+(wid>>2)*32+(lane&3)*8;
  const unsigned kdst=lds0+LDS_K+wid*1024, vdst=lds0+LDS_V+wid*1024;
  #define DMA_K(t,slot) glds16(ksrc+(long)(t)*KVBLK*PQ,(unsigned)__builtin_amdgcn_readfirstlane(kdst+(slot)))
  #define DMA_V(t,slot) glds16(vsrc+(long)(t)*KVBLK*PQ,(unsigned)__builtin_amdgcn_readfirstlane(vdst+(slot)))
  const int vb0=(int)(lds0+LDS_V)+((lane>>4)&1)*32+(lane&3)*8+(4*hi+((lane&15)>>2))*64;
  const char*Kbase=shm+LDS_K; bf16x8 kf[8];
  const lds_cptr shm3=(lds_cptr)shm; const lds_cptr kp0=shm3+LDS_K+hi*1024+r32*16; const lds_cptr vp0=shm3+LDS_V+((lane>>4)&1)*32+(lane&3)*8+(4*hi+((lane&15)>>2))*64;
  const int NT=(q0+QB)/KVBLK;
  DMA_K(0,0);DMA_V(0,0);DMA_K(1,SLOTB);
  bf16x8 qr[4];
  #pragma unroll
  for(int d0=0;d0<4;++d0)qr[d0]=*reinterpret_cast<const bf16x8*>(&Qw[(long)r32*PQ+d0*16+hi*8]);
  float mhat=0.f,l_reg=0.f;f32x16 o[2];o[0]=f32x16{};o[1]=f32x16{};f32x16 negm=f32x16{};asm volatile("":"+v"(negm));
  const int qrel=wid*QBLK+r32;
  #define CMASK(P0,P1,t) do{int jb_=(t)-(NT-4); if(jb_>=-2)cmask(P0,P1,jb_,qrel,hi,tab);}while(0)
  bool resc=false;
  #define START(P0,P1) do{ const float rm=rowmax(P0,P1); resc=false; \
    { const float dl=rm; mhat=fadd_s(mhat,dl); \
      _Pragma("unroll") for(int r=0;r<16;++r){P0[r]=fsub_s(P0[r],dl);P1[r]=fsub_s(P1[r],dl);} \
      _Pragma("unroll") for(int r=0;r<16;++r)negm[r]=-mhat; asm volatile("":"+v"(negm)); } \
    _Pragma("unroll") for(int r=0;r<16;++r)P0[r]=__builtin_amdgcn_exp2f(P0[r]); }while(0)
  #define RESC() do{ if(resc){ asm volatile("s_waitcnt lgkmcnt(0)":::"memory"); \
      _Pragma("unroll") for(int d_=0;d_<2;++d_) _Pragma("unroll") for(int r=0;r<16;++r)o[d_][r]*=wsf[crow(r,hi)]; } }while(0)
  f32x16 pA0,pA1,pB0,pB1;
  int sl_prev=0,sl_cur=0,sl_next=SLOTB;
  #define ROT() do{sl_prev=sl_cur;sl_cur=sl_next;sl_next=(sl_next==(NSLOT-1)*SLOTB)?0:sl_next+SLOTB;}while(0)
  DMA_K(2,2*SLOTB);
  WAIT_BAR(3);
  qkt(pA0,pA1,Kbase,qr,negm,r32,hi);asm volatile("s_nop 15\n\ts_nop 7":"+v"(pA0),"+v"(pA1));CMASK(pA0,pA1,0);
  START(pA0,pA1);
  _Pragma("unroll") for(int r=0;r<16;++r)pA1[r]=__builtin_amdgcn_exp2f(pA1[r]);
  WAIT_BAR(0);
  DMA_K(3,0);DMA_V(1,SLOTB);
  ROT();
  kload8(kf,kp0+sl_cur);
  WAIT_BAR(2);
  s16x4 vlo[8],vhi[8]; u32x4 pw0,pw1,pw2,pw3;
  #define PKW(P,B) cvtpk_s(P[B],P[B+1])
  #define PAF(k) __builtin_bit_cast(bf16x8,pw##k)
  #define VFR(i) (bf16x8){vlo[i][0],vlo[i][1],vlo[i][2],vlo[i][3],vhi[i][0],vhi[i][1],vhi[i][2],vhi[i][3]}
  #define PIN(x) asm volatile("":"+v"(x))
  #define MX3(a,b,c) __builtin_fmaxf(__builtin_fmaxf((a),(b)),(c))
  #define GAPA(MF,A0,A1,A2,A3,W0,W1,PW) do{ MF; sacc+=A0; sacc+=A1; sacc+=A2; sacc+=A3; PIN(sacc); W0; W1; PIN(PW); SBAR(); }while(0)
  #define EX(v) __builtin_amdgcn_exp2f(v)
  #define GAPB(MF,X,B) do{ MF; X[B]=EX(X[B]); X[B+1]=EX(X[B+1]); X[B+2]=EX(X[B+2]); X[B+3]=EX(X[B+3]); PIN(X); SBAR(); }while(0)
  #define VRD(i) do{ vlo[i]=vtr(vp_+(((i)>>2)*4096+((i)&3)*1024)); vhi[i]=vtr(vp_+(((i)>>2)*4096+((i)&3)*1024+512)); }while(0)
  #define KRD(G,j) do{ if(G){ kload2(kf,kp0+sl_next,j); SBAR(); } }while(0)
  #define STEP(C0,C1,P0,P1,t,GK,GV,GL) do{ SBAR(); \
    const lds_cptr vp_=vp0+sl_prev; \
    VRD(0); SBAR(); float sacc=(P0[0]+P0[1]); \
    GAPA(C0=__builtin_amdgcn_mfma_f32_32x32x16_bf16(kf[0],qr[0],negm,0,0,0), P0[2],P0[3],P0[4],P0[5],     pw0[0]=PKW(P0,0), pw0[1]=PKW(P0,2), pw0); \
    VRD(4); SBAR(); GAPA(C1=__builtin_amdgcn_mfma_f32_32x32x16_bf16(kf[1],qr[0],negm,0,0,0), P0[6],P0[7],P0[8],P0[9],     pw0[2]=PKW(P0,4), pw0[3]=PKW(P0,6), pw0); \
    VRD(1); SBAR(); GAPA(C0=__builtin_amdgcn_mfma_f32_32x32x16_bf16(kf[2],qr[1],C0,0,0,0),   P0[10],P0[11],P0[12],P0[13], pw1[0]=PKW(P0,8), pw1[1]=PKW(P0,10), pw1); \
    VRD(5); SBAR(); GAPA(C1=__builtin_amdgcn_mfma_f32_32x32x16_bf16(kf[3],qr[1],C1,0,0,0),   P0[14],P0[15],P1[0],P1[1],   pw1[2]=PKW(P0,12),pw1[3]=PKW(P0,14), pw1); \
    VRD(2); SBAR(); GAPA(C0=__builtin_amdgcn_mfma_f32_32x32x16_bf16(kf[4],qr[2],C0,0,0,0),   P1[2],P1[3],P1[4],P1[5],     pw2[0]=PKW(P1,0), pw2[1]=PKW(P1,2), pw2); \
    VRD(6); SBAR(); GAPA(C1=__builtin_amdgcn_mfma_f32_32x32x16_bf16(kf[5],qr[2],C1,0,0,0),   P1[6],P1[7],P1[8],P1[9],     pw2[2]=PKW(P1,4), pw2[3]=PKW(P1,6), pw2); \
    VRD(3); SBAR(); GAPA(C0=__builtin_amdgcn_mfma_f32_32x32x16_bf16(kf[6],qr[3],C0,0,0,0),   P1[10],P1[11],P1[12],P1[13], pw3[0]=PKW(P1,8), pw3[1]=PKW(P1,10), pw3); \
    VRD(7); SBAR(); GAPA(C1=__builtin_amdgcn_mfma_f32_32x32x16_bf16(kf[7],qr[3],C1,0,0,0),   P1[14],P1[15],0.f,0.f,       pw3[2]=PKW(P1,12),pw3[3]=PKW(P1,14), pw3); \
    l_reg+=sacc; \
    if(GK){DMA_K((t)+3,sl_cur);} if(GV){DMA_V((t)+1,sl_next);} \
    CMASK(C0,C1,t); \
    { float a=MX3(C0[0],C0[1],C1[0]),b=MX3(C0[2],C0[3],C1[1]); a=MX3(a,C1[2],C1[3]); \
      _Pragma("unroll") for(int r=4;r<16;r+=4){a=MX3(a,C0[r],C0[r+1]);b=MX3(b,C0[r+2],C0[r+3]);a=MX3(a,C1[r],C1[r+1]);b=MX3(b,C1[r+2],C1[r+3]);} \
      float rm=__builtin_fmaxf(a,b); { auto rr=__builtin_amdgcn_permlane32_swap(__float_as_uint(rm),__float_as_uint(rm),false,false); rm=__builtin_fmaxf(__uint_as_float(rr[0]),__uint_as_float(rr[1])); } \
      resc=false; \
      if(__builtin_expect(__any(rm>(float)THRL),0)){ const float dl=__builtin_fmaxf(rm,0.f); mhat+=dl; \
        _Pragma("unroll") for(int r=0;r<16;++r){C0[r]-=dl;C1[r]-=dl;} \
        _Pragma("unroll") for(int r=0;r<16;++r)negm[r]=-mhat; asm volatile("":"+v"(negm)); \
        const float f=__builtin_amdgcn_exp2f(-dl); l_reg*=f; if(hi==0)wsf[r32]=f; resc=true; } } \
    SBAR(); \
    GAPB(o[0]=__builtin_amdgcn_mfma_f32_32x32x16_bf16(PAF(0),VFR(0),o[0],0,0,0), C0,0); \
    GAPB(o[1]=__builtin_amdgcn_mfma_f32_32x32x16_bf16(PAF(0),VFR(4),o[1],0,0,0), C0,4); \
    KRD(GL,0); GAPB(o[0]=__builtin_amdgcn_mfma_f32_32x32x16_bf16(PAF(1),VFR(1),o[0],0,0,0), C0,8); \
    KRD(GL,1); GAPB(o[1]=__builtin_amdgcn_mfma_f32_32x32x16_bf16(PAF(1),VFR(5),o[1],0,0,0), C0,12); \
    KRD(GL,2); GAPB(o[0]=__builtin_amdgcn_mfma_f32_32x32x16_bf16(PAF(2),VFR(2),o[0],0,0,0), C1,0); \
    KRD(GL,3); GAPB(o[1]=__builtin_amdgcn_mfma_f32_32x32x16_bf16(PAF(2),VFR(6),o[1],0,0,0), C1,4); \
    GAPB(o[0]=__builtin_amdgcn_mfma_f32_32x32x16_bf16(PAF(3),VFR(3),o[0],0,0,0), C1,8); \
    GAPB(o[1]=__builtin_amdgcn_mfma_f32_32x32x16_bf16(PAF(3),VFR(7),o[1],0,0,0), C1,12); \
    }while(0)
  int t=1;
  #undef CMASK
  #define CMASK(P0,P1,t) do{}while(0)
  for(;t+7<NT;t+=2){
    STEP(pB0,pB1,pA0,pA1,t,true,true,true);     WAIT_BAR(2); RESC(); ROT();
    STEP(pA0,pA1,pB0,pB1,t+1,true,true,true);   WAIT_BAR(2); RESC(); ROT();
  }
  #undef CMASK
  #define CMASK(P0,P1,t) do{int jb_=(t)-(NT-4); if(jb_>=-2)cmask(P0,P1,jb_,qrel,hi,tab);}while(0)
  #define ENDW(tt) do{ if((tt)+3<NT){WAIT_BAR(2);} else if((tt)+2<NT){WAIT_BAR(1);} else {WAIT_BAR(0);} }while(0)
  for(;t+1<NT;t+=2){
    STEP(pB0,pB1,pA0,pA1,t,(t+3<NT),(t+1<NT),(t+1<NT));       ENDW(t);   RESC(); ROT();
    STEP(pA0,pA1,pB0,pB1,t+1,(t+4<NT),(t+2<NT),(t+2<NT));     ENDW(t+1); RESC(); ROT();
  }
  STEP(pB0,pB1,pA0,pA1,NT-1,false,false,false); RESC();
  { float sacc=pB0[0]+pB0[1]; _Pragma("unroll") for(int r=2;r<16;++r)sacc+=pB0[r]; _Pragma("unroll") for(int r=0;r<16;++r)sacc+=pB1[r]; l_reg+=sacc;
    pw0=(u32x4){PKW(pB0,0),PKW(pB0,2),PKW(pB0,4),PKW(pB0,6)};pw1=(u32x4){PKW(pB0,8),PKW(pB0,10),PKW(pB0,12),PKW(pB0,14)};pw2=(u32x4){PKW(pB1,0),PKW(pB1,2),PKW(pB1,4),PKW(pB1,6)};pw3=(u32x4){PKW(pB1,8),PKW(pB1,10),PKW(pB1,12),PKW(pB1,14)};
    SBAR(); pv(o,vb0+sl_cur,PAF(0),PAF(1),PAF(2),PAF(3)); }
  #undef PKW
  #undef PAF
  #undef VFR
  #undef PIN
  #undef MX3
  #undef GAPA
  #undef GAPB
  #undef EX
  #undef VRD
  #undef KRD
  #undef STEP
  #undef ENDW
  {auto rr=__builtin_amdgcn_permlane32_swap(__float_as_uint(l_reg),__float_as_uint(l_reg),false,false);l_reg=__uint_as_float(rr[0])+__uint_as_float(rr[1]);}
  if(hi==0)wsf[32+r32]=l_reg;asm volatile("s_waitcnt lgkmcnt(0)":::"memory");
  float rli[16];
  #pragma unroll
  for(int r=0;r<16;++r)rli[r]=__builtin_amdgcn_rcpf(wsf[32+crow(r,hi)]);
  bf16*Ow=O+(rowbase+q0+wid*QBLK)*PO;
  { bf16*stg=(bf16*)(shm+LDS_OST)+wid*2048;
    #pragma unroll
    for(int r=0;r<16;++r){const int orow=crow(r,hi);
      #pragma unroll
      for(int d0=0;d0<2;++d0)stg[orow*64+d0*32+r32]=__float2bfloat16(o[d0][r]*rli[r]);}
    asm volatile("s_waitcnt lgkmcnt(0)":::"memory");
    #pragma unroll
    for(int i=0;i<4;++i){const int row=i*8+(lane>>3),ch=lane&7; const u32x4 v=*(const u32x4*)(stg+row*64+ch*8); ATTN_STORE16(Ow+(long)row*PO+ch*8,v);} }
  asm volatile("s_waitcnt lgkmcnt(0)\n\ts_barrier":::"memory");
  #undef DMA_K
  #undef DMA_V
  #undef CMASK
  #undef START
  #undef RESC
  #undef ROT
}
constexpr int ATTN_LDS_BYTES=LDS_BYTES;
#undef SBAR
#undef WAIT_BAR
}
namespace xat {
#define XLAS __attribute__((address_space(3)))
typedef unsigned short bf16_t;
typedef short bf16x8 __attribute__((ext_vector_type(8)));
typedef float f32x16 __attribute__((ext_vector_type(16)));
typedef unsigned u32x4 __attribute__((ext_vector_type(4)));
typedef unsigned u32x2 __attribute__((ext_vector_type(2)));
typedef float f32x2_t __attribute__((ext_vector_type(2))); typedef __bf16 bf16x2_t __attribute__((ext_vector_type(2)));
__device__ __forceinline__ unsigned cvtpk(float lo, float hi) { f32x2_t v = {lo, hi}; bf16x2_t b = __builtin_convertvector(v, bf16x2_t); return __builtin_bit_cast(unsigned, b); }
constexpr int KP = 528, CHB = 32 * KP, XS_OFF = 34816, XS_BYTES = 8704, LDS_BYTES = XS_OFF + 8 * XS_BYTES;
__device__ __forceinline__ void unit(XLAS unsigned char* lds, const bf16_t* Qg, const bf16_t* Kg, const bf16_t* Vg, bf16_t* Og) {
    int tid_ = threadIdx.x; asm volatile("" : "+v"(tid_)); const int tid = tid_, lane = tid & 63, r32 = lane & 31, hi = lane >> 5; const int wid = __builtin_amdgcn_readfirstlane(tid >> 6);
    const int sr = tid >> 4, sseg = tid & 15;
    const bf16_t* kgp = Kg + (size_t)sr * 4096 + sseg * 16;
    const bf16_t* vgp = Vg + (size_t)sr * 4096 + sseg * 16;
    const unsigned wofs = (unsigned)(sr * KP + sseg * 32);
#define XAT_SRC(c) ((c) < 8 ? kgp + (size_t)(c) * 32 * 4096 : vgp + (size_t)((c) - 8) * 32 * 4096)
    u32x4 g[2][2];
    g[0][0] = *(const u32x4*)(XAT_SRC(0)); g[0][1] = *(const u32x4*)(XAT_SRC(0) + 8); g[1][0] = *(const u32x4*)(XAT_SRC(1)); g[1][1] = *(const u32x4*)(XAT_SRC(1) + 8);
    XLAS unsigned char* xs = lds + XS_OFF + wid * XS_BYTES;
    bf16x8 qf[16];
#pragma unroll
    for (int hq = 0; hq < 2; ++hq) {
        const bf16_t* qbase = Qg + (size_t)(wid * 32 + (lane >> 4)) * 1024 + hq * 128 + (lane & 15) * 8;
        u32x4 qv[8];
#pragma unroll
        for (int i = 0; i < 8; ++i) qv[i] = *(const u32x4*)(qbase + (size_t)(4 * i) * 1024);
#pragma unroll
        for (int i = 0; i < 8; ++i) *(XLAS u32x4*)(xs + (4 * i + (lane >> 4)) * 272 + (lane & 15) * 16) = qv[i];
#pragma unroll
        for (int s = 0; s < 8; ++s) qf[hq * 8 + s] = *(const XLAS bf16x8*)(xs + r32 * 272 + s * 32 + hi * 16);
    }
    const int krow = (r32 & 0x13) | ((r32 & 4) << 1) | ((r32 & 8) >> 1);
    const unsigned kro = (unsigned)(krow * KP + hi * 16), vro = (unsigned)(r32 * KP + hi * 16);
    f32x16 S[8];
#pragma unroll
    for (int c = 0; c < 8; ++c) {
        XLAS unsigned char* buf = lds + (c & 1) * CHB;
        *(XLAS u32x4*)(buf + wofs) = g[c & 1][0]; *(XLAS u32x4*)(buf + wofs + 16) = g[c & 1][1];
        __syncthreads();
        { g[c & 1][0] = *(const u32x4*)(XAT_SRC(c + 2)); g[c & 1][1] = *(const u32x4*)(XAT_SRC(c + 2) + 8); }
        f32x16 a = {};
        bf16x8 kfa[4], kfb[4];
#pragma unroll
        for (int j = 0; j < 4; ++j) kfa[j] = *(const XLAS bf16x8*)(buf + kro + j * 32);
#pragma unroll
        for (int gq = 0; gq < 4; gq += 2) {
#pragma unroll
            for (int j = 0; j < 4; ++j) kfb[j] = *(const XLAS bf16x8*)(buf + kro + (4 * gq + 4 + j) * 32);
            __builtin_amdgcn_sched_barrier(0);
#pragma unroll
            for (int j = 0; j < 4; ++j) a = __builtin_amdgcn_mfma_f32_32x32x16_bf16(kfa[j], qf[4 * gq + j], a, 0, 0, 0);
            if (gq < 2) {
#pragma unroll
                for (int j = 0; j < 4; ++j) kfa[j] = *(const XLAS bf16x8*)(buf + kro + (4 * gq + 8 + j) * 32); }
            __builtin_amdgcn_sched_barrier(0);
#pragma unroll
            for (int j = 0; j < 4; ++j) a = __builtin_amdgcn_mfma_f32_32x32x16_bf16(kfb[j], qf[4 * gq + 4 + j], a, 0, 0, 0);
        }
        S[c] = a;
    }
    float mx = S[0][0];
#pragma unroll
    for (int c = 0; c < 8; ++c)
#pragma unroll
        for (int r = 0; r < 16; ++r) mx = __builtin_fmaxf(mx, S[c][r]);
    mx = __builtin_fmaxf(mx, __shfl_xor(mx, 32));
    float l = 0.f;
    u32x4 pw[8][2];
#pragma unroll
    for (int c = 0; c < 8; ++c) {
        f32x16 p;
#pragma unroll
        for (int r = 0; r < 16; ++r) { p[r] = __builtin_amdgcn_exp2f(S[c][r] - mx); l += p[r]; }
#pragma unroll
        for (int s = 0; s < 2; ++s) { pw[c][s].x = cvtpk(p[8 * s + 0], p[8 * s + 1]); pw[c][s].y = cvtpk(p[8 * s + 2], p[8 * s + 3]); pw[c][s].z = cvtpk(p[8 * s + 4], p[8 * s + 5]); pw[c][s].w = cvtpk(p[8 * s + 6], p[8 * s + 7]); }
    }
    l += __shfl_xor(l, 32);
    const float rl = 1.0f / l;
    bf16_t* obase = Og + (size_t)(wid * 32 + (lane >> 3)) * 1024 + (lane & 7) * 8;
#pragma unroll
    for (int db = 0; db < 8; ++db) {
        XLAS unsigned char* buf = lds + (db & 1) * CHB;
        *(XLAS u32x4*)(buf + wofs) = g[db & 1][0]; *(XLAS u32x4*)(buf + wofs + 16) = g[db & 1][1];
        __syncthreads();
        if (db < 6) { g[db & 1][0] = *(const u32x4*)(XAT_SRC(db + 10)); g[db & 1][1] = *(const u32x4*)(XAT_SRC(db + 10) + 8); }
        f32x16 o = {};
#pragma unroll
        for (int kb = 0; kb < 8; ++kb)
#pragma unroll
            for (int s = 0; s < 2; ++s) { const bf16x8 vf = *(const XLAS bf16x8*)(buf + vro + kb * 64 + s * 32); o = __builtin_amdgcn_mfma_f32_32x32x16_bf16(vf, __builtin_bit_cast(bf16x8, pw[kb][s]), o, 0, 0, 0); }
#pragma unroll
        for (int g4 = 0; g4 < 4; ++g4) { u32x2 w; w.x = cvtpk(o[4 * g4] * rl, o[4 * g4 + 1] * rl); w.y = cvtpk(o[4 * g4 + 2] * rl, o[4 * g4 + 3] * rl);
            *(XLAS u32x2*)(xs + r32 * 144 + ((db & 1) * 32 + 8 * g4 + 4 * hi) * 2) = w; }
        if (db & 1) {
#pragma unroll
            for (int i = 0; i < 4; ++i) { const u32x4 v = *(const XLAS u32x4*)(xs + (8 * i + (lane >> 3)) * 144 + (lane & 7) * 16); *(u32x4*)(obase + (size_t)(8 * i) * 1024 + (db >> 1) * 64) = v; }
        }
    }
}
#undef XAT_SRC
}
#define GAS __attribute__((address_space(1)))
#define LAS __attribute__((address_space(3)))
typedef unsigned short bf16;
typedef unsigned v4u __attribute__((ext_vector_type(4)));
typedef unsigned v2u __attribute__((ext_vector_type(2)));
typedef float f32x4 __attribute__((ext_vector_type(4)));
constexpr int NWAVES = 8;
constexpr int M = 65536, SEQ = 4096, DM = 1024, NMEM = 256, DEPTH = 4;
constexpr float LOG2E = 1.4426950408889634f;
constexpr float C2A = 0.125f * LOG2E;
constexpr float C2X = 0.0625f * LOG2E;
constexpr float LAMBDA_INIT0 = 0.2f, LAMBDA_INIT2 = 0.47071301834f;
constexpr float EPS = 1e-6f;
constexpr size_t MiB = 1u << 20;
constexpr size_t WS_SMALL = 1 * MiB;
constexpr size_t WS_WIN = 2 * MiB, WS_WOUT = 10 * MiB, WS_CIN = 14 * MiB, WS_COUT = 26 * MiB, WS_WQ = 30 * MiB, WS_WK = 38 * MiB, WS_WV = 46 * MiB, WS_WO = 54 * MiB, WS_W1 = 62 * MiB, WS_W2 = 94 * MiB;
constexpr size_t WS_MEMN = 126 * MiB, WS_KB = 134 * MiB, WS_VT = 166 * MiB, WS_SSQ = 198 * MiB, WS_HB = 202 * MiB, WS_MIX = 330 * MiB, WS_BIG = 458 * MiB, WS_ORAW = WS_BIG + 384 * MiB, WS_END = 970 * MiB;
constexpr int TABN = 704;
constexpr int LDS_BYTES = 147456, TAB_OFF = attn_body::LDS_TAB;
static_assert(attn_body::ATTN_LDS_BYTES <= 131072 && TABN * 4 <= 3072 && xat::LDS_BYTES <= 131072, "LDS map");

__device__ __forceinline__ float bf_lo(unsigned w) { return __uint_as_float(w << 16); }
__device__ __forceinline__ float bf_hi(unsigned w) { return __uint_as_float(w & 0xffff0000u); }
__device__ __forceinline__ unsigned pk2(float lo, float hi) { return pg8::cvt_pk_bf16(lo, hi); }
__device__ __forceinline__ float wave_sum(float v) {
#pragma unroll
    for (int o = 1; o < 64; o <<= 1) v += __shfl_xor(v, o);
    return v;
}
__device__ __forceinline__ void transpose_item(const float* W, int ldn, int Nc, bf16* WT, int ldk, int row_off, const float* rs, int ncs, float cs, LAS float* scr, int item, int lane) {
    const int nblk = Nc / 32, kb = item / nblk, nb = item % nblk, k0 = 64 * kb, n0 = 32 * nb;
    const float csl = (n0 + (lane & 31) < ncs) ? cs : 1.f;
#pragma unroll 8
    for (int i = 0; i < 32; ++i) { const int kk = 2 * i + (lane >> 5); float v = W[(size_t)(k0 + kk) * ldn + n0 + (lane & 31)] * csl; if (rs) v *= rs[k0 + kk]; scr[kk * 33 + (lane & 31)] = v; }
    asm volatile("s_waitcnt lgkmcnt(0)" ::: "memory");
    const int c = lane & 7;
#pragma unroll
    for (int j = 0; j < 4; ++j) { const int n = (lane >> 3) + 8 * j; const LAS float* s = scr + (8 * c) * 33 + n;
        v4u o; o.x = pk2(s[0 * 33], s[1 * 33]); o.y = pk2(s[2 * 33], s[3 * 33]); o.z = pk2(s[4 * 33], s[5 * 33]); o.w = pk2(s[6 * 33], s[7 * 33]);
        *(v4u*)(WT + (size_t)(row_off + n0 + n) * ldk + k0 + 8 * c) = o; }
    asm volatile("s_waitcnt lgkmcnt(0)" ::: "memory");
}
struct Args { const float* in[25]; float* out; unsigned char* ws; int lo, hi; };
enum { I_X = 0, I_MEM, I_RELB, I_MEMG, I_NMIXG, I_NXG, I_NMLPG, I_FING, I_ABWIN, I_ABWOUT, I_LQ1, I_LK1, I_LQ2, I_LK2, I_SUBLN, I_POOLW, I_POOLS, I_CWIN, I_CW, I_CWOUT, I_WQ, I_WKV, I_WO, I_W1, I_W2 };
enum { K_PRO = 0, K_MIXPROJ, K_ATTN, K_COMBINE, K_CONV, K_MIXOUT, K_XQ, K_XATTN, K_XO, K_UP, K_DOWN, K_FINAL };
constexpr int NPHASE = 30;
__host__ __device__ inline void decode_phase(int ph, int& kind, int& l) {
    if (ph == 0) { kind = K_PRO; l = 0; return; }
    if (ph == NPHASE - 1) { kind = K_FINAL; l = 0; return; }
    const int p0 = ph - 1; l = p0 / 7; const int p = p0 - 7 * l;
    kind = p == 0 ? K_MIXPROJ : p == 1 ? ((l & 1) == 0 ? K_ATTN : K_CONV) : p == 2 ? K_MIXOUT : p == 3 ? K_XQ : p == 4 ? K_XO : p == 5 ? K_UP : K_DOWN;
}

#define XB_TMO      128
#define XB_XCNT(j)  (256  + 64 * (j))
#define XB_XSUB(j)  (1280 + 64 * (j))
#define XB_XGEN(j)  (2304 + 64 * (j))
#define XB_TOP      3328
#define XB_TOPGEN   3392
#define XCD_BAR_WORDS 3456
#define XB_SPIN_CAP (1u << 22)

__device__ __forceinline__ unsigned xb_ld(unsigned* p)              { return __hip_atomic_load(p, __ATOMIC_RELAXED, __HIP_MEMORY_SCOPE_AGENT); }
__device__ __forceinline__ unsigned xb_add(unsigned* p, unsigned v) { return __hip_atomic_fetch_add(p, v, __ATOMIC_RELAXED, __HIP_MEMORY_SCOPE_AGENT); }
__device__ __forceinline__ unsigned xb_xcc_id() { return (unsigned)__builtin_amdgcn_s_getreg((3 << 11) | 20) & 0xFu; }
#define XB_SPIN(cond, bar) do { unsigned _sp = 0; while (cond) { __builtin_amdgcn_s_sleep(1); \
    if ((++_sp & 255u) == 0u) { if (xb_ld(&(bar)[XB_TMO])) break; if (_sp > XB_SPIN_CAP) { atomicAdd(&(bar)[XB_TMO], 1u); break; } } } } while (0)

struct XcdBarrier {
    unsigned* bar; unsigned x;
    volatile LAS unsigned* st;
};

__device__ __forceinline__ XcdBarrier xcd_barrier_post(unsigned* bar, volatile LAS unsigned* st) {
    XcdBarrier b; b.bar = bar; b.x = xb_xcc_id(); b.st = st;
    if (threadIdx.x == 0) (void)xb_add(&bar[XB_XCNT(b.x)], 1u);
    return b;
}
__device__ __forceinline__ void xcd_barrier_complete(unsigned* bar, unsigned x, unsigned& nloc, unsigned& nx) {
    const unsigned G = gridDim.x * gridDim.y * gridDim.z;
    unsigned sum, cnt, mine, sp = 0u;
    for (;;) {
        sum = 0u; cnt = 0u; mine = 0u;
#pragma unroll
        for (unsigned j = 0; j < 16; ++j) { const unsigned c = xb_ld(&bar[XB_XCNT(j)]); sum += c; cnt += (c > 0u) ? 1u : 0u; mine = (j == x) ? c : mine; }
        if (sum == G) break;
        __builtin_amdgcn_s_sleep(1);
        if ((++sp & 255u) == 0u) { if (xb_ld(&bar[XB_TMO])) break; if (sp > XB_SPIN_CAP) { atomicAdd(&bar[XB_TMO], 1u); break; } }
    }
    nloc = mine > 0u ? mine : 1u; nx = cnt > 0u ? cnt : 1u;
}

__device__ __forceinline__ void xcd_barrier(const XcdBarrier& b) {
    asm volatile("s_waitcnt vmcnt(0)" ::: "memory");
    __syncthreads();
    if (threadIdx.x == 0) {
        unsigned* bar = b.bar;
        __builtin_amdgcn_s_waitcnt(0);
        unsigned nloc = b.st[0], nx = b.st[1];
        if (nloc == 0u) { xcd_barrier_complete(bar, b.x, nloc, nx); b.st[0] = nloc; b.st[1] = nx; }
        const unsigned old = xb_add(&bar[XB_XSUB(b.x)], 1u);
        const unsigned gen = old / nloc;
        if (old + 1u == (gen + 1u) * nloc) {
            __builtin_amdgcn_fence(__ATOMIC_RELEASE, "agent");
            asm volatile("s_waitcnt vmcnt(0)" ::: "memory");
            const unsigned og = xb_add(&bar[XB_TOP], 1u);
            const unsigned tg = og / nx;
            if (og + 1u == (tg + 1u) * nx) xb_add(&bar[XB_TOPGEN], 1u);
            else XB_SPIN(xb_ld(&bar[XB_TOPGEN]) == tg, bar);
            __builtin_amdgcn_fence(__ATOMIC_ACQUIRE, "agent");
            xb_add(&bar[XB_XGEN(b.x)], 1u);
            asm volatile("s_waitcnt vmcnt(0)" ::: "memory");
        } else {
            XB_SPIN(xb_ld(&bar[XB_XGEN(b.x)]) == gen, bar);
            __builtin_amdgcn_fence(__ATOMIC_ACQUIRE, "agent");
            asm volatile("s_waitcnt vmcnt(0)" ::: "memory");
        }
    }
    __syncthreads();
}

constexpr int XB_ST_OFF = LDS_BYTES - 64;
__global__ void __launch_bounds__(NWAVES * 64, 2) trunk_fwd(Args args) {
    extern __shared__ __attribute__((aligned(16))) unsigned char lds[];
    cg::grid_group grid = cg::this_grid();
    LAS unsigned char* L = (LAS unsigned char*)lds;
    if (threadIdx.x == 0) { ((volatile LAS unsigned*)(L + XB_ST_OFF))[0] = 0u; ((volatile LAS unsigned*)(L + XB_ST_OFF))[1] = 0u; }
    __syncthreads();
    if (blockIdx.x == 0) for (int i = threadIdx.x; i < XCD_BAR_WORDS; i += NWAVES * 64) ((unsigned*)args.ws)[i] = 0u;
    const int ph_hi = args.hi; int ph0 = args.lo;
    if (ph0 == 0) {
        const int l = 0, li = 0; (void)l; (void)li;
        int tid_ = threadIdx.x, G_ = gridDim.x, bid_ = blockIdx.x; asm volatile("" : "+v"(tid_), "+s"(G_), "+s"(bid_));
        const int tid = tid_, lane = tid & 63, wid = __builtin_amdgcn_readfirstlane(tid >> 6), G = G_, bid = bid_, gw = bid * NWAVES + wid, NGW = G * NWAVES;
        const __attribute__((address_space(4))) Args* ap = (const __attribute__((address_space(4))) Args*)__builtin_amdgcn_kernarg_segment_ptr();
        asm volatile("" : "+s"(ap));
#define ARGIN(i) (ap->in[i])
        unsigned char* ws = ap->ws;
        float* out = ap->out;
        float* TAB = (float*)(ws + WS_SMALL); float* LAM = (float*)(ws + WS_SMALL + 16384);
        bf16* WIN = (bf16*)(ws + WS_WIN); bf16* WOUT = (bf16*)(ws + WS_WOUT); bf16* CIN = (bf16*)(ws + WS_CIN); bf16* COUT = (bf16*)(ws + WS_COUT);
        bf16* WQ = (bf16*)(ws + WS_WQ); bf16* WK = (bf16*)(ws + WS_WK); bf16* WV = (bf16*)(ws + WS_WV); bf16* WO = (bf16*)(ws + WS_WO); bf16* W1 = (bf16*)(ws + WS_W1); bf16* W2 = (bf16*)(ws + WS_W2);
        bf16* MEMN = (bf16*)(ws + WS_MEMN); bf16* KB = (bf16*)(ws + WS_KB); bf16* VT = (bf16*)(ws + WS_VT); float* SSQ = (float*)(ws + WS_SSQ);
        bf16* HB = (bf16*)(ws + WS_HB); bf16* MIX = (bf16*)(ws + WS_MIX); bf16* BIG = (bf16*)(ws + WS_BIG); bf16* ORAW = (bf16*)(ws + WS_ORAW);
#ifndef DIS_PRO
            LAS float* scr = (LAS float*)(L + wid * 16384);
            constexpr int NIT = 31232;
            struct TD { const float* W; const float* rs; bf16* WT; int ldn, Nc, ldk, ncs, item; float cs; };
#define TDESC(R, D) do { int r = (R); D.rs = nullptr; D.ldk = 1024; D.ncs = 0; D.cs = 1.f; \
                if (r < 2048) { const int i = r >> 10; D.W = ARGIN(I_ABWIN) + (size_t)i * 1024 * 2048; D.ldn = 2048; D.Nc = 2048; D.WT = WIN + (size_t)i * 2048 * 1024; D.rs = ARGIN(I_NMIXG) + (2 * i) * 1024; D.ncs = 512; D.cs = C2A; D.item = r & 1023; } \
                else if ((r -= 2048) < 512) { const int i = r >> 8; D.W = ARGIN(I_ABWOUT) + (size_t)i * 1024 * 1024; D.ldn = 1024; D.Nc = 1024; D.WT = WOUT + (size_t)i * 1024 * 1024; D.item = r & 255; } \
                else if ((r -= 512) < 3072) { const int i = r / 1536; D.W = ARGIN(I_CWIN) + (size_t)i * 1024 * 3072; D.ldn = 3072; D.Nc = 3072; D.WT = CIN + (size_t)i * 3072 * 1024; D.rs = ARGIN(I_NMIXG) + (2 * i + 1) * 1024; D.item = r % 1536; } \
                else if ((r -= 3072) < 1024) { const int i = r >> 9; D.W = ARGIN(I_CWOUT) + (size_t)i * 1024 * 1024; D.ldn = 1024; D.Nc = 1024; D.WT = COUT + (size_t)i * 1024 * 1024; D.item = r & 511; } \
                else if ((r -= 1024) < 2048) { const int i = r >> 9; D.W = ARGIN(I_WQ) + (size_t)i * 1024 * 1024; D.ldn = 1024; D.Nc = 1024; D.WT = WQ + (size_t)i * 1024 * 1024; D.rs = ARGIN(I_NXG) + i * 1024; D.ncs = 1024; D.cs = C2X; D.item = r & 511; } \
                else if ((r -= 2048) < 2048) { const int i = r >> 9; D.W = ARGIN(I_WKV) + (size_t)i * 1024 * 2048; D.ldn = 2048; D.Nc = 1024; D.WT = WK + (size_t)i * 1024 * 1024; D.item = r & 511; } \
                else if ((r -= 2048) < 2048) { const int i = r >> 9; D.W = ARGIN(I_WKV) + (size_t)i * 1024 * 2048 + 1024; D.ldn = 2048; D.Nc = 1024; D.WT = WV + (size_t)i * 1024 * 1024; D.item = r & 511; } \
                else if ((r -= 2048) < 2048) { const int i = r >> 9; D.W = ARGIN(I_WO) + (size_t)i * 1024 * 1024; D.ldn = 1024; D.Nc = 1024; D.WT = WO + (size_t)i * 1024 * 1024; D.item = r & 511; } \
                else if ((r -= 2048) < 8192) { const int i = r >> 11; D.W = ARGIN(I_W1) + (size_t)i * 1024 * 4096; D.ldn = 4096; D.Nc = 4096; D.WT = W1 + (size_t)i * 4096 * 1024; D.rs = ARGIN(I_NMLPG) + i * 1024; D.item = r & 2047; } \
                else { r -= 8192; const int i = r >> 11; D.W = ARGIN(I_W2) + (size_t)i * 4096 * 1024; D.ldn = 1024; D.Nc = 1024; D.WT = W2 + (size_t)i * 1024 * 4096; D.ldk = 4096; D.item = r & 2047; } } while (0)
#define TLOAD(D, V) do { const int nblk_ = D.Nc / 32, kb_ = D.item / nblk_, nb_ = D.item % nblk_; const float* wp_ = D.W + (size_t)(64 * kb_ + (lane >> 5)) * D.ldn + 32 * nb_ + (lane & 31); \
                _Pragma("unroll") for (int i = 0; i < 32; ++i) V[i] = wp_[(size_t)(2 * i) * D.ldn]; } while (0)
            { float tv[32]; TD d, dn; int it = gw; bool have = it < NIT;
              if (have) { TDESC(it, d); TLOAD(d, tv); }
              while (have) {
                const int itn = it + NGW; const bool hn = itn < NIT;
                const int nblk = d.Nc / 32, kb = d.item / nblk, nb = d.item % nblk, k0 = 64 * kb, n0 = 32 * nb;
                const float csl = (n0 + (lane & 31) < d.ncs) ? d.cs : 1.f;
#pragma unroll
                for (int i = 0; i < 32; ++i) { const int kk = 2 * i + (lane >> 5); float v = tv[i] * csl; if (d.rs) v *= d.rs[k0 + kk]; scr[kk * 33 + (lane & 31)] = v; }
                if (hn) { TDESC(itn, dn); TLOAD(dn, tv); }
                asm volatile("s_waitcnt lgkmcnt(0)" ::: "memory");
                const int c = lane & 7;
#pragma unroll
                for (int j = 0; j < 4; ++j) { const int n = (lane >> 3) + 8 * j; const LAS float* sp = scr + (8 * c) * 33 + n;
                    v4u o; o.x = pk2(sp[0 * 33], sp[1 * 33]); o.y = pk2(sp[2 * 33], sp[3 * 33]); o.z = pk2(sp[4 * 33], sp[5 * 33]); o.w = pk2(sp[6 * 33], sp[7 * 33]);
                    *(v4u*)(d.WT + (size_t)(n0 + n) * d.ldk + k0 + 8 * c) = o; }
                asm volatile("s_waitcnt lgkmcnt(0)" ::: "memory");
                d = dn; it = itn; have = hn;
              } }
#undef TDESC
#undef TLOAD
            for (int t = gw; t < 2 * 4 * 128 * 16; t += NGW) {
                const int nb = t & 15, c = (t >> 4) & 127, g = (t >> 11) & 3, i = t >> 13, n = nb * 64 + lane;
                const float* pw = ARGIN(I_POOLW) + ((size_t)(i * 4 + g) * 128 + c) * 128; const float* psc = ARGIN(I_POOLS) + i * 512 + g * 128;
                const float* wo = ARGIN(I_ABWOUT) + (size_t)i * 1024 * 1024 + (size_t)(512 + g * 128) * 1024 + n;
                float a = 0.f;
#pragma unroll 16
                for (int d = 0; d < 128; ++d) a += (pw[d] * psc[d]) * wo[(size_t)d * 1024];
                WOUT[(size_t)i * 1024 * 1024 + (size_t)n * 1024 + 512 + g * 128 + c] = (bf16)(pk2(a, 0.f) & 0xffffu);
            }
            for (int row = gw; row < 16 * NMEM; row += NGW) {
                const f32x4* xr = (const f32x4*)(ARGIN(I_MEM) + (size_t)row * DM) + lane; const f32x4* gr = (const f32x4*)(ARGIN(I_MEMG)) + lane;
                f32x4 v[4]; float s = 0.f;
#pragma unroll
                for (int j = 0; j < 4; ++j) { v[j] = xr[64 * j]; s += (v[j][0] * v[j][0] + v[j][1] * v[j][1]) + (v[j][2] * v[j][2] + v[j][3] * v[j][3]); }
                const float rstd = __builtin_amdgcn_rsqf(wave_sum(s) * (1.f / DM) + EPS);
                v2u* o8 = (v2u*)(MEMN + (size_t)row * DM) + lane;
#pragma unroll
                for (int j = 0; j < 4; ++j) { const f32x4 g4 = gr[64 * j]; v2u w; w.x = pk2(v[j][0] * rstd * g4[0], v[j][1] * rstd * g4[1]); w.y = pk2(v[j][2] * rstd * g4[2], v[j][3] * rstd * g4[3]); o8[64 * j] = w; }
            }
            for (int row = gw; row < M; row += 2 * NGW) {
                const int row1 = row + NGW;
                const f32x4* xr0 = (const f32x4*)(ARGIN(I_X) + (size_t)row * DM) + lane; const f32x4* xr1 = (const f32x4*)(ARGIN(I_X) + (size_t)row1 * DM) + lane;
                f32x4 v0[4], v1[4];
#pragma unroll
                for (int j = 0; j < 4; ++j) { v0[j] = xr0[64 * j]; v1[j] = xr1[64 * j]; }
                v2u* o80 = (v2u*)(HB + (size_t)row * DM) + lane; v2u* o81 = (v2u*)(HB + (size_t)row1 * DM) + lane;
                float s0 = 0.f, s1 = 0.f;
#pragma unroll
                for (int j = 0; j < 4; ++j) { s0 += (v0[j][0] * v0[j][0] + v0[j][1] * v0[j][1]) + (v0[j][2] * v0[j][2] + v0[j][3] * v0[j][3]); s1 += (v1[j][0] * v1[j][0] + v1[j][1] * v1[j][1]) + (v1[j][2] * v1[j][2] + v1[j][3] * v1[j][3]);
                    v2u w; w.x = pk2(v0[j][0], v0[j][1]); w.y = pk2(v0[j][2], v0[j][3]); o80[64 * j] = w; w.x = pk2(v1[j][0], v1[j][1]); w.y = pk2(v1[j][2], v1[j][3]); o81[64 * j] = w; }
                s0 = wave_sum(s0); s1 = wave_sum(s1);
                if (lane < 16) { SSQ[(size_t)row * 16 + lane] = (lane == 0) ? s0 : 0.f; SSQ[(size_t)row1 * 16 + lane] = (lane == 0) ? s1 : 0.f; }
            }
            for (int e = bid * 512 + tid; e < 4 * TABN; e += G * 512) {
                const int h = e / TABN, d = e % TABN - 256; float v;
                if (d < 0) v = -INFINITY;
                else { int bk; if (d < 16) bk = d; else { bk = 16 + (int)(__builtin_amdgcn_logf((float)d * 0.0625f) * (16.0f / 3.0f)); bk = bk < 31 ? bk : 31; }
                       v = (ARGIN(I_RELB)[bk * 4 + h] - ARGIN(I_RELB)[31 * 4 + h]) * LOG2E; }
                TAB[e] = v;
            }
            if (bid == 0 && tid < 2) {
                float a = 0.f, b = 0.f;
                for (int d = 0; d < 64; ++d) { a += ARGIN(I_LQ1)[tid * 64 + d] * ARGIN(I_LK1)[tid * 64 + d]; b += ARGIN(I_LQ2)[tid * 64 + d] * ARGIN(I_LK2)[tid * 64 + d]; }
                LAM[tid] = __builtin_amdgcn_exp2f(a * LOG2E) - __builtin_amdgcn_exp2f(b * LOG2E) + (tid == 0 ? LAMBDA_INIT0 : LAMBDA_INIT2);
            }
#endif
        ph0 = 1; if (ph0 < ph_hi) grid.sync();
#undef ARGIN
    }
    (void)xcd_barrier_post((unsigned*)args.ws, (volatile LAS unsigned*)(L + XB_ST_OFF));
    for (int ph = ph0; ph < ph_hi; ++ph) {
        int kind, l; decode_phase(ph, kind, l); const int li = l >> 1;
        int tid_ = threadIdx.x, G_ = gridDim.x, bid_ = blockIdx.x; asm volatile("" : "+v"(tid_), "+s"(G_), "+s"(bid_));
        const int tid = tid_, lane = tid & 63, wid = __builtin_amdgcn_readfirstlane(tid >> 6), G = G_, bid = bid_, gw = bid * NWAVES + wid, NGW = G * NWAVES;
        const __attribute__((address_space(4))) Args* ap = (const __attribute__((address_space(4))) Args*)__builtin_amdgcn_kernarg_segment_ptr();
        asm volatile("" : "+s"(ap));
#define ARGIN(i) (ap->in[i])
        unsigned char* ws = ap->ws;
        float* out = ap->out;
        float* TAB = (float*)(ws + WS_SMALL); float* LAM = (float*)(ws + WS_SMALL + 16384);
        bf16* WIN = (bf16*)(ws + WS_WIN); bf16* WOUT = (bf16*)(ws + WS_WOUT); bf16* CIN = (bf16*)(ws + WS_CIN); bf16* COUT = (bf16*)(ws + WS_COUT);
        bf16* WQ = (bf16*)(ws + WS_WQ); bf16* WK = (bf16*)(ws + WS_WK); bf16* WV = (bf16*)(ws + WS_WV); bf16* WO = (bf16*)(ws + WS_WO); bf16* W1 = (bf16*)(ws + WS_W1); bf16* W2 = (bf16*)(ws + WS_W2);
        bf16* MEMN = (bf16*)(ws + WS_MEMN); bf16* KB = (bf16*)(ws + WS_KB); bf16* VT = (bf16*)(ws + WS_VT); float* SSQ = (float*)(ws + WS_SSQ);
        bf16* HB = (bf16*)(ws + WS_HB); bf16* MIX = (bf16*)(ws + WS_MIX); bf16* BIG = (bf16*)(ws + WS_BIG); bf16* ORAW = (bf16*)(ws + WS_ORAW);
        if (kind == K_MIXPROJ || kind == K_XQ) {
            if (kind == K_MIXPROJ && l == 0) {
                for (int z = 0; z < 2; ++z) {
                    pg8::Gemm g{z == 0 ? MEMN : WV, z == 0 ? WK : MEMN, 4096, 4096, 1024}; pg8::StaticOrder S; S.init(4096, 4096, G, bid);
                    pg8::EpiProj<0, false> E{z == 0 ? KB : VT, 4096, nullptr, nullptr, 0};
#ifndef DIS_G0
                    pg8::gemm_phase<pg8::EpiProj<0, false>, pg8::StaticOrder, true, true>(L, g, S, E);
#endif
                }
            }
            const bf16* Bt; int N;
            if (kind == K_XQ) { Bt = WQ + (size_t)l * 1024 * 1024; N = 1024; }
            else if ((l & 1) == 0) { Bt = WIN + (size_t)li * 2048 * 1024; N = 2048; }
            else { Bt = CIN + (size_t)li * 3072 * 1024; N = 3072; }
            pg8::Gemm g{HB, Bt, M, N, 1024}; pg8::StaticOrder S; S.init(M, N, G, bid);
#define PG8_LAS __attribute__((address_space(3)))
            const PG8_LAS float* rsl = nullptr; int pm0 = 0;
            if (G == 256) {
                PG8_LAS float* rw = (PG8_LAS float*)(L + 131072); pg8::Unit u0, uu; S.next(0, u0); pm0 = u0.pm; int last = -1;
                for (int i = 0; S.next(i, uu); ++i) { const int slot = (uu.pm - pm0) >> 3; if (slot != last && slot >= 0 && slot < 8) { if (tid < 256) rw[slot * 256 + tid] = pg8::row_rstd(SSQ, uu.pm * 256 + tid); last = slot; } }
                asm volatile("s_waitcnt vmcnt(0) lgkmcnt(0)" ::: "memory"); __syncthreads(); rsl = rw;
            }
            pg8::EpiProj<0, true> E{BIG, N, SSQ, rsl, pm0};
#ifndef DIS_G1
            pg8::gemm_phase<pg8::EpiProj<0, true>, pg8::StaticOrder, true, true>(L, g, S, E);
#endif
            if (kind == K_XQ) {
                asm volatile("s_waitcnt vmcnt(0)" ::: "memory"); __syncthreads();
                pg8::Unit xu;
                for (int i = 0; S.next(i, xu); ++i) { const int tm = xu.pm, h = xu.pn, b = tm >> 4;
#ifndef DIS_XAT
                    xat::unit(L, BIG + (size_t)tm * 256 * 1024 + h * 256, KB + (size_t)b * 256 * 4096 + l * 1024 + h * 256, VT + (size_t)(l * 1024 + h * 256) * 4096 + b * 256, MIX + (size_t)tm * 256 * 1024 + h * 256);
#endif
                }
            }
        }
        else if (kind == K_UP) {
            pg8::Gemm g{HB, W1 + (size_t)l * 4096 * 1024, M, 4096, 1024}; pg8::StaticOrder S; S.init(M, 4096, G, bid);
            const PG8_LAS float* rsl = nullptr; int pm0 = 0;
            if (G == 256) {
                PG8_LAS float* rw = (PG8_LAS float*)(L + 131072); pg8::Unit u0, uu; S.next(0, u0); pm0 = u0.pm; int last = -1;
                for (int i = 0; S.next(i, uu); ++i) { const int slot = (uu.pm - pm0) >> 3; if (slot != last && slot >= 0 && slot < 8) { if (tid < 256) rw[slot * 256 + tid] = pg8::row_rstd(SSQ, uu.pm * 256 + tid); last = slot; } }
                asm volatile("s_waitcnt vmcnt(0) lgkmcnt(0)" ::: "memory"); __syncthreads(); rsl = rw;
            }
            pg8::EpiProj<1, true> E{BIG, 4096, SSQ, rsl, pm0};
#ifndef DIS_G2
            pg8::gemm_phase<pg8::EpiProj<1, true>, pg8::StaticOrder, true, true>(L, g, S, E);
#endif
        }
        else if (kind == K_MIXOUT || kind == K_XO || kind == K_DOWN) {
            const bf16* A; const bf16* Bt; int K = 1024;
            if (kind == K_MIXOUT) { A = MIX; Bt = ((l & 1) == 0 ? WOUT : COUT) + (size_t)li * 1024 * 1024; }
            else if (kind == K_XO) { A = MIX; Bt = WO + (size_t)l * 1024 * 1024; }
            else { A = BIG; Bt = W2 + (size_t)l * 1024 * 4096; K = 4096; }
            pg8::Gemm g{A, Bt, M, 1024, K}; pg8::StaticOrder S; S.init(M, 1024, G, bid);
            pg8::EpiResid E{HB, SSQ};
#ifndef DIS_G3
            pg8::gemm_phase<pg8::EpiResid, pg8::StaticOrder, true, true>(L, g, S, E);
#endif
        }
        else if (kind == K_ATTN) {
            const LAS float* tab = (const LAS float*)(L + TAB_OFF); int cur_h = -1;
            for (int item = bid; item < 256; item += G) {
                const int it2 = (item & 7) * 32 + (item >> 3), b = it2 >> 4, h = (it2 >> 2) & 3, sq = it2 & 3;
                if (h != cur_h) { __syncthreads(); { LAS float* tw = (LAS float*)(L + TAB_OFF); const float t0v = TAB[h * TABN + tid]; const float t1v = TAB[h * TABN + (tid < TABN - 512 ? tid + 512 : tid)]; tw[tid] = t0v; if (tid < TABN - 512) tw[tid + 512] = t1v; } cur_h = h; asm volatile("s_waitcnt vmcnt(0) lgkmcnt(0)" ::: "memory"); __syncthreads(); }
                for (int qi = 0; qi < 4; ++qi) {
                    const int qb = qi == 0 ? 15 - sq : qi == 1 ? 8 + sq : qi == 2 ? 7 - sq : sq;
                    for (int vh = 0; vh < 4; ++vh) { const int mp = vh >> 1, j = vh & 1;
#ifndef DIS_ATTN
                        attn_body::attn_unit<8>(b, qb, (const attn_body::bf16*)(BIG + h * 128 + mp * 64), (const attn_body::bf16*)(BIG + 512 + h * 128 + mp * 64), (const attn_body::bf16*)(BIG + 1024 + h * 128 + j * 64),
                                                (attn_body::bf16*)(ORAW + mp * 512 + h * 128 + j * 64), tab, (char*)lds);
#endif
                        asm volatile("s_waitcnt vmcnt(0)" ::: "memory");
                    }
                    __syncthreads();
                    { int lane_ = threadIdx.x & 63; asm volatile("" : "+v"(lane_));
                      const float lam = LAM[li], post = 1.0f - (li == 0 ? LAMBDA_INIT0 : LAMBDA_INIT2);
                      const f32x4* gp = (const f32x4*)(ARGIN(I_SUBLN) + li * 128 + (lane_ & 15) * 8); const f32x4 ga = gp[0], gb = gp[1];
                      const size_t rowbase = (size_t)b * SEQ + (size_t)qb * 256 + wid * 32 + (lane_ >> 4); const int cofs = h * 128 + (lane_ & 15) * 8;
                      v4u aa[8], cc[8];
#pragma unroll
                      for (int it = 0; it < 8; ++it) { const size_t row = rowbase + it * 4; aa[it] = *(const v4u*)(ORAW + row * 1024 + cofs); cc[it] = *(const v4u*)(ORAW + row * 1024 + 512 + cofs); }
#pragma unroll
                      for (int it = 0; it < 8; ++it) { const size_t row = rowbase + it * 4; const v4u a = aa[it], c = cc[it];
                        float v[8] = {bf_lo(a.x) - lam * bf_lo(c.x), bf_hi(a.x) - lam * bf_hi(c.x), bf_lo(a.y) - lam * bf_lo(c.y), bf_hi(a.y) - lam * bf_hi(c.y),
                                      bf_lo(a.z) - lam * bf_lo(c.z), bf_hi(a.z) - lam * bf_hi(c.z), bf_lo(a.w) - lam * bf_lo(c.w), bf_hi(a.w) - lam * bf_hi(c.w)};
                        float sv = 0.f;
#pragma unroll
                        for (int e = 0; e < 8; ++e) sv += v[e] * v[e];
                        sv += __shfl_xor(sv, 1); sv += __shfl_xor(sv, 2); sv += __shfl_xor(sv, 4); sv += __shfl_xor(sv, 8);
                        const float r = __builtin_amdgcn_rsqf(sv * (1.0f / 128.0f) + EPS) * post;
                        v4u o; o.x = pk2(v[0] * r * ga[0], v[1] * r * ga[1]); o.y = pk2(v[2] * r * ga[2], v[3] * r * ga[3]); o.z = pk2(v[4] * r * gb[0], v[5] * r * gb[1]); o.w = pk2(v[6] * r * gb[2], v[7] * r * gb[3]);
                        *(v4u*)(MIX + row * 1024 + cofs) = o; }
                    }
                }
            }
#ifndef DIS_POOL
            { const int w = 2 << (lane >> 4);
              for (int task = gw; task < M / 32; task += NGW) {
                const int row0 = task * 32, t0 = row0 & (SEQ - 1);
                const bf16* up = BIG + (size_t)row0 * 2048 + 1536 + lane * 8; bf16* op = MIX + (size_t)row0 * 1024 + 512 + lane * 8;
                float sum[8];
#pragma unroll
                for (int e = 0; e < 8; ++e) sum[e] = 0.f;
                if (t0 > 0) for (int jj = 1; jj <= w; ++jj) {   const v4u q = *(const v4u*)(up - (size_t)jj * 2048);
                    sum[0] += bf_lo(q.x); sum[1] += bf_hi(q.x); sum[2] += bf_lo(q.y); sum[3] += bf_hi(q.y); sum[4] += bf_lo(q.z); sum[5] += bf_hi(q.z); sum[6] += bf_lo(q.w); sum[7] += bf_hi(q.w); }
                for (int i0 = 0; i0 < 32; i0 += 4) {
                    v4u qq[4], oo[4];
#pragma unroll
                    for (int k = 0; k < 4; ++k) { qq[k] = *(const v4u*)(up + (size_t)(i0 + k) * 2048); oo[k] = *(const v4u*)(up + ((long)(i0 + k) - w) * 2048); }
#pragma unroll
                    for (int k = 0; k < 4; ++k) { const int i = i0 + k; const v4u q = qq[k], o = oo[k];
                    float cur[8] = {bf_lo(q.x), bf_hi(q.x), bf_lo(q.y), bf_hi(q.y), bf_lo(q.z), bf_hi(q.z), bf_lo(q.w), bf_hi(q.w)};
#pragma unroll
                    for (int e = 0; e < 8; ++e) sum[e] += cur[e];
                    const int t = t0 + i;
                    if (t - w >= 0) {
                        sum[0] -= bf_lo(o.x); sum[1] -= bf_hi(o.x); sum[2] -= bf_lo(o.y); sum[3] -= bf_hi(o.y); sum[4] -= bf_lo(o.z); sum[5] -= bf_hi(o.z); sum[6] -= bf_lo(o.w); sum[7] -= bf_hi(o.w); }
                    const float rc = 1.0f / (float)((t + 1) < w ? (t + 1) : w);
                    v4u r; r.x = pk2(sum[0] * rc - cur[0], sum[1] * rc - cur[1]); r.y = pk2(sum[2] * rc - cur[2], sum[3] * rc - cur[3]); r.z = pk2(sum[4] * rc - cur[4], sum[5] * rc - cur[5]); r.w = pk2(sum[6] * rc - cur[6], sum[7] * rc - cur[7]);
                    *(v4u*)(op + (size_t)i * 1024) = r; }
                }
              } }
#endif
        }
        else if (kind == K_CONV) {
#ifndef DIS_CONV
            for (int task = gw; task < (M / 32) * 2; task += NGW) {
                const int row0 = (task >> 1) * 32, t0 = row0 & (SEQ - 1), ch = (task & 1) * 512 + lane * 8;
                const float* cw = ARGIN(I_CW) + (size_t)li * 3 * 1024 + ch;
                float w0[8], w1[8], w2[8];
#pragma unroll
                for (int e = 0; e < 8; ++e) { w0[e] = cw[e]; w1[e] = cw[1024 + e]; w2[e] = cw[2048 + e]; }
                const bf16* pp = BIG + (size_t)row0 * 3072 + ch; bf16* op = MIX + (size_t)row0 * 1024 + ch;
                float z1[8], z2[8];
#pragma unroll
                for (int e = 0; e < 8; ++e) { z1[e] = 0.f; z2[e] = 0.f; }
                if (t0 > 0) {
                    const v4u c1 = *(const v4u*)(pp - 3072 + 1024), x1 = *(const v4u*)(pp - 3072 + 2048), c2 = *(const v4u*)(pp - 2 * 3072 + 1024), x2 = *(const v4u*)(pp - 2 * 3072 + 2048);
                    z1[0] = bf_lo(c1.x) * bf_lo(x1.x); z1[1] = bf_hi(c1.x) * bf_hi(x1.x); z1[2] = bf_lo(c1.y) * bf_lo(x1.y); z1[3] = bf_hi(c1.y) * bf_hi(x1.y);
                    z1[4] = bf_lo(c1.z) * bf_lo(x1.z); z1[5] = bf_hi(c1.z) * bf_hi(x1.z); z1[6] = bf_lo(c1.w) * bf_lo(x1.w); z1[7] = bf_hi(c1.w) * bf_hi(x1.w);
                    z2[0] = bf_lo(c2.x) * bf_lo(x2.x); z2[1] = bf_hi(c2.x) * bf_hi(x2.x); z2[2] = bf_lo(c2.y) * bf_lo(x2.y); z2[3] = bf_hi(c2.y) * bf_hi(x2.y);
                    z2[4] = bf_lo(c2.z) * bf_lo(x2.z); z2[5] = bf_hi(c2.z) * bf_hi(x2.z); z2[6] = bf_lo(c2.w) * bf_lo(x2.w); z2[7] = bf_hi(c2.w) * bf_hi(x2.w);
                }
                for (int i0 = 0; i0 < 32; i0 += 4) {
                    v4u bqq[4], cqq[4], xqq[4];
#pragma unroll
                    for (int k = 0; k < 4; ++k) { bqq[k] = *(const v4u*)(pp + (size_t)(i0 + k) * 3072); cqq[k] = *(const v4u*)(pp + (size_t)(i0 + k) * 3072 + 1024); xqq[k] = *(const v4u*)(pp + (size_t)(i0 + k) * 3072 + 2048); }
#pragma unroll
                    for (int k = 0; k < 4; ++k) { const int i = i0 + k; const v4u bq = bqq[k], cq = cqq[k], xq = xqq[k];
                    const float bb[8] = {bf_lo(bq.x), bf_hi(bq.x), bf_lo(bq.y), bf_hi(bq.y), bf_lo(bq.z), bf_hi(bq.z), bf_lo(bq.w), bf_hi(bq.w)};
                    const float z[8] = {bf_lo(cq.x) * bf_lo(xq.x), bf_hi(cq.x) * bf_hi(xq.x), bf_lo(cq.y) * bf_lo(xq.y), bf_hi(cq.y) * bf_hi(xq.y), bf_lo(cq.z) * bf_lo(xq.z), bf_hi(cq.z) * bf_hi(xq.z), bf_lo(cq.w) * bf_lo(xq.w), bf_hi(cq.w) * bf_hi(xq.w)};
                    float y[8];
#pragma unroll
                    for (int e = 0; e < 8; ++e) { y[e] = bb[e] * (z2[e] * w0[e] + z1[e] * w1[e] + z[e] * w2[e]); z2[e] = z1[e]; z1[e] = z[e]; }
                    v4u r; r.x = pk2(y[0], y[1]); r.y = pk2(y[2], y[3]); r.z = pk2(y[4], y[5]); r.w = pk2(y[6], y[7]);
                    *(v4u*)(op + (size_t)i * 1024) = r; }
                }
            }
#endif
        }
        else {
            const f32x4* gr = (const f32x4*)(ARGIN(I_FING) + lane * 8);
            const f32x4 g0 = gr[0], g1 = gr[1], g2 = gr[128], g3 = gr[129];
            for (int row0 = gw; row0 < M; row0 += 2 * NGW) {
                v4u h0[2], h1[2];
#pragma unroll
                for (int k = 0; k < 2; ++k) { const bf16* hp = HB + (size_t)(row0 + k * NGW) * DM + lane * 8; h0[k] = *(const v4u*)(hp); h1[k] = *(const v4u*)(hp + 512); }
#pragma unroll
                for (int k = 0; k < 2; ++k) { float* op = out + (size_t)(row0 + k * NGW) * DM + lane * 8;
                    const f32x4 a0 = {bf_lo(h0[k].x), bf_hi(h0[k].x), bf_lo(h0[k].y), bf_hi(h0[k].y)}, a1 = {bf_lo(h0[k].z), bf_hi(h0[k].z), bf_lo(h0[k].w), bf_hi(h0[k].w)};
                    const f32x4 a2 = {bf_lo(h1[k].x), bf_hi(h1[k].x), bf_lo(h1[k].y), bf_hi(h1[k].y)}, a3 = {bf_lo(h1[k].z), bf_hi(h1[k].z), bf_lo(h1[k].w), bf_hi(h1[k].w)};
                    float sq = ((a0[0] * a0[0] + a0[1] * a0[1]) + (a0[2] * a0[2] + a0[3] * a0[3])) + ((a1[0] * a1[0] + a1[1] * a1[1]) + (a1[2] * a1[2] + a1[3] * a1[3]))
                             + ((a2[0] * a2[0] + a2[1] * a2[1]) + (a2[2] * a2[2] + a2[3] * a2[3])) + ((a3[0] * a3[0] + a3[1] * a3[1]) + (a3[2] * a3[2] + a3[3] * a3[3]));
                    const float r = __builtin_amdgcn_rsqf(wave_sum(sq) * (1.f / DM) + EPS);
                    *(f32x4*)(op) = a0 * r * g0; *(f32x4*)(op + 4) = a1 * r * g1; *(f32x4*)(op + 512) = a2 * r * g2; *(f32x4*)(op + 516) = a3 * r * g3; }
            }
        }
        if (ph + 1 < ph_hi) { XcdBarrier xb_; xb_.bar = (unsigned*)ws; xb_.x = xb_xcc_id(); xb_.st = (volatile LAS unsigned*)(L + XB_ST_OFF); xcd_barrier(xb_); }
    }
}


#ifndef N_LAUNCH_MODE
#define N_LAUNCH_MODE 1
#endif
extern "C" void kernel_launch(void* const* d_in, const int* in_sizes, int n_in, void* d_out, int out_size, void* d_ws, size_t ws_size, hipStream_t stream) {
    static int grid = 0;
    if (grid == 0) {
        if (n_in != 25 || in_sizes[0] != M * DM || out_size != M * DM || ws_size < WS_END) { fprintf(stderr, "kernel_launch: unexpected shapes (n_in %d, in0 %d, out %d, ws %zu); nothing launched\n", n_in, n_in > 0 ? in_sizes[0] : -1, out_size, ws_size); grid = -1; return; }
        int dev = 0, cus = 0, per_cu = 0;
        hipGetDevice(&dev); hipDeviceGetAttribute(&cus, hipDeviceAttributeMultiprocessorCount, dev);
        if (hipFuncSetAttribute((const void*)trunk_fwd, hipFuncAttributeMaxDynamicSharedMemorySize, LDS_BYTES) != hipSuccess) { fprintf(stderr, "kernel_launch: hipFuncSetAttribute failed\n"); grid = -1; return; }
        if (hipOccupancyMaxActiveBlocksPerMultiprocessor(&per_cu, (const void*)trunk_fwd, NWAVES * 64, LDS_BYTES) != hipSuccess || per_cu < 1) { fprintf(stderr, "kernel_launch: occupancy query gave %d\n", per_cu); per_cu = 1; }
        (void)hipGetLastError();
        grid = cus;
    }
    if (grid < 0) return;
    Args a{};
    for (int i = 0; i < 25; ++i) a.in[i] = (const float*)d_in[i];
    a.out = (float*)d_out; a.ws = (unsigned char*)d_ws;
#if N_LAUNCH_MODE == 1
    a.lo = 0; a.hi = NPHASE;
    { void* kargs[] = {&a}; hipError_t e = hipLaunchCooperativeKernel((const void*)trunk_fwd, dim3(grid), dim3(NWAVES * 64), kargs, LDS_BYTES, stream);
      if (e != hipSuccess) fprintf(stderr, "cooperative launch failed: %s (grid %d)\n", hipGetErrorString(e), grid); }
#elif N_LAUNCH_MODE == 0
    for (int p = 0; p < NPHASE; ++p) { a.lo = p; a.hi = p + 1; void* kargs[] = {&a};
        hipError_t e = hipLaunchCooperativeKernel((const void*)trunk_fwd, dim3(grid), dim3(NWAVES * 64), kargs, LDS_BYTES, stream);
        if (e != hipSuccess) { fprintf(stderr, "launch %d failed: %s (grid %d)\n", p, hipGetErrorString(e), grid); break; } }
#endif
}
```

```cpp
#include <hip/hip_runtime.h>
#include <hip/hip_cooperative_groups.h>
#include <hip/hip_bf16.h>
#include <cstdio>
#include <cstdint>
#include <cmath>
namespace cg = cooperative_groups;
namespace pg8 {
#define PG8_LAS __attribute__((address_space(3)))
typedef unsigned short bf16_t;
typedef short bf16x8 __attribute__((ext_vector_type(8)));
typedef float f32x4 __attribute__((ext_vector_type(4)));
typedef unsigned u32x4 __attribute__((ext_vector_type(4)));
constexpr int BM = 256, BK = 64, HALF = 128, HTB = HALF * BK * 2  , STAGE_BYTES = 8 * HTB, NXCD = 8, WGM = 8;

__host__ __device__ __forceinline__ int lds_byte(int r, int c) { const int st = (r >> 4) * 2 + (c >> 5), rr = r & 15, cc = c & 31, ob = rr * 64 + cc * 2; return st * 1024 + (ob ^ (((ob >> 9) & 1) << 5)); }
__host__ __device__ __forceinline__ void stage_rc(int b, int& R, int& C) { const int st = b / 1024, sb = b % 1024, swz = sb ^ (((sb >> 9) & 1) << 5); R = (st >> 1) * 16 + swz / 64; C = (st & 1) * 32 + (swz % 64) / 2; }
__host__ __device__ __forceinline__ int perm32(int rho) { const int n = rho >> 4, i = rho & 15; return 8 * (i >> 2) + 4 * n + (i & 3); }

struct Unit { int pm, pn; };
struct Gemm { const bf16_t* A; const bf16_t* Bt; int M, N, K; };

struct StaticOrder {
    int nM, nN, nwg, G, c;
    __host__ __device__ void init(int M, int N, int G_, int c_) { nM = M / BM; nN = N / BM; nwg = nM * nN; G = G_; c = c_; }
    __host__ __device__ bool next(int i, Unit& u) const {
        const long L = (long)i * G + c; if (L >= nwg) return false;
        int wgid = (int)L; { const int q = nwg / NXCD, r = nwg % NXCD, xcd = wgid % NXCD, off = wgid / NXCD; wgid = (xcd < r ? xcd * (q + 1) : r * (q + 1) + (xcd - r) * q) + off; }
        const int nig = WGM * nN, gid = wgid / nig, fm = gid * WGM, gsz = (nM - fm) < WGM ? (nM - fm) : WGM;
        u.pm = fm + ((wgid % nig) % gsz); u.pn = (wgid % nig) / gsz; return true;
    }
    __device__ __forceinline__ void a_ready(const Unit&) const {}
    __device__ __forceinline__ void done(const Unit&) const {}
};

__device__ __forceinline__ unsigned cvt_pk_bf16(float lo, float hi) { unsigned r; asm volatile("v_cvt_pk_bf16_f32 %0, %1, %2" : "=v"(r) : "v"(lo), "v"(hi)); return r; }
typedef float f32x2 __attribute__((ext_vector_type(2)));
__device__ __forceinline__ float row_rstd(const float* ssq, int row) {
    const f32x4* p = (const f32x4*)(ssq + (size_t)row * 16);
    const f32x4 a = p[0], b = p[1], c = p[2], d = p[3];
    const float s = (((a[0] + a[1]) + (a[2] + a[3])) + ((b[0] + b[1]) + (b[2] + b[3]))) + (((c[0] + c[1]) + (c[2] + c[3])) + ((d[0] + d[1]) + (d[2] + d[3])));
    return __builtin_amdgcn_rsqf(s * (1.0f / 1024.0f) + 1e-6f);
}
template <int ACT  , bool SCALE> struct EpiProj {
    static constexpr bool PERM = true, AFTER_DRAIN = false;
    bf16_t* O; int ldc; const float* ssq; const PG8_LAS float* rsl; int pm0;
    __device__ __forceinline__ void operator()(const f32x4 (&acc)[2][2][4][2], const Unit& u, int wr, int wc, int fr, int fq) const {
        const int row0 = u.pm * BM + wr * 64 + fr, col0 = u.pn * BM + wc * 32 + 8 * fq;
#pragma unroll
        for (int ai = 0; ai < 2; ++ai)
#pragma unroll
            for (int m = 0; m < 4; ++m) { const int row = row0 + ai * HALF + m * 16; bf16_t* rowp = O + (size_t)row * ldc + col0;
                float sc = 1.f; if (SCALE) sc = rsl ? rsl[((u.pm - pm0) >> 3) * 256 + (row & 255)] : row_rstd(ssq, row);
#pragma unroll
                for (int bj = 0; bj < 2; ++bj) { f32x4 v0 = acc[ai][bj][m][0] * sc, v1 = acc[ai][bj][m][1] * sc;
                    if (ACT == 1) {
#pragma unroll
                        for (int j = 0; j < 4; ++j) { const float a = __builtin_fmaxf(v0[j], 0.f), b = __builtin_fmaxf(v1[j], 0.f); v0[j] = a * a; v1[j] = b * b; } }
                    u32x4 w; w.x = cvt_pk_bf16(v0[0], v0[1]); w.y = cvt_pk_bf16(v0[2], v0[3]); w.z = cvt_pk_bf16(v1[0], v1[1]); w.w = cvt_pk_bf16(v1[2], v1[3]);
                    __builtin_nontemporal_store(w, (u32x4*)(rowp + bj * HALF)); } }
    }
};
struct EpiResid {
    static constexpr bool PERM = true, AFTER_DRAIN = false;
    bf16_t* hb; float* ssq;
    __device__ __forceinline__ void operator()(const f32x4 (&acc)[2][2][4][2], const Unit& u, int wr, int wc, int fr, int fq) const {
        const int row0 = u.pm * BM + wr * 64 + fr, col0 = u.pn * BM + wc * 32 + 8 * fq;
        u32x4 hv[2][4][2];
#pragma unroll
        for (int ai = 0; ai < 2; ++ai)
#pragma unroll
            for (int m = 0; m < 4; ++m)
#pragma unroll
                for (int bj = 0; bj < 2; ++bj) hv[ai][m][bj] = *(const u32x4*)(hb + (size_t)(row0 + ai * HALF + m * 16) * 1024 + col0 + bj * HALF);
#pragma unroll
        for (int ai = 0; ai < 2; ++ai)
#pragma unroll
            for (int m = 0; m < 4; ++m) { const int row = row0 + ai * HALF + m * 16; float s = 0.f;
#pragma unroll
                for (int bj = 0; bj < 2; ++bj) { const size_t off = (size_t)row * 1024 + col0 + bj * HALF;
                    const u32x4 h4 = hv[ai][m][bj];
                    const f32x4 b0 = {__uint_as_float(h4.x << 16), __uint_as_float(h4.x & 0xffff0000u), __uint_as_float(h4.y << 16), __uint_as_float(h4.y & 0xffff0000u)};
                    const f32x4 b1 = {__uint_as_float(h4.z << 16), __uint_as_float(h4.z & 0xffff0000u), __uint_as_float(h4.w << 16), __uint_as_float(h4.w & 0xffff0000u)};
                    const f32x4 v0 = acc[ai][bj][m][0] + b0, v1 = acc[ai][bj][m][1] + b1;
                    u32x4 w; w.x = cvt_pk_bf16(v0[0], v0[1]); w.y = cvt_pk_bf16(v0[2], v0[3]); w.z = cvt_pk_bf16(v1[0], v1[1]); w.w = cvt_pk_bf16(v1[2], v1[3]);
                    *(u32x4*)(hb + off) = w;
                    s += ((v0[0] * v0[0] + v0[1] * v0[1]) + (v0[2] * v0[2] + v0[3] * v0[3])) + ((v1[0] * v1[0] + v1[1] * v1[1]) + (v1[2] * v1[2] + v1[3] * v1[3])); }
                s += __shfl_xor(s, 16); s += __shfl_xor(s, 32);
                if (fq == 0) ssq[(size_t)row * 16 + u.pn * 4 + wc] = s; }
    }
};
template <class Epi, class Sched, bool ALIGN_EPI = false, bool SP2 = false>
__device__ __forceinline__ void gemm_phase(PG8_LAS unsigned char* lds, const Gemm g, const Sched& S, const Epi& E) {
    int tid_ = threadIdx.x; asm volatile("" : "+v"(tid_));
    const int tid = tid_, wid = __builtin_amdgcn_readfirstlane(tid >> 6), lane = tid & 63, wr = wid >> 2, wc = wid & 3, fr = lane & 15, fq = lane >> 4;
    const int K = g.K, nt = K / BK;
    unsigned voffA[2], voffB[2];
#pragma unroll
    for (int i = 0; i < 2; ++i) { int R, C; stage_rc(tid * 16 + i * 8192, R, C); const int Rb = Epi::PERM ? ((R & ~31) + perm32(R & 31)) : R;
        voffA[i] = (unsigned)(R * K + C) * 2u; voffB[i] = (unsigned)(Rb * K + C) * 2u; }
    const size_t kstep = (size_t)(BK * 2);
    const size_t hstep = (size_t)HALF * K * 2;
    const size_t tstep = 2 * hstep;
    const unsigned ldsw = (unsigned)wid * 1024u;
    const int aoff = lds_byte(wr * 64 + fr, fq * 8), boff = lds_byte(wc * 32 + fr, fq * 8);
#define PG8_SA(b, h) (((b) * 2 + (h)) * HTB)
#define PG8_SB(b, h) ((4 + (b) * 2 + (h)) * HTB)
#define PG8_STAGE(bufoff, gbase, voff) do { _Pragma("unroll") for (int _i = 0; _i < 2; ++_i) \
        __builtin_amdgcn_global_load_lds((const unsigned*)((const char*)(gbase) + (voff)[_i]), (PG8_LAS unsigned*)(lds + (bufoff) + ldsw + _i * 8192), 16, 0, 0); } while (0)
#define PG8_LDA(dst, b, h) do { _Pragma("unroll") for (int m = 0; m < 4; ++m) _Pragma("unroll") for (int k = 0; k < 2; ++k) dst[m][k] = *(const PG8_LAS bf16x8*)(lds + PG8_SA(b, h) + aoff + m * 2048 + k * 1024); } while (0)
#define PG8_LDB(dst, b, h) do { _Pragma("unroll") for (int n = 0; n < 2; ++n) _Pragma("unroll") for (int k = 0; k < 2; ++k) dst[n][k] = *(const PG8_LAS bf16x8*)(lds + PG8_SB(b, h) + boff + n * 2048 + k * 1024); } while (0)
#define PG8_MMA(ai, bj, At, Bt) do { __builtin_amdgcn_s_setprio(1); _Pragma("unroll") for (int m = 0; m < 4; ++m) _Pragma("unroll") for (int n = 0; n < 2; ++n) _Pragma("unroll") for (int k = 0; k < 2; ++k) \
        acc[ai][bj][m][n] = __builtin_amdgcn_mfma_f32_16x16x32_bf16(Bt[n][k], At[m][k], acc[ai][bj][m][n], 0, 0, 0); __builtin_amdgcn_s_setprio(0); } while (0)
#define PG8_WAIT_V(n) asm volatile("s_waitcnt vmcnt(" #n ")" ::: "memory")
#define PG8_WAIT_L(n) asm volatile("s_waitcnt lgkmcnt(" #n ")" ::: "memory")
#define PG8_BAR __builtin_amdgcn_s_barrier()
#define PG8_SCHED __builtin_amdgcn_sched_barrier(0)
    Unit cur, nxt; int ui = 0;
    if (!S.next(0, cur)) return;
    f32x4 acc[2][2][4][2];
#pragma unroll
    for (int a = 0; a < 2; ++a)
#pragma unroll
        for (int b = 0; b < 2; ++b)
#pragma unroll
            for (int m = 0; m < 4; ++m)
#pragma unroll
                for (int n = 0; n < 2; ++n) acc[a][b][m][n] = (f32x4){0.f, 0.f, 0.f, 0.f};
    bf16x8 At[4][2], B0[2][2], B1[2][2];
    const char* cA = (const char*)g.A + (size_t)cur.pm * tstep; const char* cB = (const char*)g.Bt + (size_t)cur.pn * tstep;
    S.a_ready(cur);
    if constexpr (SP2) {
        PG8_STAGE(PG8_SB(0, 0), cB, voffB); PG8_STAGE(PG8_SB(0, 1), cB + hstep, voffB); PG8_STAGE(PG8_SA(0, 0), cA, voffA); PG8_STAGE(PG8_SA(0, 1), cA + hstep, voffA);
        if (wr == 1) PG8_BAR;
        PG8_WAIT_V(2); PG8_BAR;
        PG8_STAGE(PG8_SB(1, 0), cB + kstep, voffB); PG8_STAGE(PG8_SA(1, 0), cA + kstep, voffA); PG8_STAGE(PG8_SB(1, 1), cB + hstep + kstep, voffB);
        PG8_WAIT_V(6); PG8_BAR;
    } else {
        PG8_STAGE(PG8_SB(0, 0), cB, voffB); PG8_STAGE(PG8_SA(0, 0), cA, voffA); PG8_STAGE(PG8_SB(0, 1), cB + hstep, voffB); PG8_STAGE(PG8_SA(0, 1), cA + hstep, voffA);
        if (wr == 1) PG8_BAR;
        PG8_WAIT_V(4); PG8_BAR;
        PG8_STAGE(PG8_SB(1, 0), cB + kstep, voffB); PG8_STAGE(PG8_SA(1, 0), cA + kstep, voffA); PG8_STAGE(PG8_SB(1, 1), cB + hstep + kstep, voffB);
        PG8_WAIT_V(6); PG8_BAR;
    }
    for (;;) {
        const bool has_next = S.next(ui + 1, nxt);
        const char* nA = has_next ? (const char*)g.A + (size_t)nxt.pm * tstep : cA; const char* nB = has_next ? (const char*)g.Bt + (size_t)nxt.pn * tstep : cB;
        for (int t = 0; t < nt; t += 2) {
            const bool last = (t == nt - 2);
            const char* a1 = cA + (size_t)(t + 1) * kstep;
            const char* a2 = last ? nA : cA + (size_t)(t + 2) * kstep; const char* b2 = last ? nB : cB + (size_t)(t + 2) * kstep;
            const char* a3 = a2 + kstep; const char* b3 = b2 + kstep;
            if (last && has_next) S.a_ready(nxt);
            if constexpr (SP2) {
            PG8_LDB(B0, 0, 0); PG8_LDB(B1, 0, 1); PG8_SCHED; PG8_LDA(At, 0, 0); PG8_STAGE(PG8_SA(1, 1), a1 + hstep, voffA);
            PG8_WAIT_V(8); PG8_WAIT_L(0); PG8_BAR; PG8_MMA(0, 0, At, B0); PG8_MMA(0, 1, At, B1); PG8_BAR; PG8_SCHED;
            PG8_LDA(At, 0, 1); PG8_STAGE(PG8_SB(0, 0), b2, voffB); PG8_STAGE(PG8_SB(0, 1), b2 + hstep, voffB); PG8_STAGE(PG8_SA(0, 0), a2, voffA);
            PG8_WAIT_V(8); PG8_WAIT_L(0); PG8_BAR; PG8_MMA(1, 0, At, B0); PG8_MMA(1, 1, At, B1); PG8_BAR; PG8_SCHED;
            PG8_LDB(B0, 1, 0); PG8_LDB(B1, 1, 1); PG8_SCHED; PG8_LDA(At, 1, 0); PG8_STAGE(PG8_SA(0, 1), a2 + hstep, voffA);
            PG8_WAIT_V(8); PG8_WAIT_L(0); PG8_BAR; PG8_MMA(0, 0, At, B0); PG8_MMA(0, 1, At, B1); PG8_BAR; PG8_SCHED;
            PG8_LDA(At, 1, 1); PG8_STAGE(PG8_SB(1, 0), b3, voffB); PG8_STAGE(PG8_SB(1, 1), b3 + hstep, voffB); PG8_STAGE(PG8_SA(1, 0), a3, voffA);
            PG8_WAIT_V(8); PG8_WAIT_L(0); PG8_BAR; PG8_MMA(1, 0, At, B0); PG8_MMA(1, 1, At, B1); PG8_BAR; PG8_SCHED;
            } else {
            PG8_LDB(B0, 0, 0); PG8_SCHED; PG8_LDA(At, 0, 0); PG8_STAGE(PG8_SA(1, 1), a1 + hstep, voffA);
            PG8_WAIT_L(8); PG8_BAR; PG8_WAIT_L(0); PG8_MMA(0, 0, At, B0); PG8_BAR; PG8_SCHED;
            PG8_LDB(B1, 0, 1); PG8_STAGE(PG8_SB(0, 0), b2, voffB);
            PG8_BAR; PG8_WAIT_L(0); PG8_MMA(0, 1, At, B1); PG8_BAR;
            PG8_LDA(At, 0, 1); PG8_STAGE(PG8_SA(0, 0), a2, voffA);
            PG8_BAR; PG8_WAIT_L(0); PG8_MMA(1, 0, At, B0); PG8_BAR; PG8_SCHED;
            PG8_STAGE(PG8_SB(0, 1), b2 + hstep, voffB);
            PG8_WAIT_V(6); PG8_BAR; PG8_MMA(1, 1, At, B1); PG8_BAR;
            PG8_LDB(B0, 1, 0); PG8_SCHED; PG8_LDA(At, 1, 0); PG8_STAGE(PG8_SA(0, 1), a2 + hstep, voffA);
            PG8_WAIT_L(8); PG8_BAR; PG8_WAIT_L(0); PG8_MMA(0, 0, At, B0); PG8_BAR; PG8_SCHED;
            PG8_LDB(B1, 1, 1); PG8_STAGE(PG8_SB(1, 0), b3, voffB);
            PG8_BAR; PG8_WAIT_L(0); PG8_MMA(0, 1, At, B1); PG8_BAR;
            PG8_LDA(At, 1, 1); PG8_STAGE(PG8_SA(1, 0), a3, voffA);
            PG8_BAR; PG8_WAIT_L(0); PG8_MMA(1, 0, At, B0); PG8_BAR; PG8_SCHED;
            PG8_STAGE(PG8_SB(1, 1), b3 + hstep, voffB);
            PG8_WAIT_V(6); PG8_BAR; PG8_MMA(1, 1, At, B1); PG8_BAR;
            }
        }
        if constexpr (ALIGN_EPI) { if (wr == 0) PG8_BAR; }
        if constexpr (!Epi::AFTER_DRAIN) { E(acc, cur, wr, wc, fr, fq); S.done(cur); }
        if (!has_next) break;
#pragma unroll
        for (int a = 0; a < 2; ++a)
#pragma unroll
            for (int b = 0; b < 2; ++b)
#pragma unroll
                for (int m = 0; m < 4; ++m)
#pragma unroll
                    for (int n = 0; n < 2; ++n) acc[a][b][m][n] = (f32x4){0.f, 0.f, 0.f, 0.f};
        cur = nxt; cA = nA; cB = nB; ++ui;
        if constexpr (ALIGN_EPI) { if (wr == 1) PG8_BAR; }
    }
    PG8_WAIT_V(0);
    if constexpr (!ALIGN_EPI) { if (wr == 0) PG8_BAR; }
    PG8_BAR;
    if constexpr (Epi::AFTER_DRAIN) { E.fused(acc, cur, wr, wc, fr, fq, lds, wid, lane); S.done(cur); }
#undef PG8_SA
#undef PG8_SB
#undef PG8_STAGE
#undef PG8_LDA
#undef PG8_LDB
#undef PG8_MMA
#undef PG8_WAIT_V
#undef PG8_WAIT_L
#undef PG8_BAR
#undef PG8_SCHED
}
}
#include <hip/hip_bf16.h>
#include <cmath>
namespace attn_body {
using bf16=__hip_bfloat16;
using bf16x8=__attribute__((ext_vector_type(8)))short;
using s16x4=__attribute__((ext_vector_type(4)))short;
using f32x16=__attribute__((ext_vector_type(16)))float;
using u32x4=__attribute__((ext_vector_type(4)))unsigned;
constexpr int BATCH=16,SEQ=4096,D=64,PQ=2048,PO=1024;
constexpr int NW=8,QBLK=32,QB=QBLK*NW,KVBLK=64,NQB=SEQ/QB;
constexpr int ATTN_UNIT_ROWS=QB;
__device__ __forceinline__ int crow(int r,int hi){return (r&3)+8*(r>>2)+4*hi;}
#define SBAR() __builtin_amdgcn_sched_barrier(0)
__device__ __forceinline__ void cmask(f32x16&p0,f32x16&p1,int jb,int qrel,int hi,const __attribute__((address_space(3))) float*tab){
  asm volatile("s_nop 15\n\ts_nop 7":"+v"(p0),"+v"(p1));
  const __attribute__((address_space(3))) float*tp=tab+(qrel-64*jb-4*hi+256);
  #pragma unroll
  for(int r=0;r<16;++r){const int o=(r&3)+8*(r>>2); float a0=tp[-o], a1=tp[-o-32]; asm volatile("v_add_f32_e32 %0, %1, %0":"+v"(p0[r]):"v"(a0)); asm volatile("v_add_f32_e32 %0, %1, %0":"+v"(p1[r]):"v"(a1));}
}

constexpr int NSLOT=3, SLOTB=8192;
constexpr int LDS_K=0, LDS_V=NSLOT*SLOTB, LDS_WS=2*NSLOT*SLOTB, LDS_TAB=LDS_WS+NW*64*4, LDS_OST=LDS_TAB+3072, LDS_BYTES=LDS_OST+NW*4096;
constexpr float C2=0.125f*1.4426950408889634f;
__device__ __forceinline__ void glds16(const void*gsrc,unsigned lds_dst){unsigned keep;
  asm volatile("s_mov_b32 %0, m0\n\ts_mov_b32 m0, %2\n\ts_nop 0\n\tglobal_load_lds_dwordx4 %1, off\n\ts_mov_b32 m0, %0":"=&s"(keep):"v"(gsrc),"s"(lds_dst):"memory");}
__device__ __forceinline__ float max3f(float a,float b,float c){float r;asm("v_max3_f32 %0, %1, %2, %3":"=v"(r):"v"(a),"v"(b),"v"(c));return r;}
__device__ __forceinline__ float max2f(float a,float b){float r;asm("v_max_f32_e32 %0, %1, %2":"=v"(r):"v"(a),"v"(b));return r;}
__device__ __forceinline__ float fadd_s(float a,float b){float r;asm("v_add_f32_e32 %0, %1, %2":"=v"(r):"v"(a),"v"(b));return r;}
__device__ __forceinline__ float fsub_s(float a,float b){float r;asm("v_sub_f32_e32 %0, %1, %2":"=v"(r):"v"(a),"v"(b));return r;}
typedef float f32x2_t __attribute__((ext_vector_type(2))); typedef __bf16 bf16x2_t __attribute__((ext_vector_type(2)));
__device__ __forceinline__ unsigned cvtpk_s(float lo,float hi){f32x2_t v={lo,hi};bf16x2_t b=__builtin_convertvector(v,bf16x2_t);return __builtin_bit_cast(unsigned,b);}
#define WAIT_BAR(N) asm volatile("s_waitcnt vmcnt(" #N ") lgkmcnt(0)\n\ts_barrier":::"memory")

__device__ __forceinline__ void qkt(f32x16&p0,f32x16&p1,const char*Kslot,const bf16x8*qr,const f32x16&negm,int r32,int hi){
  const char*kb=Kslot+hi*1024+r32*16;
  #pragma unroll
  for(int d0=0;d0<4;++d0){
    const bf16x8 b0=*reinterpret_cast<const bf16x8*>(kb+d0*2048);
    const bf16x8 b1=*reinterpret_cast<const bf16x8*>(kb+d0*2048+512);
    if(d0==0){p0=__builtin_amdgcn_mfma_f32_32x32x16_bf16(b0,qr[0],negm,0,0,0);p1=__builtin_amdgcn_mfma_f32_32x32x16_bf16(b1,qr[0],negm,0,0,0);}
    else{p0=__builtin_amdgcn_mfma_f32_32x32x16_bf16(b0,qr[d0],p0,0,0,0);p1=__builtin_amdgcn_mfma_f32_32x32x16_bf16(b1,qr[d0],p1,0,0,0);}}
}
typedef __attribute__((address_space(3))) const char* lds_cptr;
typedef short v4i16_t __attribute__((ext_vector_type(4)));
__device__ __forceinline__ void kload8(bf16x8*kf,lds_cptr kp){
  kf[0]=*(const __attribute__((address_space(3))) bf16x8*)(kp);      kf[1]=*(const __attribute__((address_space(3))) bf16x8*)(kp+512);
  kf[2]=*(const __attribute__((address_space(3))) bf16x8*)(kp+2048); kf[3]=*(const __attribute__((address_space(3))) bf16x8*)(kp+2560);
  kf[4]=*(const __attribute__((address_space(3))) bf16x8*)(kp+4096); kf[5]=*(const __attribute__((address_space(3))) bf16x8*)(kp+4608);
  kf[6]=*(const __attribute__((address_space(3))) bf16x8*)(kp+6144); kf[7]=*(const __attribute__((address_space(3))) bf16x8*)(kp+6656);
}
__device__ __forceinline__ void kload2(bf16x8*kf,lds_cptr kp,int j){ kf[2*j]=*(const __attribute__((address_space(3))) bf16x8*)(kp+j*2048); kf[2*j+1]=*(const __attribute__((address_space(3))) bf16x8*)(kp+j*2048+512); }
__device__ __forceinline__ s16x4 vtr(lds_cptr p){ return __builtin_bit_cast(s16x4,__builtin_amdgcn_ds_read_tr16_b64_v4i16((__attribute__((address_space(3))) v4i16_t*)p)); }
__device__ __forceinline__ float rowmax(const f32x16&p0,const f32x16&p1){
  float a=max3f(p0[0],p0[1],p1[0]),b=max3f(p0[2],p0[3],p1[1]);a=max3f(a,p1[2],p1[3]);
  #pragma unroll
  for(int r=4;r<16;r+=4){a=max3f(a,p0[r],p0[r+1]);b=max3f(b,p0[r+2],p0[r+3]);a=max3f(a,p1[r],p1[r+1]);b=max3f(b,p1[r+2],p1[r+3]);}
  const float m=max2f(a,b);
  auto rr=__builtin_amdgcn_permlane32_swap(__float_as_uint(m),__float_as_uint(m),false,false);
  return max2f(__uint_as_float(rr[0]),__uint_as_float(rr[1]));
}
__device__ __forceinline__ void pv(f32x16*o,int vb,bf16x8 pa0,bf16x8 pa1,bf16x8 pa2,bf16x8 pa3){
  #pragma unroll
  for(int d0=0;d0<2;++d0){s16x4 lo[4],hi[4];
    #pragma unroll
    for(int ks=0;ks<4;++ks){
      asm volatile("ds_read_b64_tr_b16 %0,%1 offset:%c2":"=&v"(lo[ks]):"v"(vb),"i"(d0*4096+ks*1024):"memory");
      asm volatile("ds_read_b64_tr_b16 %0,%1 offset:%c2":"=&v"(hi[ks]):"v"(vb),"i"(d0*4096+ks*1024+512):"memory");}
    asm volatile("s_waitcnt lgkmcnt(0)":::"memory");SBAR();
    #define PK(k) (bf16x8){lo[k][0],lo[k][1],lo[k][2],lo[k][3],hi[k][0],hi[k][1],hi[k][2],hi[k][3]}
    o[d0]=__builtin_amdgcn_mfma_f32_32x32x16_bf16(pa0,PK(0),o[d0],0,0,0);
    o[d0]=__builtin_amdgcn_mfma_f32_32x32x16_bf16(pa1,PK(1),o[d0],0,0,0);
    o[d0]=__builtin_amdgcn_mfma_f32_32x32x16_bf16(pa2,PK(2),o[d0],0,0,0);
    o[d0]=__builtin_amdgcn_mfma_f32_32x32x16_bf16(pa3,PK(3),o[d0],0,0,0);
    #undef PK
  }
}

#ifndef ATTN_STORE16
#define ATTN_STORE16(p,v) (*(u32x4*)(p)=(v))
#endif
template<int THRL> __device__ __forceinline__ void attn_unit(int b,int qb,const bf16*Q,const bf16*__restrict__ K,const bf16*__restrict__ V,bf16*O,const __attribute__((address_space(3))) float*tab,char*shm){
  int tid_=threadIdx.x; asm volatile("":"+v"(tid_)); const int tid=tid_,lane=tid&63,r32=lane&31,hi=lane>>5; const int wid=__builtin_amdgcn_readfirstlane(tid>>6);
  const long rowbase=(long)b*SEQ; const int q0=qb*QB;
  const bf16*Qw=Q+(rowbase+q0+wid*QBLK)*PQ;
  const bf16*Kh=K+rowbase*PQ,*Vh=V+rowbase*PQ;
  const unsigned lds0=(unsigned)(uintptr_t)shm;
  float*wsf=(float*)(shm+LDS_WS)+wid*64;
  const bf16*ksrc=Kh+(long)lane*PQ+wid*8;
  const bf16*vsrc=Vh+(long)(16*(wid&3)+(lane>>2))*PQ+(wid>>2)*32+(lane&3)*8;
  const unsigned kdst=lds0+LDS_K+wid*1024, vdst=lds0+LDS_V+wid*1024;
  #define DMA_K(t,slot) glds16(ksrc+(long)(t)*KVBLK*PQ,(unsigned)__builtin_amdgcn_readfirstlane(kdst+(slot)))
  #define DMA_V(t,slot) glds16(vsrc+(long)(t)*KVBLK*PQ,(unsigned)__builtin_amdgcn_readfirstlane(vdst+(slot)))
  const int vb0=(int)(lds0+LDS_V)+((lane>>4)&1)*32+(lane&3)*8+(4*hi+((lane&15)>>2))*64;
  const char*Kbase=shm+LDS_K; bf16x8 kf[8];
  const lds_cptr shm3=(lds_cptr)shm; const lds_cptr kp0=shm3+LDS_K+hi*1024+r32*16; const lds_cptr vp0=shm3+LDS_V+((lane>>4)&1)*32+(lane&3)*8+(4*hi+((lane&15)>>2))*64;
  const int NT=(q0+QB)/KVBLK;
  DMA_K(0,0);DMA_V(0,0);DMA_K(1,SLOTB);
  bf16x8 qr[4];
  #pragma unroll
  for(int d0=0;d0<4;++d0)qr[d0]=*reinterpret_cast<const bf16x8*>(&Qw[(long)r32*PQ+d0*16+hi*8]);
  float mhat=0.f,l_reg=0.f;f32x16 o[2];o[0]=f32x16{};o[1]=f32x16{};f32x16 negm=f32x16{};asm volatile("":"+v"(negm));
  const int qrel=wid*QBLK+r32;
  #define CMASK(P0,P1,t) do{int jb_=(t)-(NT-4); if(jb_>=-2)cmask(P0,P1,jb_,qrel,hi,tab);}while(0)
  bool resc=false;
  #define START(P0,P1) do{ const float rm=rowmax(P0,P1); resc=false; \
    { const float dl=rm; mhat=fadd_s(mhat,dl); \
      _Pragma("unroll") for(int r=0;r<16;++r){P0[r]=fsub_s(P0[r],dl);P1[r]=fsub_s(P1[r],dl);} \
      _Pragma("unroll") for(int r=0;r<16;++r)negm[r]=-mhat; asm volatile("":"+v"(negm)); } \
    _Pragma("unroll") for(int r=0;r<16;++r)P0[r]=__builtin_amdgcn_exp2f(P0[r]); }while(0)
  #define RESC() do{ if(resc){ asm volatile("s_waitcnt lgkmcnt(0)":::"memory"); \
      _Pragma("unroll") for(int d_=0;d_<2;++d_) _Pragma("unroll") for(int r=0;r<16;++r)o[d_][r]*=wsf[crow(r,hi)]; } }while(0)
  f32x16 pA0,pA1,pB0,pB1;
  int sl_prev=0,sl_cur=0,sl_next=SLOTB;
  #define ROT() do{sl_prev=sl_cur;sl_cur=sl_next;sl_next=(sl_next==(NSLOT-1)*SLOTB)?0:sl_next+SLOTB;}while(0)
  DMA_K(2,2*SLOTB);
  WAIT_BAR(3);
  qkt(pA0,pA1,Kbase,qr,negm,r32,hi);asm volatile("s_nop 15\n\ts_nop 7":"+v"(pA0),"+v"(pA1));CMASK(pA0,pA1,0);
  START(pA0,pA1);
  _Pragma("unroll") for(int r=0;r<16;++r)pA1[r]=__builtin_amdgcn_exp2f(pA1[r]);
  WAIT_BAR(0);
  DMA_K(3,0);DMA_V(1,SLOTB);
  ROT();
  kload8(kf,kp0+sl_cur);
  WAIT_BAR(2);
  s16x4 vlo[8],vhi[8]; u32x4 pw0,pw1,pw2,pw3;
  #define PKW(P,B) cvtpk_s(P[B],P[B+1])
  #define PAF(k) __builtin_bit_cast(bf16x8,pw##k)
  #define VFR(i) (bf16x8){vlo[i][0],vlo[i][1],vlo[i][2],vlo[i][3],vhi[i][0],vhi[i][1],vhi[i][2],vhi[i][3]}
  #define PIN(x) asm volatile("":"+v"(x))
  #define MX3(a,b,c) __builtin_fmaxf(__builtin_fmaxf((a),(b)),(c))
  #define GAPA(MF,A0,A1,A2,A3,W0,W1,PW) do{ MF; sacc+=A0; sacc+=A1; sacc+=A2; sacc+=A3; PIN(sacc); W0; W1; PIN(PW); SBAR(); }while(0)
  #define EX(v) __builtin_amdgcn_exp2f(v)
  #define GAPB(MF,X,B) do{ MF; X[B]=EX(X[B]); X[B+1]=EX(X[B+1]); X[B+2]=EX(X[B+2]); X[B+3]=EX(X[B+3]); PIN(X); SBAR(); }while(0)
  #define VRD(i) do{ vlo[i]=vtr(vp_+(((i)>>2)*4096+((i)&3)*1024)); vhi[i]=vtr(vp_+(((i)>>2)*4096+((i)&3)*1024+512)); }while(0)
  #define KRD(G,j) do{ if(G){ kload2(kf,kp0+sl_next,j); SBAR(); } }while(0)
  #define STEP(C0,C1,P0,P1,t,GK,GV,GL) do{ SBAR(); \
    const lds_cptr vp_=vp0+sl_prev; \
    VRD(0); SBAR(); float sacc=(P0[0]+P0[1]); \
    GAPA(C0=__builtin_amdgcn_mfma_f32_32x32x16_bf16(kf[0],qr[0],negm,0,0,0), P0[2],P0[3],P0[4],P0[5],     pw0[0]=PKW(P0,0), pw0[1]=PKW(P0,2), pw0); \
    VRD(4); SBAR(); GAPA(C1=__builtin_amdgcn_mfma_f32_32x32x16_bf16(kf[1],qr[0],negm,0,0,0), P0[6],P0[7],P0[8],P0[9],     pw0[2]=PKW(P0,4), pw0[3]=PKW(P0,6), pw0); \
    VRD(1); SBAR(); GAPA(C0=__builtin_amdgcn_mfma_f32_32x32x16_bf16(kf[2],qr[1],C0,0,0,0),   P0[10],P0[11],P0[12],P0[13], pw1[0]=PKW(P0,8), pw1[1]=PKW(P0,10), pw1); \
    VRD(5); SBAR(); GAPA(C1=__builtin_amdgcn_mfma_f32_32x32x16_bf16(kf[3],qr[1],C1,0,0,0),   P0[14],P0[15],P1[0],P1[1],   pw1[2]=PKW(P0,12),pw1[3]=PKW(P0,14), pw1); \
    VRD(2); SBAR(); GAPA(C0=__builtin_amdgcn_mfma_f32_32x32x16_bf16(kf[4],qr[2],C0,0,0,0),   P1[2],P1[3],P1[4],P1[5],     pw2[0]=PKW(P1,0), pw2[1]=PKW(P1,2), pw2); \
    VRD(6); SBAR(); GAPA(C1=__builtin_amdgcn_mfma_f32_32x32x16_bf16(kf[5],qr[2],C1,0,0,0),   P1[6],P1[7],P1[8],P1[9],     pw2[2]=PKW(P1,4), pw2[3]=PKW(P1,6), pw2); \
    VRD(3); SBAR(); GAPA(C0=__builtin_amdgcn_mfma_f32_32x32x16_bf16(kf[6],qr[3],C0,0,0,0),   P1[10],P1[11],P1[12],P1[13], pw3[0]=PKW(P1,8), pw3[1]=PKW(P1,10), pw3); \
    VRD(7); SBAR(); GAPA(C1=__builtin_amdgcn_mfma_f32_32x32x16_bf16(kf[7],qr[3],C1,0,0,0),   P1[14],P1[15],0.f,0.f,       pw3[2]=PKW(P1,12),pw3[3]=PKW(P1,14), pw3); \
    l_reg+=sacc; \
    if(GK){DMA_K((t)+3,sl_cur);} if(GV){DMA_V((t)+1,sl_next);} \
    CMASK(C0,C1,t); \
    { float a=MX3(C0[0],C0[1],C1[0]),b=MX3(C0[2],C0[3],C1[1]); a=MX3(a,C1[2],C1[3]); \
      _Pragma("unroll") for(int r=4;r<16;r+=4){a=MX3(a,C0[r],C0[r+1]);b=MX3(b,C0[r+2],C0[r+3]);a=MX3(a,C1[r],C1[r+1]);b=MX3(b,C1[r+2],C1[r+3]);} \
      float rm=__builtin_fmaxf(a,b); { auto rr=__builtin_amdgcn_permlane32_swap(__float_as_uint(rm),__float_as_uint(rm),false,false); rm=__builtin_fmaxf(__uint_as_float(rr[0]),__uint_as_float(rr[1])); } \
      resc=false; \
      if(__builtin_expect(__any(rm>(float)THRL),0)){ const float dl=__builtin_fmaxf(rm,0.f); mhat+=dl; \
        _Pragma("unroll") for(int r=0;r<16;++r){C0[r]-=dl;C1[r]-=dl;} \
        _Pragma("unroll") for(int r=0;r<16;++r)negm[r]=-mhat; asm volatile("":"+v"(negm)); \
        const float f=__builtin_amdgcn_exp2f(-dl); l_reg*=f; if(hi==0)wsf[r32]=f; resc=true; } } \
    SBAR(); \
    GAPB(o[0]=__builtin_amdgcn_mfma_f32_32x32x16_bf16(PAF(0),VFR(0),o[0],0,0,0), C0,0); \
    GAPB(o[1]=__builtin_amdgcn_mfma_f32_32x32x16_bf16(PAF(0),VFR(4),o[1],0,0,0), C0,4); \
    KRD(GL,0); GAPB(o[0]=__builtin_amdgcn_mfma_f32_32x32x16_bf16(PAF(1),VFR(1),o[0],0,0,0), C0,8); \
    KRD(GL,1); GAPB(o[1]=__builtin_amdgcn_mfma_f32_32x32x16_bf16(PAF(1),VFR(5),o[1],0,0,0), C0,12); \
    KRD(GL,2); GAPB(o[0]=__builtin_amdgcn_mfma_f32_32x32x16_bf16(PAF(2),VFR(2),o[0],0,0,0), C1,0); \
    KRD(GL,3); GAPB(o[1]=__builtin_amdgcn_mfma_f32_32x32x16_bf16(PAF(2),VFR(6),o[1],0,0,0), C1,4); \
    GAPB(o[0]=__builtin_amdgcn_mfma_f32_32x32x16_bf16(PAF(3),VFR(3),o[0],0,0,0), C1,8); \
    GAPB(o[1]=__builtin_amdgcn_mfma_f32_32x32x16_bf16(PAF(3),VFR(7),o[1],0,0,0), C1,12); \
    }while(0)
  int t=1;
  #undef CMASK
  #define CMASK(P0,P1,t) do{}while(0)
  for(;t+7<NT;t+=2){
    STEP(pB0,pB1,pA0,pA1,t,true,true,true);     WAIT_BAR(2); RESC(); ROT();
    STEP(pA0,pA1,pB0,pB1,t+1,true,true,true);   WAIT_BAR(2); RESC(); ROT();
  }
  #undef CMASK
  #define CMASK(P0,P1,t) do{int jb_=(t)-(NT-4); if(jb_>=-2)cmask(P0,P1,jb_,qrel,hi,tab);}while(0)
  #define ENDW(tt) do{ if((tt)+3<NT){WAIT_BAR(2);} else if((tt)+2<NT){WAIT_BAR(1);} else {WAIT_BAR(0);} }while(0)
  for(;t+1<NT;t+=2){
    STEP(pB0,pB1,pA0,pA1,t,(t+3<NT),(t+1<NT),(t+1<NT));       ENDW(t);   RESC(); ROT();
    STEP(pA0,pA1,pB0,pB1,t+1,(t+4<NT),(t+2<NT),(t+2<NT));     ENDW(t+1); RESC(); ROT();
  }
  STEP(pB0,pB1,pA0,pA1,NT-1,false,false,false); RESC();
  { float sacc=pB0[0]+pB0[1]; _Pragma("unroll") for(int r=2;r<16;++r)sacc+=pB0[r]; _Pragma("unroll") for(int r=0;r<16;++r)sacc+=pB1[r]; l_reg+=sacc;
    pw0=(u32x4){PKW(pB0,0),PKW(pB0,2),PKW(pB0,4),PKW(pB0,6)};pw1=(u32x4){PKW(pB0,8),PKW(pB0,10),PKW(pB0,12),PKW(pB0,14)};pw2=(u32x4){PKW(pB1,0),PKW(pB1,2),PKW(pB1,4),PKW(pB1,6)};pw3=(u32x4){PKW(pB1,8),PKW(pB1,10),PKW(pB1,12),PKW(pB1,14)};
    SBAR(); pv(o,vb0+sl_cur,PAF(0),PAF(1),PAF(2),PAF(3)); }
  #undef PKW
  #undef PAF
  #undef VFR
  #undef PIN
  #undef MX3
  #undef GAPA
  #undef GAPB
  #undef EX
  #undef VRD
  #undef KRD
  #undef STEP
  #undef ENDW
  {auto rr=__builtin_amdgcn_permlane32_swap(__float_as_uint(l_reg),__float_as_uint(l_reg),false,false);l_reg=__uint_as_float(rr[0])+__uint_as_float(rr[1]);}
  if(hi==0)wsf[32+r32]=l_reg;asm volatile("s_waitcnt lgkmcnt(0)":::"memory");
  float rli[16];
  #pragma unroll
  for(int r=0;r<16;++r)rli[r]=__builtin_amdgcn_rcpf(wsf[32+crow(r,hi)]);
  bf16*Ow=O+(rowbase+q0+wid*QBLK)*PO;
  { bf16*stg=(bf16*)(shm+LDS_OST)+wid*2048;
    #pragma unroll
    for(int r=0;r<16;++r){const int orow=crow(r,hi);
      #pragma unroll
      for(int d0=0;d0<2;++d0)stg[orow*64+d0*32+r32]=__float2bfloat16(o[d0][r]*rli[r]);}
    asm volatile("s_waitcnt lgkmcnt(0)":::"memory");
    #pragma unroll
    for(int i=0;i<4;++i){const int row=i*8+(lane>>3),ch=lane&7; const u32x4 v=*(const u32x4*)(stg+row*64+ch*8); ATTN_STORE16(Ow+(long)row*PO+ch*8,v);} }
  asm volatile("s_waitcnt lgkmcnt(0)\n\ts_barrier":::"memory");
  #undef DMA_K
  #undef DMA_V
  #undef CMASK
  #undef START
  #undef RESC
  #undef ROT
}
constexpr int ATTN_LDS_BYTES=LDS_BYTES;
#undef SBAR
#undef WAIT_BAR
}
namespace xat {
#define XLAS __attribute__((address_space(3)))
typedef unsigned short bf16_t;
typedef short bf16x8 __attribute__((ext_vector_type(8)));
typedef float f32x16 __attribute__((ext_vector_type(16)));
typedef unsigned u32x4 __attribute__((ext_vector_type(4)));
typedef unsigned u32x2 __attribute__((ext_vector_type(2)));
typedef float f32x2_t __attribute__((ext_vector_type(2))); typedef __bf16 bf16x2_t __attribute__((ext_vector_type(2)));
__device__ __forceinline__ unsigned cvtpk(float lo, float hi) { f32x2_t v = {lo, hi}; bf16x2_t b = __builtin_convertvector(v, bf16x2_t); return __builtin_bit_cast(unsigned, b); }
constexpr int KP = 528, CHB = 32 * KP, XS_OFF = 34816, XS_BYTES = 8704, LDS_BYTES = XS_OFF + 8 * XS_BYTES;
__device__ __forceinline__ void unit(XLAS unsigned char* lds, const bf16_t* Qg, const bf16_t* Kg, const bf16_t* Vg, bf16_t* Og) {
    int tid_ = threadIdx.x; asm volatile("" : "+v"(tid_)); const int tid = tid_, lane = tid & 63, r32 = lane & 31, hi = lane >> 5; const int wid = __builtin_amdgcn_readfirstlane(tid >> 6);
    const int sr = tid >> 4, sseg = tid & 15;
    const bf16_t* kgp = Kg + (size_t)sr * 4096 + sseg * 16;
    const bf16_t* vgp = Vg + (size_t)sr * 4096 + sseg * 16;
    const unsigned wofs = (unsigned)(sr * KP + sseg * 32);
#define XAT_SRC(c) ((c) < 8 ? kgp + (size_t)(c) * 32 * 4096 : vgp + (size_t)((c) - 8) * 32 * 4096)
    u32x4 g[2][2];
    g[0][0] = *(const u32x4*)(XAT_SRC(0)); g[0][1] = *(const u32x4*)(XAT_SRC(0) + 8); g[1][0] = *(const u32x4*)(XAT_SRC(1)); g[1][1] = *(const u32x4*)(XAT_SRC(1) + 8);
    XLAS unsigned char* xs = lds + XS_OFF + wid * XS_BYTES;
    bf16x8 qf[16];
#pragma unroll
    for (int hq = 0; hq < 2; ++hq) {
        const bf16_t* qbase = Qg + (size_t)(wid * 32 + (lane >> 4)) * 1024 + hq * 128 + (lane & 15) * 8;
        u32x4 qv[8];
#pragma unroll
        for (int i = 0; i < 8; ++i) qv[i] = *(const u32x4*)(qbase + (size_t)(4 * i) * 1024);
#pragma unroll
        for (int i = 0; i < 8; ++i) *(XLAS u32x4*)(xs + (4 * i + (lane >> 4)) * 272 + (lane & 15) * 16) = qv[i];
#pragma unroll
        for (int s = 0; s < 8; ++s) qf[hq * 8 + s] = *(const XLAS bf16x8*)(xs + r32 * 272 + s * 32 + hi * 16);
    }
    const int krow = (r32 & 0x13) | ((r32 & 4) << 1) | ((r32 & 8) >> 1);
    const unsigned kro = (unsigned)(krow * KP + hi * 16), vro = (unsigned)(r32 * KP + hi * 16);
    f32x16 S[8];
#pragma unroll
    for (int c = 0; c < 8; ++c) {
        XLAS unsigned char* buf = lds + (c & 1) * CHB;
        *(XLAS u32x4*)(buf + wofs) = g[c & 1][0]; *(XLAS u32x4*)(buf + wofs + 16) = g[c & 1][1];
        __syncthreads();
        { g[c & 1][0] = *(const u32x4*)(XAT_SRC(c + 2)); g[c & 1][1] = *(const u32x4*)(XAT_SRC(c + 2) + 8); }
        f32x16 a = {};
        bf16x8 kfa[4], kfb[4];
#pragma unroll
        for (int j = 0; j < 4; ++j) kfa[j] = *(const XLAS bf16x8*)(buf + kro + j * 32);
#pragma unroll
        for (int gq = 0; gq < 4; gq += 2) {
#pragma unroll
            for (int j = 0; j < 4; ++j) kfb[j] = *(const XLAS bf16x8*)(buf + kro + (4 * gq + 4 + j) * 32);
            __builtin_amdgcn_sched_barrier(0);
#pragma unroll
            for (int j = 0; j < 4; ++j) a = __builtin_amdgcn_mfma_f32_32x32x16_bf16(kfa[j], qf[4 * gq + j], a, 0, 0, 0);
            if (gq < 2) {
#pragma unroll
                for (int j = 0; j < 4; ++j) kfa[j] = *(const XLAS bf16x8*)(buf + kro + (4 * gq + 8 + j) * 32); }
            __builtin_amdgcn_sched_barrier(0);
#pragma unroll
            for (int j = 0; j < 4; ++j) a = __builtin_amdgcn_mfma_f32_32x32x16_bf16(kfb[j], qf[4 * gq + 4 + j], a, 0, 0, 0);
        }
        S[c] = a;
    }
    float mx = S[0][0];
#pragma unroll
    for (int c = 0; c < 8; ++c)
#pragma unroll
        for (int r = 0; r < 16; ++r) mx = __builtin_fmaxf(mx, S[c][r]);
    mx = __builtin_fmaxf(mx, __shfl_xor(mx, 32));
    float l = 0.f;
    u32x4 pw[8][2];
#pragma unroll
    for (int c = 0; c < 8; ++c) {
        f32x16 p;
#pragma unroll
        for (int r = 0; r < 16; ++r) { p[r] = __builtin_amdgcn_exp2f(S[c][r] - mx); l += p[r]; }
#pragma unroll
        for (int s = 0; s < 2; ++s) { pw[c][s].x = cvtpk(p[8 * s + 0], p[8 * s + 1]); pw[c][s].y = cvtpk(p[8 * s + 2], p[8 * s + 3]); pw[c][s].z = cvtpk(p[8 * s + 4], p[8 * s + 5]); pw[c][s].w = cvtpk(p[8 * s + 6], p[8 * s + 7]); }
    }
    l += __shfl_xor(l, 32);
    const float rl = 1.0f / l;
    bf16_t* obase = Og + (size_t)(wid * 32 + (lane >> 3)) * 1024 + (lane & 7) * 8;
#pragma unroll
    for (int db = 0; db < 8; ++db) {
        XLAS unsigned char* buf = lds + (db & 1) * CHB;
        *(XLAS u32x4*)(buf + wofs) = g[db & 1][0]; *(XLAS u32x4*)(buf + wofs + 16) = g[db & 1][1];
        __syncthreads();
        if (db < 6) { g[db & 1][0] = *(const u32x4*)(XAT_SRC(db + 10)); g[db & 1][1] = *(const u32x4*)(XAT_SRC(db + 10) + 8); }
        f32x16 o = {};
#pragma unroll
        for (int kb = 0; kb < 8; ++kb)
#pragma unroll
            for (int s = 0; s < 2; ++s) { const bf16x8 vf = *(const XLAS bf16x8*)(buf + vro + kb * 64 + s * 32); o = __builtin_amdgcn_mfma_f32_32x32x16_bf16(vf, __builtin_bit_cast(bf16x8, pw[kb][s]), o, 0, 0, 0); }
#pragma unroll
        for (int g4 = 0; g4 < 4; ++g4) { u32x2 w; w.x = cvtpk(o[4 * g4] * rl, o[4 * g4 + 1] * rl); w.y = cvtpk(o[4 * g4 + 2] * rl, o[4 * g4 + 3] * rl);
            *(XLAS u32x2*)(xs + r32 * 144 + ((db & 1) * 32 + 8 * g4 + 4 * hi) * 2) = w; }
        if (db & 1) {
#pragma unroll
            for (int i = 0; i < 4; ++i) { const u32x4 v = *(const XLAS u32x4*)(xs + (8 * i + (lane >> 3)) * 144 + (lane & 7) * 16); *(u32x4*)(obase + (size_t)(8 * i) * 1024 + (db >> 1) * 64) = v; }
        }
    }
}
#undef XAT_SRC
}
#define GAS __attribute__((address_space(1)))
#define LAS __attribute__((address_space(3)))
typedef unsigned short bf16;
typedef unsigned v4u __attribute__((ext_vector_type(4)));
typedef unsigned v2u __attribute__((ext_vector_type(2)));
typedef float f32x4 __attribute__((ext_vector_type(4)));
constexpr int NWAVES = 8;
constexpr int M = 65536, SEQ = 4096, DM = 1024, NMEM = 256, DEPTH = 4;
constexpr float LOG2E = 1.4426950408889634f;
constexpr float C2A = 0.125f * LOG2E;
constexpr float C2X = 0.0625f * LOG2E;
constexpr float LAMBDA_INIT0 = 0.2f, LAMBDA_INIT2 = 0.47071301834f;
constexpr float EPS = 1e-6f;
constexpr size_t MiB = 1u << 20;
constexpr size_t WS_SMALL = 1 * MiB;
constexpr size_t WS_WIN = 2 * MiB, WS_WOUT = 10 * MiB, WS_CIN = 14 * MiB, WS_COUT = 26 * MiB, WS_WQ = 30 * MiB, WS_WK = 38 * MiB, WS_WV = 46 * MiB, WS_WO = 54 * MiB, WS_W1 = 62 * MiB, WS_W2 = 94 * MiB;
constexpr size_t WS_MEMN = 126 * MiB, WS_KB = 134 * MiB, WS_VT = 166 * MiB, WS_SSQ = 198 * MiB, WS_HB = 202 * MiB, WS_MIX = 330 * MiB, WS_BIG = 458 * MiB, WS_ORAW = WS_BIG + 384 * MiB, WS_END = 970 * MiB;
constexpr int TABN = 704;
constexpr int LDS_BYTES = 147456, TAB_OFF = attn_body::LDS_TAB;
static_assert(attn_body::ATTN_LDS_BYTES <= 131072 && TABN * 4 <= 3072 && xat::LDS_BYTES <= 131072, "LDS map");

__device__ __forceinline__ float bf_lo(unsigned w) { return __uint_as_float(w << 16); }
__device__ __forceinline__ float bf_hi(unsigned w) { return __uint_as_float(w & 0xffff0000u); }
__device__ __forceinline__ unsigned pk2(float lo, float hi) { return pg8::cvt_pk_bf16(lo, hi); }
__device__ __forceinline__ float wave_sum(float v) {
#pragma unroll
    for (int o = 1; o < 64; o <<= 1) v += __shfl_xor(v, o);
    return v;
}
__device__ __forceinline__ void transpose_item(const float* W, int ldn, int Nc, bf16* WT, int ldk, int row_off, const float* rs, int ncs, float cs, LAS float* scr, int item, int lane) {
    const int nblk = Nc / 32, kb = item / nblk, nb = item % nblk, k0 = 64 * kb, n0 = 32 * nb;
    const float csl = (n0 + (lane & 31) < ncs) ? cs : 1.f;
#pragma unroll 8
    for (int i = 0; i < 32; ++i) { const int kk = 2 * i + (lane >> 5); float v = W[(size_t)(k0 + kk) * ldn + n0 + (lane & 31)] * csl; if (rs) v *= rs[k0 + kk]; scr[kk * 33 + (lane & 31)] = v; }
    asm volatile("s_waitcnt lgkmcnt(0)" ::: "memory");
    const int c = lane & 7;
#pragma unroll
    for (int j = 0; j < 4; ++j) { const int n = (lane >> 3) + 8 * j; const LAS float* s = scr + (8 * c) * 33 + n;
        v4u o; o.x = pk2(s[0 * 33], s[1 * 33]); o.y = pk2(s[2 * 33], s[3 * 33]); o.z = pk2(s[4 * 33], s[5 * 33]); o.w = pk2(s[6 * 33], s[7 * 33]);
        *(v4u*)(WT + (size_t)(row_off + n0 + n) * ldk + k0 + 8 * c) = o; }
    asm volatile("s_waitcnt lgkmcnt(0)" ::: "memory");
}
struct Args { const float* in[25]; float* out; unsigned char* ws; int lo, hi; };
enum { I_X = 0, I_MEM, I_RELB, I_MEMG, I_NMIXG, I_NXG, I_NMLPG, I_FING, I_ABWIN, I_ABWOUT, I_LQ1, I_LK1, I_LQ2, I_LK2, I_SUBLN, I_POOLW, I_POOLS, I_CWIN, I_CW, I_CWOUT, I_WQ, I_WKV, I_WO, I_W1, I_W2 };
enum { K_PRO = 0, K_MIXPROJ, K_ATTN, K_COMBINE, K_CONV, K_MIXOUT, K_XQ, K_XATTN, K_XO, K_UP, K_DOWN, K_FINAL };
constexpr int NPHASE = 30;
__host__ __device__ inline void decode_phase(int ph, int& kind, int& l) {
    if (ph == 0) { kind = K_PRO; l = 0; return; }
    if (ph == NPHASE - 1) { kind = K_FINAL; l = 0; return; }
    const int p0 = ph - 1; l = p0 / 7; const int p = p0 - 7 * l;
    kind = p == 0 ? K_MIXPROJ : p == 1 ? ((l & 1) == 0 ? K_ATTN : K_CONV) : p == 2 ? K_MIXOUT : p == 3 ? K_XQ : p == 4 ? K_XO : p == 5 ? K_UP : K_DOWN;
}

#define XB_TMO      128
#define XB_XCNT(j)  (256  + 64 * (j))
#define XB_XSUB(j)  (1280 + 64 * (j))
#define XB_XGEN(j)  (2304 + 64 * (j))
#define XB_TOP      3328
#define XB_TOPGEN   3392
#define XCD_BAR_WORDS 3456
#define XB_SPIN_CAP (1u << 22)

__device__ __forceinline__ unsigned xb_ld(unsigned* p)              { return __hip_atomic_load(p, __ATOMIC_RELAXED, __HIP_MEMORY_SCOPE_AGENT); }
__device__ __forceinline__ unsigned xb_add(unsigned* p, unsigned v) { return __hip_atomic_fetch_add(p, v, __ATOMIC_RELAXED, __HIP_MEMORY_SCOPE_AGENT); }
__device__ __forceinline__ unsigned xb_xcc_id() { return (unsigned)__builtin_amdgcn_s_getreg((3 << 11) | 20) & 0xFu; }
#define XB_SPIN(cond, bar) do { unsigned _sp = 0; while (cond) { __builtin_amdgcn_s_sleep(1); \
    if ((++_sp & 255u) == 0u) { if (xb_ld(&(bar)[XB_TMO])) break; if (_sp > XB_SPIN_CAP) { atomicAdd(&(bar)[XB_TMO], 1u); break; } } } } while (0)

struct XcdBarrier {
    unsigned* bar; unsigned x;
    volatile LAS unsigned* st;
};

__device__ __forceinline__ XcdBarrier xcd_barrier_post(unsigned* bar, volatile LAS unsigned* st) {
    XcdBarrier b; b.bar = bar; b.x = xb_xcc_id(); b.st = st;
    if (threadIdx.x == 0) (void)xb_add(&bar[XB_XCNT(b.x)], 1u);
    return b;
}
__device__ __forceinline__ void xcd_barrier_complete(unsigned* bar, unsigned x, unsigned& nloc, unsigned& nx) {
    const unsigned G = gridDim.x * gridDim.y * gridDim.z;
    unsigned sum, cnt, mine, sp = 0u;
    for (;;) {
        sum = 0u; cnt = 0u; mine = 0u;
#pragma unroll
        for (unsigned j = 0; j < 16; ++j) { const unsigned c = xb_ld(&bar[XB_XCNT(j)]); sum += c; cnt += (c > 0u) ? 1u : 0u; mine = (j == x) ? c : mine; }
        if (sum == G) break;
        __builtin_amdgcn_s_sleep(1);
        if ((++sp & 255u) == 0u) { if (xb_ld(&bar[XB_TMO])) break; if (sp > XB_SPIN_CAP) { atomicAdd(&bar[XB_TMO], 1u); break; } }
    }
    nloc = mine > 0u ? mine : 1u; nx = cnt > 0u ? cnt : 1u;
}

__device__ __forceinline__ void xcd_barrier(const XcdBarrier& b) {
    asm volatile("s_waitcnt vmcnt(0)" ::: "memory");
    __syncthreads();
    if (threadIdx.x == 0) {
        unsigned* bar = b.bar;
        __builtin_amdgcn_s_waitcnt(0);
        unsigned nloc = b.st[0], nx = b.st[1];
        if (nloc == 0u) { xcd_barrier_complete(bar, b.x, nloc, nx); b.st[0] = nloc; b.st[1] = nx; }
        const unsigned old = xb_add(&bar[XB_XSUB(b.x)], 1u);
        const unsigned gen = old / nloc;
        if (old + 1u == (gen + 1u) * nloc) {
            __builtin_amdgcn_fence(__ATOMIC_RELEASE, "agent");
            asm volatile("s_waitcnt vmcnt(0)" ::: "memory");
            const unsigned og = xb_add(&bar[XB_TOP], 1u);
            const unsigned tg = og / nx;
            if (og + 1u == (tg + 1u) * nx) xb_add(&bar[XB_TOPGEN], 1u);
            else XB_SPIN(xb_ld(&bar[XB_TOPGEN]) == tg, bar);
            __builtin_amdgcn_fence(__ATOMIC_ACQUIRE, "agent");
            xb_add(&bar[XB_XGEN(b.x)], 1u);
            asm volatile("s_waitcnt vmcnt(0)" ::: "memory");
        } else {
            XB_SPIN(xb_ld(&bar[XB_XGEN(b.x)]) == gen, bar);
            __builtin_amdgcn_fence(__ATOMIC_ACQUIRE, "agent");
            asm volatile("s_waitcnt vmcnt(0)" ::: "memory");
        }
    }
    __syncthreads();
}

constexpr int XB_ST_OFF = LDS_BYTES - 64;
__global__ void __launch_bounds__(NWAVES * 64, 2) trunk_fwd(Args args) {
    extern __shared__ __attribute__((aligned(16))) unsigned char lds[];
    cg::grid_group grid = cg::this_grid();
    LAS unsigned char* L = (LAS unsigned char*)lds;
    if (threadIdx.x == 0) { ((volatile LAS unsigned*)(L + XB_ST_OFF))[0] = 0u; ((volatile LAS unsigned*)(L + XB_ST_OFF))[1] = 0u; }
    __syncthreads();
    if (blockIdx.x == 0) for (int i = threadIdx.x; i < XCD_BAR_WORDS; i += NWAVES * 64) ((unsigned*)args.ws)[i] = 0u;
    const int ph_hi = args.hi; int ph0 = args.lo;
    if (ph0 == 0) {
        const int l = 0, li = 0; (void)l; (void)li;
        int tid_ = threadIdx.x, G_ = gridDim.x, bid_ = blockIdx.x; asm volatile("" : "+v"(tid_), "+s"(G_), "+s"(bid_));
        const int tid = tid_, lane = tid & 63, wid = __builtin_amdgcn_readfirstlane(tid >> 6), G = G_, bid = bid_, gw = bid * NWAVES + wid, NGW = G * NWAVES;
        const __attribute__((address_space(4))) Args* ap = (const __attribute__((address_space(4))) Args*)__builtin_amdgcn_kernarg_segment_ptr();
        asm volatile("" : "+s"(ap));
#define ARGIN(i) (ap->in[i])
        unsigned char* ws = ap->ws;
        float* out = ap->out;
        float* TAB = (float*)(ws + WS_SMALL); float* LAM = (float*)(ws + WS_SMALL + 16384);
        bf16* WIN = (bf16*)(ws + WS_WIN); bf16* WOUT = (bf16*)(ws + WS_WOUT); bf16* CIN = (bf16*)(ws + WS_CIN); bf16* COUT = (bf16*)(ws + WS_COUT);
        bf16* WQ = (bf16*)(ws + WS_WQ); bf16* WK = (bf16*)(ws + WS_WK); bf16* WV = (bf16*)(ws + WS_WV); bf16* WO = (bf16*)(ws + WS_WO); bf16* W1 = (bf16*)(ws + WS_W1); bf16* W2 = (bf16*)(ws + WS_W2);
        bf16* MEMN = (bf16*)(ws + WS_MEMN); bf16* KB = (bf16*)(ws + WS_KB); bf16* VT = (bf16*)(ws + WS_VT); float* SSQ = (float*)(ws + WS_SSQ);
        bf16* HB = (bf16*)(ws + WS_HB); bf16* MIX = (bf16*)(ws + WS_MIX); bf16* BIG = (bf16*)(ws + WS_BIG); bf16* ORAW = (bf16*)(ws + WS_ORAW);
#ifndef DIS_PRO
            LAS float* scr = (LAS float*)(L + wid * 16384);
            constexpr int NIT = 15616;
            struct TD { const float* W; const float* rs; bf16* WT; int ldn, Nc, ldk, ncs, item; float cs; };
#define TDESC(R, D) do { int r = (R); D.rs = nullptr; D.ldk = 1024; D.ncs = 0; D.cs = 1.f; \
                if (r < 1024) { const int i = r >> 9; D.W = ARGIN(I_ABWIN) + (size_t)i * 1024 * 2048; D.ldn = 2048; D.Nc = 2048; D.WT = WIN + (size_t)i * 2048 * 1024; D.rs = ARGIN(I_NMIXG) + (2 * i) * 1024; D.ncs = 512; D.cs = C2A; D.item = r & 511; } \
                else if ((r -= 1024) < 256) { const int i = r >> 7; D.W = ARGIN(I_ABWOUT) + (size_t)i * 1024 * 1024; D.ldn = 1024; D.Nc = 1024; D.WT = WOUT + (size_t)i * 1024 * 1024; D.item = r & 127; } \
                else if ((r -= 256) < 1536) { const int i = r / 768; D.W = ARGIN(I_CWIN) + (size_t)i * 1024 * 3072; D.ldn = 3072; D.Nc = 3072; D.WT = CIN + (size_t)i * 3072 * 1024; D.rs = ARGIN(I_NMIXG) + (2 * i + 1) * 1024; D.item = r % 768; } \
                else if ((r -= 1536) < 512) { const int i = r >> 8; D.W = ARGIN(I_CWOUT) + (size_t)i * 1024 * 1024; D.ldn = 1024; D.Nc = 1024; D.WT = COUT + (size_t)i * 1024 * 1024; D.item = r & 255; } \
                else if ((r -= 512) < 1024) { const int i = r >> 8; D.W = ARGIN(I_WQ) + (size_t)i * 1024 * 1024; D.ldn = 1024; D.Nc = 1024; D.WT = WQ + (size_t)i * 1024 * 1024; D.rs = ARGIN(I_NXG) + i * 1024; D.ncs = 1024; D.cs = C2X; D.item = r & 255; } \
                else if ((r -= 1024) < 1024) { const int i = r >> 8; D.W = ARGIN(I_WKV) + (size_t)i * 1024 * 2048; D.ldn = 2048; D.Nc = 1024; D.WT = WK + (size_t)i * 1024 * 1024; D.item = r & 255; } \
                else if ((r -= 1024) < 1024) { const int i = r >> 8; D.W = ARGIN(I_WKV) + (size_t)i * 1024 * 2048 + 1024; D.ldn = 2048; D.Nc = 1024; D.WT = WV + (size_t)i * 1024 * 1024; D.item = r & 255; } \
                else if ((r -= 1024) < 1024) { const int i = r >> 8; D.W = ARGIN(I_WO) + (size_t)i * 1024 * 1024; D.ldn = 1024; D.Nc = 1024; D.WT = WO + (size_t)i * 1024 * 1024; D.item = r & 255; } \
                else if ((r -= 1024) < 4096) { const int i = r >> 10; D.W = ARGIN(I_W1) + (size_t)i * 1024 * 4096; D.ldn = 4096; D.Nc = 4096; D.WT = W1 + (size_t)i * 4096 * 1024; D.rs = ARGIN(I_NMLPG) + i * 1024; D.item = r & 1023; } \
                else { r -= 4096; const int i = r >> 10; D.W = ARGIN(I_W2) + (size_t)i * 4096 * 1024; D.ldn = 1024; D.Nc = 1024; D.WT = W2 + (size_t)i * 1024 * 4096; D.ldk = 4096; D.item = r & 1023; } } while (0)
#define TLOAD(D, V) do { const int nblk_ = D.Nc / 64, kb_ = D.item / nblk_, nb_ = D.item % nblk_; const float* wp_ = D.W + (size_t)(64 * kb_ + (lane >> 4)) * D.ldn + 64 * nb_ + (lane & 15) * 4; \
                _Pragma("unroll") for (int i = 0; i < 16; ++i) V[i] = *(const f32x4*)(wp_ + (size_t)(4 * i) * D.ldn); } while (0)
            { f32x4 tv[16]; TD d, dn; int it = gw; bool have = it < NIT;
              LAS float* scr2 = (LAS float*)(L + wid * 16640);
              if (have) { TDESC(it, d); TLOAD(d, tv); }
              while (have) {
                const int itn = it + NGW; const bool hn = itn < NIT;
                const int nblk = d.Nc / 64, kb = d.item / nblk, nb = d.item % nblk, k0 = 64 * kb, n0 = 64 * nb;
                const int n4 = (lane & 15) * 4, kq = lane >> 4;
                const float csl = (n0 + n4 < d.ncs) ? d.cs : 1.f;
#pragma unroll
                for (int i = 0; i < 16; ++i) { const int kk = 4 * i + kq; float sc = csl; if (d.rs) sc *= d.rs[k0 + kk];
                    scr2[(n4 + 0) * 65 + kk] = tv[i][0] * sc; scr2[(n4 + 1) * 65 + kk] = tv[i][1] * sc; scr2[(n4 + 2) * 65 + kk] = tv[i][2] * sc; scr2[(n4 + 3) * 65 + kk] = tv[i][3] * sc; }
                if (hn) { TDESC(itn, dn); TLOAD(dn, tv); }
                asm volatile("s_waitcnt lgkmcnt(0)" ::: "memory");
                const int c = lane & 7;
#pragma unroll
                for (int j = 0; j < 8; ++j) { const int n = (lane >> 3) + 8 * j; const LAS float* sp = scr2 + n * 65 + 8 * c;
                    v4u o; o.x = pk2(sp[0], sp[1]); o.y = pk2(sp[2], sp[3]); o.z = pk2(sp[4], sp[5]); o.w = pk2(sp[6], sp[7]);
                    *(v4u*)(d.WT + (size_t)(n0 + n) * d.ldk + k0 + 8 * c) = o; }
                asm volatile("s_waitcnt lgkmcnt(0)" ::: "memory");
                d = dn; it = itn; have = hn;
              } }
#undef TDESC
#undef TLOAD
            for (int t = gw; t < 2 * 4 * 16 * 16; t += NGW) {
                const int nb = t & 15, c8 = (t >> 4) & 15, g = (t >> 8) & 3, i = t >> 10, n = nb * 64 + lane;
                const float* pw = ARGIN(I_POOLW) + ((size_t)(i * 4 + g) * 128 + c8 * 8) * 128; const float* psc = ARGIN(I_POOLS) + i * 512 + g * 128;
                const float* wo = ARGIN(I_ABWOUT) + (size_t)i * 1024 * 1024 + (size_t)(512 + g * 128) * 1024 + n;
                float a[8];
#pragma unroll
                for (int e = 0; e < 8; ++e) a[e] = 0.f;
#pragma unroll 8
                for (int d = 0; d < 128; ++d) { const float w = wo[(size_t)d * 1024] * psc[d];
#pragma unroll
                    for (int e = 0; e < 8; ++e) a[e] += pw[e * 128 + d] * w; }
                v4u o; o.x = pk2(a[0], a[1]); o.y = pk2(a[2], a[3]); o.z = pk2(a[4], a[5]); o.w = pk2(a[6], a[7]);
                *(v4u*)(WOUT + (size_t)i * 1024 * 1024 + (size_t)n * 1024 + 512 + g * 128 + c8 * 8) = o;
            }
            for (int row = gw; row < 16 * NMEM; row += NGW) {
                const f32x4* xr = (const f32x4*)(ARGIN(I_MEM) + (size_t)row * DM) + lane; const f32x4* gr = (const f32x4*)(ARGIN(I_MEMG)) + lane;
                f32x4 v[4]; float s = 0.f;
#pragma unroll
                for (int j = 0; j < 4; ++j) { v[j] = xr[64 * j]; s += (v[j][0] * v[j][0] + v[j][1] * v[j][1]) + (v[j][2] * v[j][2] + v[j][3] * v[j][3]); }
                const float rstd = __builtin_amdgcn_rsqf(wave_sum(s) * (1.f / DM) + EPS);
                v2u* o8 = (v2u*)(MEMN + (size_t)row * DM) + lane;
#pragma unroll
                for (int j = 0; j < 4; ++j) { const f32x4 g4 = gr[64 * j]; v2u w; w.x = pk2(v[j][0] * rstd * g4[0], v[j][1] * rstd * g4[1]); w.y = pk2(v[j][2] * rstd * g4[2], v[j][3] * rstd * g4[3]); o8[64 * j] = w; }
            }
            for (int row = gw; row < M; row += 2 * NGW) {
                const int row1 = row + NGW;
                const f32x4* xr0 = (const f32x4*)(ARGIN(I_X) + (size_t)row * DM) + lane; const f32x4* xr1 = (const f32x4*)(ARGIN(I_X) + (size_t)row1 * DM) + lane;
                f32x4 v0[4], v1[4];
#pragma unroll
                for (int j = 0; j < 4; ++j) { v0[j] = xr0[64 * j]; v1[j] = xr1[64 * j]; }
                v2u* o80 = (v2u*)(HB + (size_t)row * DM) + lane; v2u* o81 = (v2u*)(HB + (size_t)row1 * DM) + lane;
                float s0 = 0.f, s1 = 0.f;
#pragma unroll
                for (int j = 0; j < 4; ++j) { s0 += (v0[j][0] * v0[j][0] + v0[j][1] * v0[j][1]) + (v0[j][2] * v0[j][2] + v0[j][3] * v0[j][3]); s1 += (v1[j][0] * v1[j][0] + v1[j][1] * v1[j][1]) + (v1[j][2] * v1[j][2] + v1[j][3] * v1[j][3]);
                    v2u w; w.x = pk2(v0[j][0], v0[j][1]); w.y = pk2(v0[j][2], v0[j][3]); o80[64 * j] = w; w.x = pk2(v1[j][0], v1[j][1]); w.y = pk2(v1[j][2], v1[j][3]); o81[64 * j] = w; }
                s0 = wave_sum(s0); s1 = wave_sum(s1);
                if (lane < 16) { SSQ[(size_t)row * 16 + lane] = (lane == 0) ? s0 : 0.f; SSQ[(size_t)row1 * 16 + lane] = (lane == 0) ? s1 : 0.f; }
            }
            for (int e = bid * 512 + tid; e < 4 * TABN; e += G * 512) {
                const int h = e / TABN, d = e % TABN - 256; float v;
                if (d < 0) v = -INFINITY;
                else { int bk; if (d < 16) bk = d; else { bk = 16 + (int)(__builtin_amdgcn_logf((float)d * 0.0625f) * (16.0f / 3.0f)); bk = bk < 31 ? bk : 31; }
                       v = (ARGIN(I_RELB)[bk * 4 + h] - ARGIN(I_RELB)[31 * 4 + h]) * LOG2E; }
                TAB[e] = v;
            }
            if (bid == 0 && tid < 2) {
                float a = 0.f, b = 0.f;
                for (int d = 0; d < 64; ++d) { a += ARGIN(I_LQ1)[tid * 64 + d] * ARGIN(I_LK1)[tid * 64 + d]; b += ARGIN(I_LQ2)[tid * 64 + d] * ARGIN(I_LK2)[tid * 64 + d]; }
                LAM[tid] = __builtin_amdgcn_exp2f(a * LOG2E) - __builtin_amdgcn_exp2f(b * LOG2E) + (tid == 0 ? LAMBDA_INIT0 : LAMBDA_INIT2);
            }
#endif
        ph0 = 1; if (ph0 < ph_hi) grid.sync();
#undef ARGIN
    }
    (void)xcd_barrier_post((unsigned*)args.ws, (volatile LAS unsigned*)(L + XB_ST_OFF));
    for (int ph = ph0; ph < ph_hi; ++ph) {
        int kind, l; decode_phase(ph, kind, l); const int li = l >> 1;
        int tid_ = threadIdx.x, G_ = gridDim.x, bid_ = blockIdx.x; asm volatile("" : "+v"(tid_), "+s"(G_), "+s"(bid_));
        const int tid = tid_, lane = tid & 63, wid = __builtin_amdgcn_readfirstlane(tid >> 6), G = G_, bid = bid_, gw = bid * NWAVES + wid, NGW = G * NWAVES;
        const __attribute__((address_space(4))) Args* ap = (const __attribute__((address_space(4))) Args*)__builtin_amdgcn_kernarg_segment_ptr();
        asm volatile("" : "+s"(ap));
#define ARGIN(i) (ap->in[i])
        unsigned char* ws = ap->ws;
        float* out = ap->out;
        float* TAB = (float*)(ws + WS_SMALL); float* LAM = (float*)(ws + WS_SMALL + 16384);
        bf16* WIN = (bf16*)(ws + WS_WIN); bf16* WOUT = (bf16*)(ws + WS_WOUT); bf16* CIN = (bf16*)(ws + WS_CIN); bf16* COUT = (bf16*)(ws + WS_COUT);
        bf16* WQ = (bf16*)(ws + WS_WQ); bf16* WK = (bf16*)(ws + WS_WK); bf16* WV = (bf16*)(ws + WS_WV); bf16* WO = (bf16*)(ws + WS_WO); bf16* W1 = (bf16*)(ws + WS_W1); bf16* W2 = (bf16*)(ws + WS_W2);
        bf16* MEMN = (bf16*)(ws + WS_MEMN); bf16* KB = (bf16*)(ws + WS_KB); bf16* VT = (bf16*)(ws + WS_VT); float* SSQ = (float*)(ws + WS_SSQ);
        bf16* HB = (bf16*)(ws + WS_HB); bf16* MIX = (bf16*)(ws + WS_MIX); bf16* BIG = (bf16*)(ws + WS_BIG); bf16* ORAW = (bf16*)(ws + WS_ORAW);
        if (kind == K_MIXPROJ || kind == K_XQ) {
            if (kind == K_MIXPROJ && l == 0) {
                for (int z = 0; z < 2; ++z) {
                    pg8::Gemm g{z == 0 ? MEMN : WV, z == 0 ? WK : MEMN, 4096, 4096, 1024}; pg8::StaticOrder S; S.init(4096, 4096, G, bid);
                    pg8::EpiProj<0, false> E{z == 0 ? KB : VT, 4096, nullptr, nullptr, 0};
#ifndef DIS_G0
                    pg8::gemm_phase<pg8::EpiProj<0, false>, pg8::StaticOrder, true, true>(L, g, S, E);
#endif
                }
            }
            const bf16* Bt; int N;
            if (kind == K_XQ) { Bt = WQ + (size_t)l * 1024 * 1024; N = 1024; }
            else if ((l & 1) == 0) { Bt = WIN + (size_t)li * 2048 * 1024; N = 2048; }
            else { Bt = CIN + (size_t)li * 3072 * 1024; N = 3072; }
            pg8::Gemm g{HB, Bt, M, N, 1024}; pg8::StaticOrder S; S.init(M, N, G, bid);
#define PG8_LAS __attribute__((address_space(3)))
            const PG8_LAS float* rsl = nullptr; int pm0 = 0;
            if (G == 256) {
                PG8_LAS float* rw = (PG8_LAS float*)(L + 131072); pg8::Unit u0, uu; S.next(0, u0); pm0 = u0.pm; int last = -1;
                for (int i = 0; S.next(i, uu); ++i) { const int slot = (uu.pm - pm0) >> 3; if (slot != last && slot >= 0 && slot < 8) { if (tid < 256) rw[slot * 256 + tid] = pg8::row_rstd(SSQ, uu.pm * 256 + tid); last = slot; } }
                asm volatile("s_waitcnt vmcnt(0) lgkmcnt(0)" ::: "memory"); __syncthreads(); rsl = rw;
            }
            pg8::EpiProj<0, true> E{BIG, N, SSQ, rsl, pm0};
#ifndef DIS_G1
            pg8::gemm_phase<pg8::EpiProj<0, true>, pg8::StaticOrder, true, true>(L, g, S, E);
#endif
            if (kind == K_XQ) {
                asm volatile("s_waitcnt vmcnt(0)" ::: "memory"); __syncthreads();
                pg8::Unit xu;
                for (int i = 0; S.next(i, xu); ++i) { const int tm = xu.pm, h = xu.pn, b = tm >> 4;
#ifndef DIS_XAT
                    xat::unit(L, BIG + (size_t)tm * 256 * 1024 + h * 256, KB + (size_t)b * 256 * 4096 + l * 1024 + h * 256, VT + (size_t)(l * 1024 + h * 256) * 4096 + b * 256, MIX + (size_t)tm * 256 * 1024 + h * 256);
#endif
                }
            }
        }
        else if (kind == K_UP) {
            pg8::Gemm g{HB, W1 + (size_t)l * 4096 * 1024, M, 4096, 1024}; pg8::StaticOrder S; S.init(M, 4096, G, bid);
            const PG8_LAS float* rsl = nullptr; int pm0 = 0;
            if (G == 256) {
                PG8_LAS float* rw = (PG8_LAS float*)(L + 131072); pg8::Unit u0, uu; S.next(0, u0); pm0 = u0.pm; int last = -1;
                for (int i = 0; S.next(i, uu); ++i) { const int slot = (uu.pm - pm0) >> 3; if (slot != last && slot >= 0 && slot < 8) { if (tid < 256) rw[slot * 256 + tid] = pg8::row_rstd(SSQ, uu.pm * 256 + tid); last = slot; } }
                asm volatile("s_waitcnt vmcnt(0) lgkmcnt(0)" ::: "memory"); __syncthreads(); rsl = rw;
            }
            pg8::EpiProj<1, true> E{BIG, 4096, SSQ, rsl, pm0};
#ifndef DIS_G2
            pg8::gemm_phase<pg8::EpiProj<1, true>, pg8::StaticOrder, true, true>(L, g, S, E);
#endif
        }
        else if (kind == K_MIXOUT || kind == K_XO || kind == K_DOWN) {
            const bf16* A; const bf16* Bt; int K = 1024;
            if (kind == K_MIXOUT) { A = MIX; Bt = ((l & 1) == 0 ? WOUT : COUT) + (size_t)li * 1024 * 1024; }
            else if (kind == K_XO) { A = MIX; Bt = WO + (size_t)l * 1024 * 1024; }
            else { A = BIG; Bt = W2 + (size_t)l * 1024 * 4096; K = 4096; }
            pg8::Gemm g{A, Bt, M, 1024, K}; pg8::StaticOrder S; S.init(M, 1024, G, bid);
            pg8::EpiResid E{HB, SSQ};
#ifndef DIS_G3
            pg8::gemm_phase<pg8::EpiResid, pg8::StaticOrder, true, true>(L, g, S, E);
#endif
        }
        else if (kind == K_ATTN) {
            const LAS float* tab = (const LAS float*)(L + TAB_OFF); int cur_h = -1;
            for (int item = bid; item < 256; item += G) {
                const int it2 = (item & 7) * 32 + (item >> 3), b = it2 >> 4, h = (it2 >> 2) & 3, sq = it2 & 3;
                if (h != cur_h) { __syncthreads(); { LAS float* tw = (LAS float*)(L + TAB_OFF); const float t0v = TAB[h * TABN + tid]; const float t1v = TAB[h * TABN + (tid < TABN - 512 ? tid + 512 : tid)]; tw[tid] = t0v; if (tid < TABN - 512) tw[tid + 512] = t1v; } cur_h = h; asm volatile("s_waitcnt vmcnt(0) lgkmcnt(0)" ::: "memory"); __syncthreads(); }
                for (int qi = 0; qi < 4; ++qi) {
                    const int qb = qi == 0 ? 15 - sq : qi == 1 ? 8 + sq : qi == 2 ? 7 - sq : sq;
                    for (int vh = 0; vh < 4; ++vh) { const int mp = vh >> 1, j = vh & 1;
#ifndef DIS_ATTN
                        attn_body::attn_unit<8>(b, qb, (const attn_body::bf16*)(BIG + h * 128 + mp * 64), (const attn_body::bf16*)(BIG + 512 + h * 128 + mp * 64), (const attn_body::bf16*)(BIG + 1024 + h * 128 + j * 64),
                                                (attn_body::bf16*)(ORAW + mp * 512 + h * 128 + j * 64), tab, (char*)lds);
#endif
                        asm volatile("s_waitcnt vmcnt(0)" ::: "memory");
                    }
                    __syncthreads();
                    { int lane_ = threadIdx.x & 63; asm volatile("" : "+v"(lane_));
                      const float lam = LAM[li], post = 1.0f - (li == 0 ? LAMBDA_INIT0 : LAMBDA_INIT2);
                      const f32x4* gp = (const f32x4*)(ARGIN(I_SUBLN) + li * 128 + (lane_ & 15) * 8); const f32x4 ga = gp[0], gb = gp[1];
                      const size_t rowbase = (size_t)b * SEQ + (size_t)qb * 256 + wid * 32 + (lane_ >> 4); const int cofs = h * 128 + (lane_ & 15) * 8;
                      v4u aa[8], cc[8];
#pragma unroll
                      for (int it = 0; it < 8; ++it) { const size_t row = rowbase + it * 4; aa[it] = *(const v4u*)(ORAW + row * 1024 + cofs); cc[it] = *(const v4u*)(ORAW + row * 1024 + 512 + cofs); }
#pragma unroll
                      for (int it = 0; it < 8; ++it) { const size_t row = rowbase + it * 4; const v4u a = aa[it], c = cc[it];
                        float v[8] = {bf_lo(a.x) - lam * bf_lo(c.x), bf_hi(a.x) - lam * bf_hi(c.x), bf_lo(a.y) - lam * bf_lo(c.y), bf_hi(a.y) - lam * bf_hi(c.y),
                                      bf_lo(a.z) - lam * bf_lo(c.z), bf_hi(a.z) - lam * bf_hi(c.z), bf_lo(a.w) - lam * bf_lo(c.w), bf_hi(a.w) - lam * bf_hi(c.w)};
                        float sv = 0.f;
#pragma unroll
                        for (int e = 0; e < 8; ++e) sv += v[e] * v[e];
                        sv += __shfl_xor(sv, 1); sv += __shfl_xor(sv, 2); sv += __shfl_xor(sv, 4); sv += __shfl_xor(sv, 8);
                        const float r = __builtin_amdgcn_rsqf(sv * (1.0f / 128.0f) + EPS) * post;
                        v4u o; o.x = pk2(v[0] * r * ga[0], v[1] * r * ga[1]); o.y = pk2(v[2] * r * ga[2], v[3] * r * ga[3]); o.z = pk2(v[4] * r * gb[0], v[5] * r * gb[1]); o.w = pk2(v[6] * r * gb[2], v[7] * r * gb[3]);
                        *(v4u*)(MIX + row * 1024 + cofs) = o; }
                    }
                }
            }
#ifndef DIS_POOL
            { const int w = 2 << (lane >> 4);
              for (int task = gw; task < M / 32; task += NGW) {
                const int row0 = task * 32, t0 = row0 & (SEQ - 1);
                const bf16* up = BIG + (size_t)row0 * 2048 + 1536 + lane * 8; bf16* op = MIX + (size_t)row0 * 1024 + 512 + lane * 8;
                float sum[8];
#pragma unroll
                for (int e = 0; e < 8; ++e) sum[e] = 0.f;
                if (t0 > 0) for (int jj = 1; jj <= w; ++jj) {   const v4u q = *(const v4u*)(up - (size_t)jj * 2048);
                    sum[0] += bf_lo(q.x); sum[1] += bf_hi(q.x); sum[2] += bf_lo(q.y); sum[3] += bf_hi(q.y); sum[4] += bf_lo(q.z); sum[5] += bf_hi(q.z); sum[6] += bf_lo(q.w); sum[7] += bf_hi(q.w); }
                for (int i0 = 0; i0 < 32; i0 += 4) {
                    v4u qq[4], oo[4];
#pragma unroll
                    for (int k = 0; k < 4; ++k) { qq[k] = *(const v4u*)(up + (size_t)(i0 + k) * 2048); oo[k] = *(const v4u*)(up + ((long)(i0 + k) - w) * 2048); }
#pragma unroll
                    for (int k = 0; k < 4; ++k) { const int i = i0 + k; const v4u q = qq[k], o = oo[k];
                    float cur[8] = {bf_lo(q.x), bf_hi(q.x), bf_lo(q.y), bf_hi(q.y), bf_lo(q.z), bf_hi(q.z), bf_lo(q.w), bf_hi(q.w)};
#pragma unroll
                    for (int e = 0; e < 8; ++e) sum[e] += cur[e];
                    const int t = t0 + i;
                    if (t - w >= 0) {
                        sum[0] -= bf_lo(o.x); sum[1] -= bf_hi(o.x); sum[2] -= bf_lo(o.y); sum[3] -= bf_hi(o.y); sum[4] -= bf_lo(o.z); sum[5] -= bf_hi(o.z); sum[6] -= bf_lo(o.w); sum[7] -= bf_hi(o.w); }
                    const float rc = 1.0f / (float)((t + 1) < w ? (t + 1) : w);
                    v4u r; r.x = pk2(sum[0] * rc - cur[0], sum[1] * rc - cur[1]); r.y = pk2(sum[2] * rc - cur[2], sum[3] * rc - cur[3]); r.z = pk2(sum[4] * rc - cur[4], sum[5] * rc - cur[5]); r.w = pk2(sum[6] * rc - cur[6], sum[7] * rc - cur[7]);
                    *(v4u*)(op + (size_t)i * 1024) = r; }
                }
              } }
#endif
        }
        else if (kind == K_CONV) {
#ifndef DIS_CONV
            for (int task = gw; task < (M / 32) * 2; task += NGW) {
                const int row0 = (task >> 1) * 32, t0 = row0 & (SEQ - 1), ch = (task & 1) * 512 + lane * 8;
                const float* cw = ARGIN(I_CW) + (size_t)li * 3 * 1024 + ch;
                float w0[8], w1[8], w2[8];
#pragma unroll
                for (int e = 0; e < 8; ++e) { w0[e] = cw[e]; w1[e] = cw[1024 + e]; w2[e] = cw[2048 + e]; }
                const bf16* pp = BIG + (size_t)row0 * 3072 + ch; bf16* op = MIX + (size_t)row0 * 1024 + ch;
                float z1[8], z2[8];
#pragma unroll
                for (int e = 0; e < 8; ++e) { z1[e] = 0.f; z2[e] = 0.f; }
                if (t0 > 0) {
                    const v4u c1 = *(const v4u*)(pp - 3072 + 1024), x1 = *(const v4u*)(pp - 3072 + 2048), c2 = *(const v4u*)(pp - 2 * 3072 + 1024), x2 = *(const v4u*)(pp - 2 * 3072 + 2048);
                    z1[0] = bf_lo(c1.x) * bf_lo(x1.x); z1[1] = bf_hi(c1.x) * bf_hi(x1.x); z1[2] = bf_lo(c1.y) * bf_lo(x1.y); z1[3] = bf_hi(c1.y) * bf_hi(x1.y);
                    z1[4] = bf_lo(c1.z) * bf_lo(x1.z); z1[5] = bf_hi(c1.z) * bf_hi(x1.z); z1[6] = bf_lo(c1.w) * bf_lo(x1.w); z1[7] = bf_hi(c1.w) * bf_hi(x1.w);
                    z2[0] = bf_lo(c2.x) * bf_lo(x2.x); z2[1] = bf_hi(c2.x) * bf_hi(x2.x); z2[2] = bf_lo(c2.y) * bf_lo(x2.y); z2[3] = bf_hi(c2.y) * bf_hi(x2.y);
                    z2[4] = bf_lo(c2.z) * bf_lo(x2.z); z2[5] = bf_hi(c2.z) * bf_hi(x2.z); z2[6] = bf_lo(c2.w) * bf_lo(x2.w); z2[7] = bf_hi(c2.w) * bf_hi(x2.w);
                }
                for (int i0 = 0; i0 < 32; i0 += 4) {
                    v4u bqq[4], cqq[4], xqq[4];
#pragma unroll
                    for (int k = 0; k < 4; ++k) { bqq[k] = *(const v4u*)(pp + (size_t)(i0 + k) * 3072); cqq[k] = *(const v4u*)(pp + (size_t)(i0 + k) * 3072 + 1024); xqq[k] = *(const v4u*)(pp + (size_t)(i0 + k) * 3072 + 2048); }
#pragma unroll
                    for (int k = 0; k < 4; ++k) { const int i = i0 + k; const v4u bq = bqq[k], cq = cqq[k], xq = xqq[k];
                    const float bb[8] = {bf_lo(bq.x), bf_hi(bq.x), bf_lo(bq.y), bf_hi(bq.y), bf_lo(bq.z), bf_hi(bq.z), bf_lo(bq.w), bf_hi(bq.w)};
                    const float z[8] = {bf_lo(cq.x) * bf_lo(xq.x), bf_hi(cq.x) * bf_hi(xq.x), bf_lo(cq.y) * bf_lo(xq.y), bf_hi(cq.y) * bf_hi(xq.y), bf_lo(cq.z) * bf_lo(xq.z), bf_hi(cq.z) * bf_hi(xq.z), bf_lo(cq.w) * bf_lo(xq.w), bf_hi(cq.w) * bf_hi(xq.w)};
                    float y[8];
#pragma unroll
                    for (int e = 0; e < 8; ++e) { y[e] = bb[e] * (z2[e] * w0[e] + z1[e] * w1[e] + z[e] * w2[e]); z2[e] = z1[e]; z1[e] = z[e]; }
                    v4u r; r.x = pk2(y[0], y[1]); r.y = pk2(y[2], y[3]); r.z = pk2(y[4], y[5]); r.w = pk2(y[6], y[7]);
                    *(v4u*)(op + (size_t)i * 1024) = r; }
                }
            }
#endif
        }
        else {
            const f32x4* gr = (const f32x4*)(ARGIN(I_FING) + lane * 8);
            const f32x4 g0 = gr[0], g1 = gr[1], g2 = gr[128], g3 = gr[129];
            for (int row0 = gw; row0 < M; row0 += 2 * NGW) {
                v4u h0[2], h1[2];
#pragma unroll
                for (int k = 0; k < 2; ++k) { const bf16* hp = HB + (size_t)(row0 + k * NGW) * DM + lane * 8; h0[k] = *(const v4u*)(hp); h1[k] = *(const v4u*)(hp + 512); }
#pragma unroll
                for (int k = 0; k < 2; ++k) { float* op = out + (size_t)(row0 + k * NGW) * DM + lane * 8;
                    const f32x4 a0 = {bf_lo(h0[k].x), bf_hi(h0[k].x), bf_lo(h0[k].y), bf_hi(h0[k].y)}, a1 = {bf_lo(h0[k].z), bf_hi(h0[k].z), bf_lo(h0[k].w), bf_hi(h0[k].w)};
                    const f32x4 a2 = {bf_lo(h1[k].x), bf_hi(h1[k].x), bf_lo(h1[k].y), bf_hi(h1[k].y)}, a3 = {bf_lo(h1[k].z), bf_hi(h1[k].z), bf_lo(h1[k].w), bf_hi(h1[k].w)};
                    float sq = ((a0[0] * a0[0] + a0[1] * a0[1]) + (a0[2] * a0[2] + a0[3] * a0[3])) + ((a1[0] * a1[0] + a1[1] * a1[1]) + (a1[2] * a1[2] + a1[3] * a1[3]))
                             + ((a2[0] * a2[0] + a2[1] * a2[1]) + (a2[2] * a2[2] + a2[3] * a2[3])) + ((a3[0] * a3[0] + a3[1] * a3[1]) + (a3[2] * a3[2] + a3[3] * a3[3]));
                    const float r = __builtin_amdgcn_rsqf(wave_sum(sq) * (1.f / DM) + EPS);
                    *(f32x4*)(op) = a0 * r * g0; *(f32x4*)(op + 4) = a1 * r * g1; *(f32x4*)(op + 512) = a2 * r * g2; *(f32x4*)(op + 516) = a3 * r * g3; }
            }
        }
        if (ph + 1 < ph_hi) { XcdBarrier xb_; xb_.bar = (unsigned*)ws; xb_.x = xb_xcc_id(); xb_.st = (volatile LAS unsigned*)(L + XB_ST_OFF); xcd_barrier(xb_); }
    }
}


#ifndef N_LAUNCH_MODE
#define N_LAUNCH_MODE 1
#endif
extern "C" void kernel_launch(void* const* d_in, const int* in_sizes, int n_in, void* d_out, int out_size, void* d_ws, size_t ws_size, hipStream_t stream) {
    static int grid = 0;
    if (grid == 0) {
        if (n_in != 25 || in_sizes[0] != M * DM || out_size != M * DM || ws_size < WS_END) { fprintf(stderr, "kernel_launch: unexpected shapes (n_in %d, in0 %d, out %d, ws %zu); nothing launched\n", n_in, n_in > 0 ? in_sizes[0] : -1, out_size, ws_size); grid = -1; return; }
        int dev = 0, cus = 0, per_cu = 0;
        hipGetDevice(&dev); hipDeviceGetAttribute(&cus, hipDeviceAttributeMultiprocessorCount, dev);
        if (hipFuncSetAttribute((const void*)trunk_fwd, hipFuncAttributeMaxDynamicSharedMemorySize, LDS_BYTES) != hipSuccess) { fprintf(stderr, "kernel_launch: hipFuncSetAttribute failed\n"); grid = -1; return; }
        if (hipOccupancyMaxActiveBlocksPerMultiprocessor(&per_cu, (const void*)trunk_fwd, NWAVES * 64, LDS_BYTES) != hipSuccess || per_cu < 1) { fprintf(stderr, "kernel_launch: occupancy query gave %d\n", per_cu); per_cu = 1; }
        (void)hipGetLastError();
        grid = cus;
    }
    if (grid < 0) return;
    Args a{};
    for (int i = 0; i < 25; ++i) a.in[i] = (const float*)d_in[i];
    a.out = (float*)d_out; a.ws = (unsigned char*)d_ws;
#if N_LAUNCH_MODE == 1
    a.lo = 0; a.hi = NPHASE;
    { void* kargs[] = {&a}; hipError_t e = hipLaunchCooperativeKernel((const void*)trunk_fwd, dim3(grid), dim3(NWAVES * 64), kargs, LDS_BYTES, stream);
      if (e != hipSuccess) fprintf(stderr, "cooperative launch failed: %s (grid %d)\n", hipGetErrorString(e), grid); }
#elif N_LAUNCH_MODE == 0
    for (int p = 0; p < NPHASE; ++p) { a.lo = p; a.hi = p + 1; void* kargs[] = {&a};
        hipError_t e = hipLaunchCooperativeKernel((const void*)trunk_fwd, dim3(grid), dim3(NWAVES * 64), kargs, LDS_BYTES, stream);
        if (e != hipSuccess) { fprintf(stderr, "launch %d failed: %s (grid %d)\n", p, hipGetErrorString(e), grid); break; } }
#endif
}
```

```cpp
#include <hip/hip_runtime.h>
#include <hip/hip_cooperative_groups.h>
#include <hip/hip_bf16.h>
#include <cstdio>
#include <cstdint>
#include <cmath>
namespace cg = cooperative_groups;
namespace pg8 {
#define PG8_LAS __attribute__((address_space(3)))
typedef unsigned short bf16_t;
typedef short bf16x8 __attribute__((ext_vector_type(8)));
typedef float f32x4 __attribute__((ext_vector_type(4)));
typedef unsigned u32x4 __attribute__((ext_vector_type(4)));
constexpr int BM = 256, BK = 64, HALF = 128, HTB = HALF * BK * 2  , STAGE_BYTES = 8 * HTB, NXCD = 8, WGM = 8;

__host__ __device__ __forceinline__ int lds_byte(int r, int c) { const int st = (r >> 4) * 2 + (c >> 5), rr = r & 15, cc = c & 31, ob = rr * 64 + cc * 2; return st * 1024 + (ob ^ (((ob >> 9) & 1) << 5)); }
__host__ __device__ __forceinline__ void stage_rc(int b, int& R, int& C) { const int st = b / 1024, sb = b % 1024, swz = sb ^ (((sb >> 9) & 1) << 5); R = (st >> 1) * 16 + swz / 64; C = (st & 1) * 32 + (swz % 64) / 2; }
__host__ __device__ __forceinline__ int perm32(int rho) { const int n = rho >> 4, i = rho & 15; return 8 * (i >> 2) + 4 * n + (i & 3); }

struct Unit { int pm, pn; };
struct Gemm { const bf16_t* A; const bf16_t* Bt; int M, N, K; };

struct StaticOrder {
    int nM, nN, nwg, G, c;
    __host__ __device__ void init(int M, int N, int G_, int c_) { nM = M / BM; nN = N / BM; nwg = nM * nN; G = G_; c = c_; }
    __host__ __device__ bool next(int i, Unit& u) const {
        const long L = (long)i * G + c; if (L >= nwg) return false;
        int wgid = (int)L; { const int q = nwg / NXCD, r = nwg % NXCD, xcd = wgid % NXCD, off = wgid / NXCD; wgid = (xcd < r ? xcd * (q + 1) : r * (q + 1) + (xcd - r) * q) + off; }
        const int nig = WGM * nN, gid = wgid / nig, fm = gid * WGM, gsz = (nM - fm) < WGM ? (nM - fm) : WGM;
        u.pm = fm + ((wgid % nig) % gsz); u.pn = (wgid % nig) / gsz; return true;
    }
    __device__ __forceinline__ void a_ready(const Unit&) const {}
    __device__ __forceinline__ void done(const Unit&) const {}
};

__device__ __forceinline__ unsigned cvt_pk_bf16(float lo, float hi) { unsigned r; asm volatile("v_cvt_pk_bf16_f32 %0, %1, %2" : "=v"(r) : "v"(lo), "v"(hi)); return r; }
typedef float f32x2 __attribute__((ext_vector_type(2)));
__device__ __forceinline__ float row_rstd(const float* ssq, int row) {
    const f32x4* p = (const f32x4*)(ssq + (size_t)row * 16);
    const f32x4 a = p[0], b = p[1], c = p[2], d = p[3];
    const float s = (((a[0] + a[1]) + (a[2] + a[3])) + ((b[0] + b[1]) + (b[2] + b[3]))) + (((c[0] + c[1]) + (c[2] + c[3])) + ((d[0] + d[1]) + (d[2] + d[3])));
    return __builtin_amdgcn_rsqf(s * (1.0f / 1024.0f) + 1e-6f);
}
template <int ACT  , bool SCALE> struct EpiProj {
    static constexpr bool PERM = true, AFTER_DRAIN = false;
    int zfrom, zcol;
    bf16_t* O; int ldc; const float* ssq; const PG8_LAS float* rsl; int pm0;
    __device__ __forceinline__ void operator()(const f32x4 (&acc)[2][2][4][2], const Unit& u, int wr, int wc, int fr, int fq) const {
        const int row0 = u.pm * BM + wr * 64 + fr, col0 = u.pn * BM + wc * 32 + 8 * fq;
        if constexpr (ACT == 0 && SCALE) { if (u.pn >= zfrom) {
            const int zc = zcol + (u.pn - zfrom) * HALF + wc * 32 + 8 * fq;
#pragma unroll
            for (int ai = 0; ai < 2; ++ai)
#pragma unroll
                for (int m = 0; m < 4; ++m) { const int row = row0 + ai * HALF + m * 16;
                    const float sc = rsl ? rsl[((u.pm - pm0) >> 3) * 256 + (row & 255)] : row_rstd(ssq, row);
                    const f32x4 z0 = (acc[ai][0][m][0] * sc) * (acc[ai][1][m][0] * sc), z1 = (acc[ai][0][m][1] * sc) * (acc[ai][1][m][1] * sc);
                    u32x4 w; w.x = cvt_pk_bf16(z0[0], z0[1]); w.y = cvt_pk_bf16(z0[2], z0[3]); w.z = cvt_pk_bf16(z1[0], z1[1]); w.w = cvt_pk_bf16(z1[2], z1[3]);
                    __builtin_nontemporal_store(w, (u32x4*)(O + (size_t)row * ldc + zc)); }
            return; } }
#pragma unroll
        for (int ai = 0; ai < 2; ++ai)
#pragma unroll
            for (int m = 0; m < 4; ++m) { const int row = row0 + ai * HALF + m * 16; bf16_t* rowp = O + (size_t)row * ldc + col0;
                float sc = 1.f; if (SCALE) sc = rsl ? rsl[((u.pm - pm0) >> 3) * 256 + (row & 255)] : row_rstd(ssq, row);
#pragma unroll
                for (int bj = 0; bj < 2; ++bj) { f32x4 v0 = acc[ai][bj][m][0] * sc, v1 = acc[ai][bj][m][1] * sc;
                    if (ACT == 1) {
#pragma unroll
                        for (int j = 0; j < 4; ++j) { const float a = __builtin_fmaxf(v0[j], 0.f), b = __builtin_fmaxf(v1[j], 0.f); v0[j] = a * a; v1[j] = b * b; } }
                    u32x4 w; w.x = cvt_pk_bf16(v0[0], v0[1]); w.y = cvt_pk_bf16(v0[2], v0[3]); w.z = cvt_pk_bf16(v1[0], v1[1]); w.w = cvt_pk_bf16(v1[2], v1[3]);
                    __builtin_nontemporal_store(w, (u32x4*)(rowp + bj * HALF)); } }
    }
};
struct EpiResid {
    static constexpr bool PERM = true, AFTER_DRAIN = false;
    bf16_t* hb; float* ssq;
    __device__ __forceinline__ void operator()(const f32x4 (&acc)[2][2][4][2], const Unit& u, int wr, int wc, int fr, int fq) const {
        const int row0 = u.pm * BM + wr * 64 + fr, col0 = u.pn * BM + wc * 32 + 8 * fq;
        u32x4 hv[2][4][2];
#pragma unroll
        for (int ai = 0; ai < 2; ++ai)
#pragma unroll
            for (int m = 0; m < 4; ++m)
#pragma unroll
                for (int bj = 0; bj < 2; ++bj) hv[ai][m][bj] = *(const u32x4*)(hb + (size_t)(row0 + ai * HALF + m * 16) * 1024 + col0 + bj * HALF);
#pragma unroll
        for (int ai = 0; ai < 2; ++ai)
#pragma unroll
            for (int m = 0; m < 4; ++m) { const int row = row0 + ai * HALF + m * 16; float s = 0.f;
#pragma unroll
                for (int bj = 0; bj < 2; ++bj) { const size_t off = (size_t)row * 1024 + col0 + bj * HALF;
                    const u32x4 h4 = hv[ai][m][bj];
                    const f32x4 b0 = {__uint_as_float(h4.x << 16), __uint_as_float(h4.x & 0xffff0000u), __uint_as_float(h4.y << 16), __uint_as_float(h4.y & 0xffff0000u)};
                    const f32x4 b1 = {__uint_as_float(h4.z << 16), __uint_as_float(h4.z & 0xffff0000u), __uint_as_float(h4.w << 16), __uint_as_float(h4.w & 0xffff0000u)};
                    const f32x4 v0 = acc[ai][bj][m][0] + b0, v1 = acc[ai][bj][m][1] + b1;
                    u32x4 w; w.x = cvt_pk_bf16(v0[0], v0[1]); w.y = cvt_pk_bf16(v0[2], v0[3]); w.z = cvt_pk_bf16(v1[0], v1[1]); w.w = cvt_pk_bf16(v1[2], v1[3]);
                    *(u32x4*)(hb + off) = w;
                    s += ((v0[0] * v0[0] + v0[1] * v0[1]) + (v0[2] * v0[2] + v0[3] * v0[3])) + ((v1[0] * v1[0] + v1[1] * v1[1]) + (v1[2] * v1[2] + v1[3] * v1[3])); }
                s += __shfl_xor(s, 16); s += __shfl_xor(s, 32);
                if (fq == 0) ssq[(size_t)row * 16 + u.pn * 4 + wc] = s; }
    }
};
template <class Epi, class Sched, bool ALIGN_EPI = false, bool SP2 = false>
__device__ __forceinline__ void gemm_phase(PG8_LAS unsigned char* lds, const Gemm g, const Sched& S, const Epi& E) {
    int tid_ = threadIdx.x; asm volatile("" : "+v"(tid_));
    const int tid = tid_, wid = __builtin_amdgcn_readfirstlane(tid >> 6), lane = tid & 63, wr = wid >> 2, wc = wid & 3, fr = lane & 15, fq = lane >> 4;
    const int K = g.K, nt = K / BK;
    unsigned voffA[2], voffB[2];
#pragma unroll
    for (int i = 0; i < 2; ++i) { int R, C; stage_rc(tid * 16 + i * 8192, R, C); const int Rb = Epi::PERM ? ((R & ~31) + perm32(R & 31)) : R;
        voffA[i] = (unsigned)(R * K + C) * 2u; voffB[i] = (unsigned)(Rb * K + C) * 2u; }
    const size_t kstep = (size_t)(BK * 2);
    const size_t hstep = (size_t)HALF * K * 2;
    const size_t tstep = 2 * hstep;
    const unsigned ldsw = (unsigned)wid * 1024u;
    const int aoff = lds_byte(wr * 64 + fr, fq * 8), boff = lds_byte(wc * 32 + fr, fq * 8);
#define PG8_SA(b, h) (((b) * 2 + (h)) * HTB)
#define PG8_SB(b, h) ((4 + (b) * 2 + (h)) * HTB)
#define PG8_STAGE(bufoff, gbase, voff) do { _Pragma("unroll") for (int _i = 0; _i < 2; ++_i) \
        __builtin_amdgcn_global_load_lds((const unsigned*)((const char*)(gbase) + (voff)[_i]), (PG8_LAS unsigned*)(lds + (bufoff) + ldsw + _i * 8192), 16, 0, 0); } while (0)
#define PG8_LDA(dst, b, h) do { _Pragma("unroll") for (int m = 0; m < 4; ++m) _Pragma("unroll") for (int k = 0; k < 2; ++k) dst[m][k] = *(const PG8_LAS bf16x8*)(lds + PG8_SA(b, h) + aoff + m * 2048 + k * 1024); } while (0)
#define PG8_LDB(dst, b, h) do { _Pragma("unroll") for (int n = 0; n < 2; ++n) _Pragma("unroll") for (int k = 0; k < 2; ++k) dst[n][k] = *(const PG8_LAS bf16x8*)(lds + PG8_SB(b, h) + boff + n * 2048 + k * 1024); } while (0)
#define PG8_MMA(ai, bj, At, Bt) do { __builtin_amdgcn_s_setprio(1); _Pragma("unroll") for (int m = 0; m < 4; ++m) _Pragma("unroll") for (int n = 0; n < 2; ++n) _Pragma("unroll") for (int k = 0; k < 2; ++k) \
        acc[ai][bj][m][n] = __builtin_amdgcn_mfma_f32_16x16x32_bf16(Bt[n][k], At[m][k], acc[ai][bj][m][n], 0, 0, 0); __builtin_amdgcn_s_setprio(0); } while (0)
#define PG8_WAIT_V(n) asm volatile("s_waitcnt vmcnt(" #n ")" ::: "memory")
#define PG8_WAIT_L(n) asm volatile("s_waitcnt lgkmcnt(" #n ")" ::: "memory")
#define PG8_BAR __builtin_amdgcn_s_barrier()
#define PG8_SCHED __builtin_amdgcn_sched_barrier(0)
    Unit cur, nxt; int ui = 0;
    if (!S.next(0, cur)) return;
    f32x4 acc[2][2][4][2];
#pragma unroll
    for (int a = 0; a < 2; ++a)
#pragma unroll
        for (int b = 0; b < 2; ++b)
#pragma unroll
            for (int m = 0; m < 4; ++m)
#pragma unroll
                for (int n = 0; n < 2; ++n) acc[a][b][m][n] = (f32x4){0.f, 0.f, 0.f, 0.f};
    bf16x8 At[4][2], B0[2][2], B1[2][2];
    const char* cA = (const char*)g.A + (size_t)cur.pm * tstep; const char* cB = (const char*)g.Bt + (size_t)cur.pn * tstep;
    S.a_ready(cur);
    if constexpr (SP2) {
        PG8_STAGE(PG8_SB(0, 0), cB, voffB); PG8_STAGE(PG8_SB(0, 1), cB + hstep, voffB); PG8_STAGE(PG8_SA(0, 0), cA, voffA); PG8_STAGE(PG8_SA(0, 1), cA + hstep, voffA);
        if (wr == 1) PG8_BAR;
        PG8_WAIT_V(2); PG8_BAR;
        PG8_STAGE(PG8_SB(1, 0), cB + kstep, voffB); PG8_STAGE(PG8_SA(1, 0), cA + kstep, voffA); PG8_STAGE(PG8_SB(1, 1), cB + hstep + kstep, voffB);
        PG8_WAIT_V(6); PG8_BAR;
    } else {
        PG8_STAGE(PG8_SB(0, 0), cB, voffB); PG8_STAGE(PG8_SA(0, 0), cA, voffA); PG8_STAGE(PG8_SB(0, 1), cB + hstep, voffB); PG8_STAGE(PG8_SA(0, 1), cA + hstep, voffA);
        if (wr == 1) PG8_BAR;
        PG8_WAIT_V(4); PG8_BAR;
        PG8_STAGE(PG8_SB(1, 0), cB + kstep, voffB); PG8_STAGE(PG8_SA(1, 0), cA + kstep, voffA); PG8_STAGE(PG8_SB(1, 1), cB + hstep + kstep, voffB);
        PG8_WAIT_V(6); PG8_BAR;
    }
    for (;;) {
        const bool has_next = S.next(ui + 1, nxt);
        const char* nA = has_next ? (const char*)g.A + (size_t)nxt.pm * tstep : cA; const char* nB = has_next ? (const char*)g.Bt + (size_t)nxt.pn * tstep : cB;
        for (int t = 0; t < nt; t += 2) {
            const bool last = (t == nt - 2);
            const char* a1 = cA + (size_t)(t + 1) * kstep;
            const char* a2 = last ? nA : cA + (size_t)(t + 2) * kstep; const char* b2 = last ? nB : cB + (size_t)(t + 2) * kstep;
            const char* a3 = a2 + kstep; const char* b3 = b2 + kstep;
            if (last && has_next) S.a_ready(nxt);
            if constexpr (SP2) {
            PG8_LDB(B0, 0, 0); PG8_LDB(B1, 0, 1); PG8_SCHED; PG8_LDA(At, 0, 0); PG8_STAGE(PG8_SA(1, 1), a1 + hstep, voffA);
            PG8_WAIT_V(8); PG8_WAIT_L(0); PG8_BAR; PG8_MMA(0, 0, At, B0); PG8_MMA(0, 1, At, B1); PG8_BAR; PG8_SCHED;
            PG8_LDA(At, 0, 1); PG8_STAGE(PG8_SB(0, 0), b2, voffB); PG8_STAGE(PG8_SB(0, 1), b2 + hstep, voffB); PG8_STAGE(PG8_SA(0, 0), a2, voffA);
            PG8_WAIT_V(8); PG8_WAIT_L(0); PG8_BAR; PG8_MMA(1, 0, At, B0); PG8_MMA(1, 1, At, B1); PG8_BAR; PG8_SCHED;
            PG8_LDB(B0, 1, 0); PG8_LDB(B1, 1, 1); PG8_SCHED; PG8_LDA(At, 1, 0); PG8_STAGE(PG8_SA(0, 1), a2 + hstep, voffA);
            PG8_WAIT_V(8); PG8_WAIT_L(0); PG8_BAR; PG8_MMA(0, 0, At, B0); PG8_MMA(0, 1, At, B1); PG8_BAR; PG8_SCHED;
            PG8_LDA(At, 1, 1); PG8_STAGE(PG8_SB(1, 0), b3, voffB); PG8_STAGE(PG8_SB(1, 1), b3 + hstep, voffB); PG8_STAGE(PG8_SA(1, 0), a3, voffA);
            PG8_WAIT_V(8); PG8_WAIT_L(0); PG8_BAR; PG8_MMA(1, 0, At, B0); PG8_MMA(1, 1, At, B1); PG8_BAR; PG8_SCHED;
            } else {
            PG8_LDB(B0, 0, 0); PG8_SCHED; PG8_LDA(At, 0, 0); PG8_STAGE(PG8_SA(1, 1), a1 + hstep, voffA);
            PG8_WAIT_L(8); PG8_BAR; PG8_WAIT_L(0); PG8_MMA(0, 0, At, B0); PG8_BAR; PG8_SCHED;
            PG8_LDB(B1, 0, 1); PG8_STAGE(PG8_SB(0, 0), b2, voffB);
            PG8_BAR; PG8_WAIT_L(0); PG8_MMA(0, 1, At, B1); PG8_BAR;
            PG8_LDA(At, 0, 1); PG8_STAGE(PG8_SA(0, 0), a2, voffA);
            PG8_BAR; PG8_WAIT_L(0); PG8_MMA(1, 0, At, B0); PG8_BAR; PG8_SCHED;
            PG8_STAGE(PG8_SB(0, 1), b2 + hstep, voffB);
            PG8_WAIT_V(6); PG8_BAR; PG8_MMA(1, 1, At, B1); PG8_BAR;
            PG8_LDB(B0, 1, 0); PG8_SCHED; PG8_LDA(At, 1, 0); PG8_STAGE(PG8_SA(0, 1), a2 + hstep, voffA);
            PG8_WAIT_L(8); PG8_BAR; PG8_WAIT_L(0); PG8_MMA(0, 0, At, B0); PG8_BAR; PG8_SCHED;
            PG8_LDB(B1, 1, 1); PG8_STAGE(PG8_SB(1, 0), b3, voffB);
            PG8_BAR; PG8_WAIT_L(0); PG8_MMA(0, 1, At, B1); PG8_BAR;
            PG8_LDA(At, 1, 1); PG8_STAGE(PG8_SA(1, 0), a3, voffA);
            PG8_BAR; PG8_WAIT_L(0); PG8_MMA(1, 0, At, B0); PG8_BAR; PG8_SCHED;
            PG8_STAGE(PG8_SB(1, 1), b3 + hstep, voffB);
            PG8_WAIT_V(6); PG8_BAR; PG8_MMA(1, 1, At, B1); PG8_BAR;
            }
        }
        if constexpr (ALIGN_EPI) { if (wr == 0) PG8_BAR; }
        if constexpr (!Epi::AFTER_DRAIN) { E(acc, cur, wr, wc, fr, fq); S.done(cur); }
        if (!has_next) break;
#pragma unroll
        for (int a = 0; a < 2; ++a)
#pragma unroll
            for (int b = 0; b < 2; ++b)
#pragma unroll
                for (int m = 0; m < 4; ++m)
#pragma unroll
                    for (int n = 0; n < 2; ++n) acc[a][b][m][n] = (f32x4){0.f, 0.f, 0.f, 0.f};
        cur = nxt; cA = nA; cB = nB; ++ui;
        if constexpr (ALIGN_EPI) { if (wr == 1) PG8_BAR; }
    }
    PG8_WAIT_V(0);
    if constexpr (!ALIGN_EPI) { if (wr == 0) PG8_BAR; }
    PG8_BAR;
    if constexpr (Epi::AFTER_DRAIN) { E.fused(acc, cur, wr, wc, fr, fq, lds, wid, lane); S.done(cur); }
#undef PG8_SA
#undef PG8_SB
#undef PG8_STAGE
#undef PG8_LDA
#undef PG8_LDB
#undef PG8_MMA
#undef PG8_WAIT_V
#undef PG8_WAIT_L
#undef PG8_BAR
#undef PG8_SCHED
}
}
#include <hip/hip_bf16.h>
#include <cmath>
namespace attn_body {
using bf16=__hip_bfloat16;
using bf16x8=__attribute__((ext_vector_type(8)))short;
using s16x4=__attribute__((ext_vector_type(4)))short;
using f32x16=__attribute__((ext_vector_type(16)))float;
using u32x4=__attribute__((ext_vector_type(4)))unsigned;
constexpr int BATCH=16,SEQ=4096,D=64,PQ=2048,PO=1024;
constexpr int NW=8,QBLK=32,QB=QBLK*NW,KVBLK=64,NQB=SEQ/QB;
constexpr int ATTN_UNIT_ROWS=QB;
__device__ __forceinline__ int crow(int r,int hi){return (r&3)+8*(r>>2)+4*hi;}
#define SBAR() __builtin_amdgcn_sched_barrier(0)
__device__ __forceinline__ void cmask(f32x16&p0,f32x16&p1,int jb,int qrel,int hi,const __attribute__((address_space(3))) float*tab){
  asm volatile("s_nop 15\n\ts_nop 7":"+v"(p0),"+v"(p1));
  const __attribute__((address_space(3))) float*tp=tab+(qrel-64*jb-4*hi+256);
  #pragma unroll
  for(int r=0;r<16;++r){const int o=(r&3)+8*(r>>2); float a0=tp[-o], a1=tp[-o-32]; asm volatile("v_add_f32_e32 %0, %1, %0":"+v"(p0[r]):"v"(a0)); asm volatile("v_add_f32_e32 %0, %1, %0":"+v"(p1[r]):"v"(a1));}
}

constexpr int NSLOT=3, SLOTB=8192;
constexpr int LDS_K=0, LDS_V=NSLOT*SLOTB, LDS_WS=2*NSLOT*SLOTB, LDS_TAB=LDS_WS+NW*64*4, LDS_OST=LDS_TAB+3072, LDS_BYTES=LDS_OST+NW*4096;
constexpr float C2=0.125f*1.4426950408889634f;
__device__ __forceinline__ void glds16(const void*gsrc,unsigned lds_dst){unsigned keep;
  asm volatile("s_mov_b32 %0, m0\n\ts_mov_b32 m0, %2\n\ts_nop 0\n\tglobal_load_lds_dwordx4 %1, off\n\ts_mov_b32 m0, %0":"=&s"(keep):"v"(gsrc),"s"(lds_dst):"memory");}
__device__ __forceinline__ float max3f(float a,float b,float c){float r;asm("v_max3_f32 %0, %1, %2, %3":"=v"(r):"v"(a),"v"(b),"v"(c));return r;}
__device__ __forceinline__ float max2f(float a,float b){float r;asm("v_max_f32_e32 %0, %1, %2":"=v"(r):"v"(a),"v"(b));return r;}
__device__ __forceinline__ float fadd_s(float a,float b){float r;asm("v_add_f32_e32 %0, %1, %2":"=v"(r):"v"(a),"v"(b));return r;}
__device__ __forceinline__ float fsub_s(float a,float b){float r;asm("v_sub_f32_e32 %0, %1, %2":"=v"(r):"v"(a),"v"(b));return r;}
typedef float f32x2_t __attribute__((ext_vector_type(2))); typedef __bf16 bf16x2_t __attribute__((ext_vector_type(2)));
__device__ __forceinline__ unsigned cvtpk_s(float lo,float hi){f32x2_t v={lo,hi};bf16x2_t b=__builtin_convertvector(v,bf16x2_t);return __builtin_bit_cast(unsigned,b);}
#define WAIT_BAR(N) asm volatile("s_waitcnt vmcnt(" #N ") lgkmcnt(0)\n\ts_barrier":::"memory")

__device__ __forceinline__ void qkt(f32x16&p0,f32x16&p1,const char*Kslot,const bf16x8*qr,const f32x16&negm,int r32,int hi){
  const char*kb=Kslot+hi*1024+r32*16;
  #pragma unroll
  for(int d0=0;d0<4;++d0){
    const bf16x8 b0=*reinterpret_cast<const bf16x8*>(kb+d0*2048);
    const bf16x8 b1=*reinterpret_cast<const bf16x8*>(kb+d0*2048+512);
    if(d0==0){p0=__builtin_amdgcn_mfma_f32_32x32x16_bf16(b0,qr[0],negm,0,0,0);p1=__builtin_amdgcn_mfma_f32_32x32x16_bf16(b1,qr[0],negm,0,0,0);}
    else{p0=__builtin_amdgcn_mfma_f32_32x32x16_bf16(b0,qr[d0],p0,0,0,0);p1=__builtin_amdgcn_mfma_f32_32x32x16_bf16(b1,qr[d0],p1,0,0,0);}}
}
typedef __attribute__((address_space(3))) const char* lds_cptr;
typedef short v4i16_t __attribute__((ext_vector_type(4)));
__device__ __forceinline__ void kload8(bf16x8*kf,lds_cptr kp){
  kf[0]=*(const __attribute__((address_space(3))) bf16x8*)(kp);      kf[1]=*(const __attribute__((address_space(3))) bf16x8*)(kp+512);
  kf[2]=*(const __attribute__((address_space(3))) bf16x8*)(kp+2048); kf[3]=*(const __attribute__((address_space(3))) bf16x8*)(kp+2560);
  kf[4]=*(const __attribute__((address_space(3))) bf16x8*)(kp+4096); kf[5]=*(const __attribute__((address_space(3))) bf16x8*)(kp+4608);
  kf[6]=*(const __attribute__((address_space(3))) bf16x8*)(kp+6144); kf[7]=*(const __attribute__((address_space(3))) bf16x8*)(kp+6656);
}
__device__ __forceinline__ void kload2(bf16x8*kf,lds_cptr kp,int j){ kf[2*j]=*(const __attribute__((address_space(3))) bf16x8*)(kp+j*2048); kf[2*j+1]=*(const __attribute__((address_space(3))) bf16x8*)(kp+j*2048+512); }
__device__ __forceinline__ s16x4 vtr(lds_cptr p){ return __builtin_bit_cast(s16x4,__builtin_amdgcn_ds_read_tr16_b64_v4i16((__attribute__((address_space(3))) v4i16_t*)p)); }
__device__ __forceinline__ float rowmax(const f32x16&p0,const f32x16&p1){
  float a=max3f(p0[0],p0[1],p1[0]),b=max3f(p0[2],p0[3],p1[1]);a=max3f(a,p1[2],p1[3]);
  #pragma unroll
  for(int r=4;r<16;r+=4){a=max3f(a,p0[r],p0[r+1]);b=max3f(b,p0[r+2],p0[r+3]);a=max3f(a,p1[r],p1[r+1]);b=max3f(b,p1[r+2],p1[r+3]);}
  const float m=max2f(a,b);
  auto rr=__builtin_amdgcn_permlane32_swap(__float_as_uint(m),__float_as_uint(m),false,false);
  return max2f(__uint_as_float(rr[0]),__uint_as_float(rr[1]));
}
__device__ __forceinline__ void pv(f32x16*o,int vb,bf16x8 pa0,bf16x8 pa1,bf16x8 pa2,bf16x8 pa3){
  #pragma unroll
  for(int d0=0;d0<2;++d0){s16x4 lo[4],hi[4];
    #pragma unroll
    for(int ks=0;ks<4;++ks){
      asm volatile("ds_read_b64_tr_b16 %0,%1 offset:%c2":"=&v"(lo[ks]):"v"(vb),"i"(d0*4096+ks*1024):"memory");
      asm volatile("ds_read_b64_tr_b16 %0,%1 offset:%c2":"=&v"(hi[ks]):"v"(vb),"i"(d0*4096+ks*1024+512):"memory");}
    asm volatile("s_waitcnt lgkmcnt(0)":::"memory");SBAR();
    #define PK(k) (bf16x8){lo[k][0],lo[k][1],lo[k][2],lo[k][3],hi[k][0],hi[k][1],hi[k][2],hi[k][3]}
    o[d0]=__builtin_amdgcn_mfma_f32_32x32x16_bf16(pa0,PK(0),o[d0],0,0,0);
    o[d0]=__builtin_amdgcn_mfma_f32_32x32x16_bf16(pa1,PK(1),o[d0],0,0,0);
    o[d0]=__builtin_amdgcn_mfma_f32_32x32x16_bf16(pa2,PK(2),o[d0],0,0,0);
    o[d0]=__builtin_amdgcn_mfma_f32_32x32x16_bf16(pa3,PK(3),o[d0],0,0,0);
    #undef PK
  }
}

#ifndef ATTN_STORE16
#define ATTN_STORE16(p,v) (*(u32x4*)(p)=(v))
#endif
template<int THRL> __device__ __forceinline__ void attn_unit(int b,int qb,const bf16*Q,const bf16*__restrict__ K,const bf16*__restrict__ V,bf16*O,const __attribute__((address_space(3))) float*tab,char*shm){
  int tid_=threadIdx.x; asm volatile("":"+v"(tid_)); const int tid=tid_,lane=tid&63,r32=lane&31,hi=lane>>5; const int wid=__builtin_amdgcn_readfirstlane(tid>>6);
  const long rowbase=(long)b*SEQ; const int q0=qb*QB;
  const bf16*Qw=Q+(rowbase+q0+wid*QBLK)*PQ;
  const bf16*Kh=K+rowbase*PQ,*Vh=V+rowbase*PQ;
  const unsigned lds0=(unsigned)(uintptr_t)shm;
  float*wsf=(float*)(shm+LDS_WS)+wid*64;
  const bf16*ksrc=Kh+(long)lane*PQ+wid*8;
  const bf16*vsrc=Vh+(long)(16*(wid&3)+(lane>>2))*PQ+(wid>>2)*32+(lane&3)*8;
  const unsigned kdst=lds0+LDS_K+wid*1024, vdst=lds0+LDS_V+wid*1024;
  #define DMA_K(t,slot) glds16(ksrc+(long)(t)*KVBLK*PQ,(unsigned)__builtin_amdgcn_readfirstlane(kdst+(slot)))
  #define DMA_V(t,slot) glds16(vsrc+(long)(t)*KVBLK*PQ,(unsigned)__builtin_amdgcn_readfirstlane(vdst+(slot)))
  const int vb0=(int)(lds0+LDS_V)+((lane>>4)&1)*32+(lane&3)*8+(4*hi+((lane&15)>>2))*64;
  const char*Kbase=shm+LDS_K; bf16x8 kf[8];
  const lds_cptr shm3=(lds_cptr)shm; const lds_cptr kp0=shm3+LDS_K+hi*1024+r32*16; const lds_cptr vp0=shm3+LDS_V+((lane>>4)&1)*32+(lane&3)*8+(4*hi+((lane&15)>>2))*64;
  const int NT=(q0+QB)/KVBLK;
  DMA_K(0,0);DMA_V(0,0);DMA_K(1,SLOTB);
  bf16x8 qr[4];
  #pragma unroll
  for(int d0=0;d0<4;++d0)qr[d0]=*reinterpret_cast<const bf16x8*>(&Qw[(long)r32*PQ+d0*16+hi*8]);
  float mhat=0.f,l_reg=0.f;f32x16 o[2];o[0]=f32x16{};o[1]=f32x16{};f32x16 negm=f32x16{};asm volatile("":"+v"(negm));
  const int qrel=wid*QBLK+r32;
  #define CMASK(P0,P1,t) do{int jb_=(t)-(NT-4); if(jb_>=-2)cmask(P0,P1,jb_,qrel,hi,tab);}while(0)
  bool resc=false;
  #define START(P0,P1) do{ const float rm=rowmax(P0,P1); resc=false; \
    { const float dl=rm; mhat=fadd_s(mhat,dl); \
      _Pragma("unroll") for(int r=0;r<16;++r){P0[r]=fsub_s(P0[r],dl);P1[r]=fsub_s(P1[r],dl);} \
      _Pragma("unroll") for(int r=0;r<16;++r)negm[r]=-mhat; asm volatile("":"+v"(negm)); } \
    _Pragma("unroll") for(int r=0;r<16;++r)P0[r]=__builtin_amdgcn_exp2f(P0[r]); }while(0)
  #define RESC() do{ if(resc){ asm volatile("s_waitcnt lgkmcnt(0)":::"memory"); \
      _Pragma("unroll") for(int d_=0;d_<2;++d_) _Pragma("unroll") for(int r=0;r<16;++r)o[d_][r]*=wsf[crow(r,hi)]; } }while(0)
  f32x16 pA0,pA1,pB0,pB1;
  int sl_prev=0,sl_cur=0,sl_next=SLOTB;
  #define ROT() do{sl_prev=sl_cur;sl_cur=sl_next;sl_next=(sl_next==(NSLOT-1)*SLOTB)?0:sl_next+SLOTB;}while(0)
  DMA_K(2,2*SLOTB);
  WAIT_BAR(3);
  qkt(pA0,pA1,Kbase,qr,negm,r32,hi);asm volatile("s_nop 15\n\ts_nop 7":"+v"(pA0),"+v"(pA1));CMASK(pA0,pA1,0);
  START(pA0,pA1);
  _Pragma("unroll") for(int r=0;r<16;++r)pA1[r]=__builtin_amdgcn_exp2f(pA1[r]);
  WAIT_BAR(0);
  DMA_K(3,0);DMA_V(1,SLOTB);
  ROT();
  kload8(kf,kp0+sl_cur);
  WAIT_BAR(2);
  s16x4 vlo[8],vhi[8]; u32x4 pw0,pw1,pw2,pw3;
  #define PKW(P,B) cvtpk_s(P[B],P[B+1])
  #define PAF(k) __builtin_bit_cast(bf16x8,pw##k)
  #define VFR(i) (bf16x8){vlo[i][0],vlo[i][1],vlo[i][2],vlo[i][3],vhi[i][0],vhi[i][1],vhi[i][2],vhi[i][3]}
  #define PIN(x) asm volatile("":"+v"(x))
  #define MX3(a,b,c) __builtin_fmaxf(__builtin_fmaxf((a),(b)),(c))
  #define GAPA(MF,A0,A1,A2,A3,W0,W1,PW) do{ MF; sacc+=A0; sacc+=A1; sacc+=A2; sacc+=A3; PIN(sacc); W0; W1; PIN(PW); SBAR(); }while(0)
  #define EX(v) __builtin_amdgcn_exp2f(v)
  #define GAPB(MF,X,B) do{ MF; X[B]=EX(X[B]); X[B+1]=EX(X[B+1]); X[B+2]=EX(X[B+2]); X[B+3]=EX(X[B+3]); PIN(X); SBAR(); }while(0)
  #define VRD(i) do{ vlo[i]=vtr(vp_+(((i)>>2)*4096+((i)&3)*1024)); vhi[i]=vtr(vp_+(((i)>>2)*4096+((i)&3)*1024+512)); }while(0)
  #define KRD(G,j) do{ if(G){ kload2(kf,kp0+sl_next,j); SBAR(); } }while(0)
  #define STEP(C0,C1,P0,P1,t,GK,GV,GL) do{ SBAR(); \
    const lds_cptr vp_=vp0+sl_prev; \
    VRD(0); SBAR(); float sacc=(P0[0]+P0[1]); \
    GAPA(C0=__builtin_amdgcn_mfma_f32_32x32x16_bf16(kf[0],qr[0],negm,0,0,0), P0[2],P0[3],P0[4],P0[5],     pw0[0]=PKW(P0,0), pw0[1]=PKW(P0,2), pw0); \
    VRD(4); SBAR(); GAPA(C1=__builtin_amdgcn_mfma_f32_32x32x16_bf16(kf[1],qr[0],negm,0,0,0), P0[6],P0[7],P0[8],P0[9],     pw0[2]=PKW(P0,4), pw0[3]=PKW(P0,6), pw0); \
    VRD(1); SBAR(); GAPA(C0=__builtin_amdgcn_mfma_f32_32x32x16_bf16(kf[2],qr[1],C0,0,0,0),   P0[10],P0[11],P0[12],P0[13], pw1[0]=PKW(P0,8), pw1[1]=PKW(P0,10), pw1); \
    VRD(5); SBAR(); GAPA(C1=__builtin_amdgcn_mfma_f32_32x32x16_bf16(kf[3],qr[1],C1,0,0,0),   P0[14],P0[15],P1[0],P1[1],   pw1[2]=PKW(P0,12),pw1[3]=PKW(P0,14), pw1); \
    VRD(2); SBAR(); GAPA(C0=__builtin_amdgcn_mfma_f32_32x32x16_bf16(kf[4],qr[2],C0,0,0,0),   P1[2],P1[3],P1[4],P1[5],     pw2[0]=PKW(P1,0), pw2[1]=PKW(P1,2), pw2); \
    VRD(6); SBAR(); GAPA(C1=__builtin_amdgcn_mfma_f32_32x32x16_bf16(kf[5],qr[2],C1,0,0,0),   P1[6],P1[7],P1[8],P1[9],     pw2[2]=PKW(P1,4), pw2[3]=PKW(P1,6), pw2); \
    VRD(3); SBAR(); GAPA(C0=__builtin_amdgcn_mfma_f32_32x32x16_bf16(kf[6],qr[3],C0,0,0,0),   P1[10],P1[11],P1[12],P1[13], pw3[0]=PKW(P1,8), pw3[1]=PKW(P1,10), pw3); \
    VRD(7); SBAR(); GAPA(C1=__builtin_amdgcn_mfma_f32_32x32x16_bf16(kf[7],qr[3],C1,0,0,0),   P1[14],P1[15],0.f,0.f,       pw3[2]=PKW(P1,12),pw3[3]=PKW(P1,14), pw3); \
    l_reg+=sacc; \
    if(GK){DMA_K((t)+3,sl_cur);} if(GV){DMA_V((t)+1,sl_next);} \
    CMASK(C0,C1,t); \
    { float a=MX3(C0[0],C0[1],C1[0]),b=MX3(C0[2],C0[3],C1[1]); a=MX3(a,C1[2],C1[3]); \
      _Pragma("unroll") for(int r=4;r<16;r+=4){a=MX3(a,C0[r],C0[r+1]);b=MX3(b,C0[r+2],C0[r+3]);a=MX3(a,C1[r],C1[r+1]);b=MX3(b,C1[r+2],C1[r+3]);} \
      float rm=__builtin_fmaxf(a,b); { auto rr=__builtin_amdgcn_permlane32_swap(__float_as_uint(rm),__float_as_uint(rm),false,false); rm=__builtin_fmaxf(__uint_as_float(rr[0]),__uint_as_float(rr[1])); } \
      resc=false; \
      if(__builtin_expect(__any(rm>(float)THRL),0)){ const float dl=__builtin_fmaxf(rm,0.f); mhat+=dl; \
        _Pragma("unroll") for(int r=0;r<16;++r){C0[r]-=dl;C1[r]-=dl;} \
        _Pragma("unroll") for(int r=0;r<16;++r)negm[r]=-mhat; asm volatile("":"+v"(negm)); \
        const float f=__builtin_amdgcn_exp2f(-dl); l_reg*=f; if(hi==0)wsf[r32]=f; resc=true; } } \
    SBAR(); \
    GAPB(o[0]=__builtin_amdgcn_mfma_f32_32x32x16_bf16(PAF(0),VFR(0),o[0],0,0,0), C0,0); \
    GAPB(o[1]=__builtin_amdgcn_mfma_f32_32x32x16_bf16(PAF(0),VFR(4),o[1],0,0,0), C0,4); \
    KRD(GL,0); GAPB(o[0]=__builtin_amdgcn_mfma_f32_32x32x16_bf16(PAF(1),VFR(1),o[0],0,0,0), C0,8); \
    KRD(GL,1); GAPB(o[1]=__builtin_amdgcn_mfma_f32_32x32x16_bf16(PAF(1),VFR(5),o[1],0,0,0), C0,12); \
    KRD(GL,2); GAPB(o[0]=__builtin_amdgcn_mfma_f32_32x32x16_bf16(PAF(2),VFR(2),o[0],0,0,0), C1,0); \
    KRD(GL,3); GAPB(o[1]=__builtin_amdgcn_mfma_f32_32x32x16_bf16(PAF(2),VFR(6),o[1],0,0,0), C1,4); \
    GAPB(o[0]=__builtin_amdgcn_mfma_f32_32x32x16_bf16(PAF(3),VFR(3),o[0],0,0,0), C1,8); \
    GAPB(o[1]=__builtin_amdgcn_mfma_f32_32x32x16_bf16(PAF(3),VFR(7),o[1],0,0,0), C1,12); \
    }while(0)
  int t=1;
  #undef CMASK
  #define CMASK(P0,P1,t) do{}while(0)
  for(;t+7<NT;t+=2){
    STEP(pB0,pB1,pA0,pA1,t,true,true,true);     WAIT_BAR(2); RESC(); ROT();
    STEP(pA0,pA1,pB0,pB1,t+1,true,true,true);   WAIT_BAR(2); RESC(); ROT();
  }
  #undef CMASK
  #define CMASK(P0,P1,t) do{int jb_=(t)-(NT-4); if(jb_>=-2)cmask(P0,P1,jb_,qrel,hi,tab);}while(0)
  #define ENDW(tt) do{ if((tt)+3<NT){WAIT_BAR(2);} else if((tt)+2<NT){WAIT_BAR(1);} else {WAIT_BAR(0);} }while(0)
  for(;t+1<NT;t+=2){
    STEP(pB0,pB1,pA0,pA1,t,(t+3<NT),(t+1<NT),(t+1<NT));       ENDW(t);   RESC(); ROT();
    STEP(pA0,pA1,pB0,pB1,t+1,(t+4<NT),(t+2<NT),(t+2<NT));     ENDW(t+1); RESC(); ROT();
  }
  STEP(pB0,pB1,pA0,pA1,NT-1,false,false,false); RESC();
  { float sacc=pB0[0]+pB0[1]; _Pragma("unroll") for(int r=2;r<16;++r)sacc+=pB0[r]; _Pragma("unroll") for(int r=0;r<16;++r)sacc+=pB1[r]; l_reg+=sacc;
    pw0=(u32x4){PKW(pB0,0),PKW(pB0,2),PKW(pB0,4),PKW(pB0,6)};pw1=(u32x4){PKW(pB0,8),PKW(pB0,10),PKW(pB0,12),PKW(pB0,14)};pw2=(u32x4){PKW(pB1,0),PKW(pB1,2),PKW(pB1,4),PKW(pB1,6)};pw3=(u32x4){PKW(pB1,8),PKW(pB1,10),PKW(pB1,12),PKW(pB1,14)};
    SBAR(); pv(o,vb0+sl_cur,PAF(0),PAF(1),PAF(2),PAF(3)); }
  #undef PKW
  #undef PAF
  #undef VFR
  #undef PIN
  #undef MX3
  #undef GAPA
  #undef GAPB
  #undef EX
  #undef VRD
  #undef KRD
  #undef STEP
  #undef ENDW
  {auto rr=__builtin_amdgcn_permlane32_swap(__float_as_uint(l_reg),__float_as_uint(l_reg),false,false);l_reg=__uint_as_float(rr[0])+__uint_as_float(rr[1]);}
  if(hi==0)wsf[32+r32]=l_reg;asm volatile("s_waitcnt lgkmcnt(0)":::"memory");
  float rli[16];
  #pragma unroll
  for(int r=0;r<16;++r)rli[r]=__builtin_amdgcn_rcpf(wsf[32+crow(r,hi)]);
  bf16*Ow=O+(rowbase+q0+wid*QBLK)*PO;
  { bf16*stg=(bf16*)(shm+LDS_OST)+wid*2048;
    #pragma unroll
    for(int r=0;r<16;++r){const int orow=crow(r,hi);
      #pragma unroll
      for(int d0=0;d0<2;++d0)stg[orow*64+d0*32+r32]=__float2bfloat16(o[d0][r]*rli[r]);}
    asm volatile("s_waitcnt lgkmcnt(0)":::"memory");
    #pragma unroll
    for(int i=0;i<4;++i){const int row=i*8+(lane>>3),ch=lane&7; const u32x4 v=*(const u32x4*)(stg+row*64+ch*8); ATTN_STORE16(Ow+(long)row*PO+ch*8,v);} }
  asm volatile("s_waitcnt lgkmcnt(0)\n\ts_barrier":::"memory");
  #undef DMA_K
  #undef DMA_V
  #undef CMASK
  #undef START
  #undef RESC
  #undef ROT
}
constexpr int ATTN_LDS_BYTES=LDS_BYTES;
#undef SBAR
#undef WAIT_BAR
}
namespace xat {
#define XLAS __attribute__((address_space(3)))
typedef unsigned short bf16_t;
typedef short bf16x8 __attribute__((ext_vector_type(8)));
typedef float f32x16 __attribute__((ext_vector_type(16)));
typedef unsigned u32x4 __attribute__((ext_vector_type(4)));
typedef unsigned u32x2 __attribute__((ext_vector_type(2)));
typedef float f32x2_t __attribute__((ext_vector_type(2))); typedef __bf16 bf16x2_t __attribute__((ext_vector_type(2)));
__device__ __forceinline__ unsigned cvtpk(float lo, float hi) { f32x2_t v = {lo, hi}; bf16x2_t b = __builtin_convertvector(v, bf16x2_t); return __builtin_bit_cast(unsigned, b); }
constexpr int KP = 528, CHB = 32 * KP, XS_OFF = 34816, XS_BYTES = 8704, LDS_BYTES = XS_OFF + 8 * XS_BYTES;
__device__ __forceinline__ void unit(XLAS unsigned char* lds, const bf16_t* Qg, const bf16_t* Kg, const bf16_t* Vg, bf16_t* Og) {
    int tid_ = threadIdx.x; asm volatile("" : "+v"(tid_)); const int tid = tid_, lane = tid & 63, r32 = lane & 31, hi = lane >> 5; const int wid = __builtin_amdgcn_readfirstlane(tid >> 6);
    const int sr = tid >> 4, sseg = tid & 15;
    const bf16_t* kgp = Kg + (size_t)sr * 4096 + sseg * 16;
    const bf16_t* vgp = Vg + (size_t)sr * 4096 + sseg * 16;
    const unsigned wofs = (unsigned)(sr * KP + sseg * 32);
#define XAT_SRC(c) ((c) < 8 ? kgp + (size_t)(c) * 32 * 4096 : vgp + (size_t)((c) - 8) * 32 * 4096)
    u32x4 g[2][2];
    g[0][0] = *(const u32x4*)(XAT_SRC(0)); g[0][1] = *(const u32x4*)(XAT_SRC(0) + 8); g[1][0] = *(const u32x4*)(XAT_SRC(1)); g[1][1] = *(const u32x4*)(XAT_SRC(1) + 8);
    XLAS unsigned char* xs = lds + XS_OFF + wid * XS_BYTES;
    bf16x8 qf[16];
#pragma unroll
    for (int hq = 0; hq < 2; ++hq) {
        const bf16_t* qbase = Qg + (size_t)(wid * 32 + (lane >> 4)) * 1024 + hq * 128 + (lane & 15) * 8;
        u32x4 qv[8];
#pragma unroll
        for (int i = 0; i < 8; ++i) qv[i] = *(const u32x4*)(qbase + (size_t)(4 * i) * 1024);
#pragma unroll
        for (int i = 0; i < 8; ++i) *(XLAS u32x4*)(xs + (4 * i + (lane >> 4)) * 272 + (lane & 15) * 16) = qv[i];
#pragma unroll
        for (int s = 0; s < 8; ++s) qf[hq * 8 + s] = *(const XLAS bf16x8*)(xs + r32 * 272 + s * 32 + hi * 16);
    }
    const int krow = (r32 & 0x13) | ((r32 & 4) << 1) | ((r32 & 8) >> 1);
    const unsigned kro = (unsigned)(krow * KP + hi * 16), vro = (unsigned)(r32 * KP + hi * 16);
    f32x16 S[8];
#pragma unroll
    for (int c = 0; c < 8; ++c) {
        XLAS unsigned char* buf = lds + (c & 1) * CHB;
        *(XLAS u32x4*)(buf + wofs) = g[c & 1][0]; *(XLAS u32x4*)(buf + wofs + 16) = g[c & 1][1];
        __syncthreads();
        { g[c & 1][0] = *(const u32x4*)(XAT_SRC(c + 2)); g[c & 1][1] = *(const u32x4*)(XAT_SRC(c + 2) + 8); }
        f32x16 a = {};
        bf16x8 kfa[4], kfb[4];
#pragma unroll
        for (int j = 0; j < 4; ++j) kfa[j] = *(const XLAS bf16x8*)(buf + kro + j * 32);
#pragma unroll
        for (int gq = 0; gq < 4; gq += 2) {
#pragma unroll
            for (int j = 0; j < 4; ++j) kfb[j] = *(const XLAS bf16x8*)(buf + kro + (4 * gq + 4 + j) * 32);
            __builtin_amdgcn_sched_barrier(0);
#pragma unroll
            for (int j = 0; j < 4; ++j) a = __builtin_amdgcn_mfma_f32_32x32x16_bf16(kfa[j], qf[4 * gq + j], a, 0, 0, 0);
            if (gq < 2) {
#pragma unroll
                for (int j = 0; j < 4; ++j) kfa[j] = *(const XLAS bf16x8*)(buf + kro + (4 * gq + 8 + j) * 32); }
            __builtin_amdgcn_sched_barrier(0);
#pragma unroll
            for (int j = 0; j < 4; ++j) a = __builtin_amdgcn_mfma_f32_32x32x16_bf16(kfb[j], qf[4 * gq + 4 + j], a, 0, 0, 0);
        }
        S[c] = a;
    }
    float mx = S[0][0];
#pragma unroll
    for (int c = 0; c < 8; ++c)
#pragma unroll
        for (int r = 0; r < 16; ++r) mx = __builtin_fmaxf(mx, S[c][r]);
    mx = __builtin_fmaxf(mx, __shfl_xor(mx, 32));
    float l = 0.f;
    u32x4 pw[8][2];
#pragma unroll
    for (int c = 0; c < 8; ++c) {
        f32x16 p;
#pragma unroll
        for (int r = 0; r < 16; ++r) { p[r] = __builtin_amdgcn_exp2f(S[c][r] - mx); l += p[r]; }
#pragma unroll
        for (int s = 0; s < 2; ++s) { pw[c][s].x = cvtpk(p[8 * s + 0], p[8 * s + 1]); pw[c][s].y = cvtpk(p[8 * s + 2], p[8 * s + 3]); pw[c][s].z = cvtpk(p[8 * s + 4], p[8 * s + 5]); pw[c][s].w = cvtpk(p[8 * s + 6], p[8 * s + 7]); }
    }
    l += __shfl_xor(l, 32);
    const float rl = 1.0f / l;
    bf16_t* obase = Og + (size_t)(wid * 32 + (lane >> 3)) * 1024 + (lane & 7) * 8;
#pragma unroll
    for (int db = 0; db < 8; ++db) {
        XLAS unsigned char* buf = lds + (db & 1) * CHB;
        *(XLAS u32x4*)(buf + wofs) = g[db & 1][0]; *(XLAS u32x4*)(buf + wofs + 16) = g[db & 1][1];
        __syncthreads();
        if (db < 6) { g[db & 1][0] = *(const u32x4*)(XAT_SRC(db + 10)); g[db & 1][1] = *(const u32x4*)(XAT_SRC(db + 10) + 8); }
        f32x16 o = {};
#pragma unroll
        for (int kb = 0; kb < 8; ++kb)
#pragma unroll
            for (int s = 0; s < 2; ++s) { const bf16x8 vf = *(const XLAS bf16x8*)(buf + vro + kb * 64 + s * 32); o = __builtin_amdgcn_mfma_f32_32x32x16_bf16(vf, __builtin_bit_cast(bf16x8, pw[kb][s]), o, 0, 0, 0); }
#pragma unroll
        for (int g4 = 0; g4 < 4; ++g4) { u32x2 w; w.x = cvtpk(o[4 * g4] * rl, o[4 * g4 + 1] * rl); w.y = cvtpk(o[4 * g4 + 2] * rl, o[4 * g4 + 3] * rl);
            *(XLAS u32x2*)(xs + r32 * 144 + ((db & 1) * 32 + 8 * g4 + 4 * hi) * 2) = w; }
        if (db & 1) {
#pragma unroll
            for (int i = 0; i < 4; ++i) { const u32x4 v = *(const XLAS u32x4*)(xs + (8 * i + (lane >> 3)) * 144 + (lane & 7) * 16); *(u32x4*)(obase + (size_t)(8 * i) * 1024 + (db >> 1) * 64) = v; }
        }
    }
}
#undef XAT_SRC
}
#define GAS __attribute__((address_space(1)))
#define LAS __attribute__((address_space(3)))
typedef unsigned short bf16;
typedef unsigned v4u __attribute__((ext_vector_type(4)));
typedef unsigned v2u __attribute__((ext_vector_type(2)));
typedef float f32x4 __attribute__((ext_vector_type(4)));
constexpr int NWAVES = 8;
constexpr int M = 65536, SEQ = 4096, DM = 1024, NMEM = 256, DEPTH = 4;
constexpr float LOG2E = 1.4426950408889634f;
constexpr float C2A = 0.125f * LOG2E;
constexpr float C2X = 0.0625f * LOG2E;
constexpr float LAMBDA_INIT0 = 0.2f, LAMBDA_INIT2 = 0.47071301834f;
constexpr float EPS = 1e-6f;
constexpr size_t MiB = 1u << 20;
constexpr size_t WS_SMALL = 1 * MiB;
constexpr size_t WS_WIN = 2 * MiB, WS_WOUT = 10 * MiB, WS_CIN = 14 * MiB, WS_COUT = 26 * MiB, WS_WQ = 30 * MiB, WS_WK = 38 * MiB, WS_WV = 46 * MiB, WS_WO = 54 * MiB, WS_W1 = 62 * MiB, WS_W2 = 94 * MiB;
constexpr size_t WS_MEMN = 126 * MiB, WS_KB = 134 * MiB, WS_VT = 166 * MiB, WS_SSQ = 198 * MiB, WS_HB = 202 * MiB, WS_MIX = 330 * MiB, WS_BIG = 458 * MiB, WS_ORAW = WS_BIG + 384 * MiB, WS_END = 970 * MiB;
constexpr int TABN = 704;
constexpr int LDS_BYTES = 147456, TAB_OFF = attn_body::LDS_TAB;
static_assert(attn_body::ATTN_LDS_BYTES <= 131072 && TABN * 4 <= 3072 && xat::LDS_BYTES <= 131072, "LDS map");

__device__ __forceinline__ float bf_lo(unsigned w) { return __uint_as_float(w << 16); }
__device__ __forceinline__ float bf_hi(unsigned w) { return __uint_as_float(w & 0xffff0000u); }
__device__ __forceinline__ unsigned pk2(float lo, float hi) { return pg8::cvt_pk_bf16(lo, hi); }
__device__ __forceinline__ float wave_sum(float v) {
#pragma unroll
    for (int o = 1; o < 64; o <<= 1) v += __shfl_xor(v, o);
    return v;
}
__device__ __forceinline__ void transpose_item(const float* W, int ldn, int Nc, bf16* WT, int ldk, int row_off, const float* rs, int ncs, float cs, LAS float* scr, int item, int lane) {
    const int nblk = Nc / 32, kb = item / nblk, nb = item % nblk, k0 = 64 * kb, n0 = 32 * nb;
    const float csl = (n0 + (lane & 31) < ncs) ? cs : 1.f;
#pragma unroll 8
    for (int i = 0; i < 32; ++i) { const int kk = 2 * i + (lane >> 5); float v = W[(size_t)(k0 + kk) * ldn + n0 + (lane & 31)] * csl; if (rs) v *= rs[k0 + kk]; scr[kk * 33 + (lane & 31)] = v; }
    asm volatile("s_waitcnt lgkmcnt(0)" ::: "memory");
    const int c = lane & 7;
#pragma unroll
    for (int j = 0; j < 4; ++j) { const int n = (lane >> 3) + 8 * j; const LAS float* s = scr + (8 * c) * 33 + n;
        v4u o; o.x = pk2(s[0 * 33], s[1 * 33]); o.y = pk2(s[2 * 33], s[3 * 33]); o.z = pk2(s[4 * 33], s[5 * 33]); o.w = pk2(s[6 * 33], s[7 * 33]);
        *(v4u*)(WT + (size_t)(row_off + n0 + n) * ldk + k0 + 8 * c) = o; }
    asm volatile("s_waitcnt lgkmcnt(0)" ::: "memory");
}
struct Args { const float* in[25]; float* out; unsigned char* ws; int lo, hi; };
enum { I_X = 0, I_MEM, I_RELB, I_MEMG, I_NMIXG, I_NXG, I_NMLPG, I_FING, I_ABWIN, I_ABWOUT, I_LQ1, I_LK1, I_LQ2, I_LK2, I_SUBLN, I_POOLW, I_POOLS, I_CWIN, I_CW, I_CWOUT, I_WQ, I_WKV, I_WO, I_W1, I_W2 };
enum { K_PRO = 0, K_MIXPROJ, K_ATTN, K_COMBINE, K_CONV, K_MIXOUT, K_XQ, K_XATTN, K_XO, K_UP, K_DOWN, K_FINAL };
constexpr int NPHASE = 30;
__host__ __device__ inline void decode_phase(int ph, int& kind, int& l) {
    if (ph == 0) { kind = K_PRO; l = 0; return; }
    if (ph == NPHASE - 1) { kind = K_FINAL; l = 0; return; }
    const int p0 = ph - 1; l = p0 / 7; const int p = p0 - 7 * l;
    kind = p == 0 ? K_MIXPROJ : p == 1 ? ((l & 1) == 0 ? K_ATTN : K_CONV) : p == 2 ? K_MIXOUT : p == 3 ? K_XQ : p == 4 ? K_XO : p == 5 ? K_UP : K_DOWN;
}

#define XB_TMO      128
#define XB_XCNT(j)  (256  + 64 * (j))
#define XB_XSUB(j)  (1280 + 64 * (j))
#define XB_XGEN(j)  (2304 + 64 * (j))
#define XB_TOP      3328
#define XB_TOPGEN   3392
#define XCD_BAR_WORDS 3456
#define XB_SPIN_CAP (1u << 22)

__device__ __forceinline__ unsigned xb_ld(unsigned* p)              { return __hip_atomic_load(p, __ATOMIC_RELAXED, __HIP_MEMORY_SCOPE_AGENT); }
__device__ __forceinline__ unsigned xb_add(unsigned* p, unsigned v) { return __hip_atomic_fetch_add(p, v, __ATOMIC_RELAXED, __HIP_MEMORY_SCOPE_AGENT); }
__device__ __forceinline__ unsigned xb_xcc_id() { return (unsigned)__builtin_amdgcn_s_getreg((3 << 11) | 20) & 0xFu; }
#define XB_SPIN(cond, bar) do { unsigned _sp = 0; while (cond) { __builtin_amdgcn_s_sleep(1); \
    if ((++_sp & 255u) == 0u) { if (xb_ld(&(bar)[XB_TMO])) break; if (_sp > XB_SPIN_CAP) { atomicAdd(&(bar)[XB_TMO], 1u); break; } } } } while (0)

struct XcdBarrier {
    unsigned* bar; unsigned x;
    volatile LAS unsigned* st;
};

__device__ __forceinline__ XcdBarrier xcd_barrier_post(unsigned* bar, volatile LAS unsigned* st) {
    XcdBarrier b; b.bar = bar; b.x = xb_xcc_id(); b.st = st;
    if (threadIdx.x == 0) (void)xb_add(&bar[XB_XCNT(b.x)], 1u);
    return b;
}
__device__ __forceinline__ void xcd_barrier_complete(unsigned* bar, unsigned x, unsigned& nloc, unsigned& nx) {
    const unsigned G = gridDim.x * gridDim.y * gridDim.z;
    unsigned sum, cnt, mine, sp = 0u;
    for (;;) {
        sum = 0u; cnt = 0u; mine = 0u;
#pragma unroll
        for (unsigned j = 0; j < 16; ++j) { const unsigned c = xb_ld(&bar[XB_XCNT(j)]); sum += c; cnt += (c > 0u) ? 1u : 0u; mine = (j == x) ? c : mine; }
        if (sum == G) break;
        __builtin_amdgcn_s_sleep(1);
        if ((++sp & 255u) == 0u) { if (xb_ld(&bar[XB_TMO])) break; if (sp > XB_SPIN_CAP) { atomicAdd(&bar[XB_TMO], 1u); break; } }
    }
    nloc = mine > 0u ? mine : 1u; nx = cnt > 0u ? cnt : 1u;
}

__device__ __forceinline__ void xcd_barrier(const XcdBarrier& b) {
    asm volatile("s_waitcnt vmcnt(0)" ::: "memory");
    __syncthreads();
    if (threadIdx.x == 0) {
        unsigned* bar = b.bar;
        __builtin_amdgcn_s_waitcnt(0);
        unsigned nloc = b.st[0], nx = b.st[1];
        if (nloc == 0u) { xcd_barrier_complete(bar, b.x, nloc, nx); b.st[0] = nloc; b.st[1] = nx; }
        const unsigned old = xb_add(&bar[XB_XSUB(b.x)], 1u);
        const unsigned gen = old / nloc;
        if (old + 1u == (gen + 1u) * nloc) {
            __builtin_amdgcn_fence(__ATOMIC_RELEASE, "agent");
            asm volatile("s_waitcnt vmcnt(0)" ::: "memory");
            const unsigned og = xb_add(&bar[XB_TOP], 1u);
            const unsigned tg = og / nx;
            if (og + 1u == (tg + 1u) * nx) xb_add(&bar[XB_TOPGEN], 1u);
            else XB_SPIN(xb_ld(&bar[XB_TOPGEN]) == tg, bar);
            __builtin_amdgcn_fence(__ATOMIC_ACQUIRE, "agent");
            xb_add(&bar[XB_XGEN(b.x)], 1u);
            asm volatile("s_waitcnt vmcnt(0)" ::: "memory");
        } else {
            XB_SPIN(xb_ld(&bar[XB_XGEN(b.x)]) == gen, bar);
            __builtin_amdgcn_fence(__ATOMIC_ACQUIRE, "agent");
            asm volatile("s_waitcnt vmcnt(0)" ::: "memory");
        }
    }
    __syncthreads();
}

constexpr int XB_ST_OFF = LDS_BYTES - 64;
__global__ void __launch_bounds__(NWAVES * 64, 2) trunk_fwd(Args args) {
    extern __shared__ __attribute__((aligned(16))) unsigned char lds[];
    cg::grid_group grid = cg::this_grid();
    LAS unsigned char* L = (LAS unsigned char*)lds;
    if (threadIdx.x == 0) { ((volatile LAS unsigned*)(L + XB_ST_OFF))[0] = 0u; ((volatile LAS unsigned*)(L + XB_ST_OFF))[1] = 0u; }
    __syncthreads();
    if (blockIdx.x == 0) for (int i = threadIdx.x; i < XCD_BAR_WORDS; i += NWAVES * 64) ((unsigned*)args.ws)[i] = 0u;
    const int ph_hi = args.hi; int ph0 = args.lo;
    if (ph0 == 0) {
        const int l = 0, li = 0; (void)l; (void)li;
        int tid_ = threadIdx.x, G_ = gridDim.x, bid_ = blockIdx.x; asm volatile("" : "+v"(tid_), "+s"(G_), "+s"(bid_));
        const int tid = tid_, lane = tid & 63, wid = __builtin_amdgcn_readfirstlane(tid >> 6), G = G_, bid = bid_, gw = bid * NWAVES + wid, NGW = G * NWAVES;
        const __attribute__((address_space(4))) Args* ap = (const __attribute__((address_space(4))) Args*)__builtin_amdgcn_kernarg_segment_ptr();
        asm volatile("" : "+s"(ap));
#define ARGIN(i) (ap->in[i])
        unsigned char* ws = ap->ws;
        float* out = ap->out;
        float* TAB = (float*)(ws + WS_SMALL); float* LAM = (float*)(ws + WS_SMALL + 16384);
        bf16* WIN = (bf16*)(ws + WS_WIN); bf16* WOUT = (bf16*)(ws + WS_WOUT); bf16* CIN = (bf16*)(ws + WS_CIN); bf16* COUT = (bf16*)(ws + WS_COUT);
        bf16* WQ = (bf16*)(ws + WS_WQ); bf16* WK = (bf16*)(ws + WS_WK); bf16* WV = (bf16*)(ws + WS_WV); bf16* WO = (bf16*)(ws + WS_WO); bf16* W1 = (bf16*)(ws + WS_W1); bf16* W2 = (bf16*)(ws + WS_W2);
        bf16* MEMN = (bf16*)(ws + WS_MEMN); bf16* KB = (bf16*)(ws + WS_KB); bf16* VT = (bf16*)(ws + WS_VT); float* SSQ = (float*)(ws + WS_SSQ);
        bf16* HB = (bf16*)(ws + WS_HB); bf16* MIX = (bf16*)(ws + WS_MIX); bf16* BIG = (bf16*)(ws + WS_BIG); bf16* ORAW = (bf16*)(ws + WS_ORAW);
#ifndef DIS_PRO
            LAS float* scr = (LAS float*)(L + wid * 16384);
            constexpr int NIT = 15616;
            struct TD { const float* W; const float* rs; bf16* WT; int ldn, Nc, ldk, ncs, item, remap; float cs; };
#define TDESC(R, D) do { int r = (R); D.rs = nullptr; D.ldk = 1024; D.ncs = 0; D.cs = 1.f; D.remap = 0; \
                if (r < 1024) { const int i = r >> 9; D.W = ARGIN(I_ABWIN) + (size_t)i * 1024 * 2048; D.ldn = 2048; D.Nc = 2048; D.WT = WIN + (size_t)i * 2048 * 1024; D.rs = ARGIN(I_NMIXG) + (2 * i) * 1024; D.ncs = 512; D.cs = C2A; D.item = r & 511; } \
                else if ((r -= 1024) < 256) { const int i = r >> 7; D.W = ARGIN(I_ABWOUT) + (size_t)i * 1024 * 1024; D.ldn = 1024; D.Nc = 1024; D.WT = WOUT + (size_t)i * 1024 * 1024; D.item = r & 127; } \
                else if ((r -= 256) < 1536) { const int i = r / 768; D.W = ARGIN(I_CWIN) + (size_t)i * 1024 * 3072; D.ldn = 3072; D.Nc = 3072; D.WT = CIN + (size_t)i * 3072 * 1024; D.rs = ARGIN(I_NMIXG) + (2 * i + 1) * 1024; D.item = r % 768; D.remap = 1; } \
                else if ((r -= 1536) < 512) { const int i = r >> 8; D.W = ARGIN(I_CWOUT) + (size_t)i * 1024 * 1024; D.ldn = 1024; D.Nc = 1024; D.WT = COUT + (size_t)i * 1024 * 1024; D.item = r & 255; } \
                else if ((r -= 512) < 1024) { const int i = r >> 8; D.W = ARGIN(I_WQ) + (size_t)i * 1024 * 1024; D.ldn = 1024; D.Nc = 1024; D.WT = WQ + (size_t)i * 1024 * 1024; D.rs = ARGIN(I_NXG) + i * 1024; D.ncs = 1024; D.cs = C2X; D.item = r & 255; } \
                else if ((r -= 1024) < 1024) { const int i = r >> 8; D.W = ARGIN(I_WKV) + (size_t)i * 1024 * 2048; D.ldn = 2048; D.Nc = 1024; D.WT = WK + (size_t)i * 1024 * 1024; D.item = r & 255; } \
                else if ((r -= 1024) < 1024) { const int i = r >> 8; D.W = ARGIN(I_WKV) + (size_t)i * 1024 * 2048 + 1024; D.ldn = 2048; D.Nc = 1024; D.WT = WV + (size_t)i * 1024 * 1024; D.item = r & 255; } \
                else if ((r -= 1024) < 1024) { const int i = r >> 8; D.W = ARGIN(I_WO) + (size_t)i * 1024 * 1024; D.ldn = 1024; D.Nc = 1024; D.WT = WO + (size_t)i * 1024 * 1024; D.item = r & 255; } \
                else if ((r -= 1024) < 4096) { const int i = r >> 10; D.W = ARGIN(I_W1) + (size_t)i * 1024 * 4096; D.ldn = 4096; D.Nc = 4096; D.WT = W1 + (size_t)i * 4096 * 1024; D.rs = ARGIN(I_NMLPG) + i * 1024; D.item = r & 1023; } \
                else { r -= 4096; const int i = r >> 10; D.W = ARGIN(I_W2) + (size_t)i * 4096 * 1024; D.ldn = 1024; D.Nc = 1024; D.WT = W2 + (size_t)i * 1024 * 4096; D.ldk = 4096; D.item = r & 1023; } } while (0)
#define TLOAD(D, V) do { const int nblk_ = D.Nc / 64, kb_ = D.item / nblk_, nb_ = D.item % nblk_; const float* wp_ = D.W + (size_t)(64 * kb_ + (lane >> 4)) * D.ldn + 64 * nb_ + (lane & 15) * 4; \
                _Pragma("unroll") for (int i = 0; i < 16; ++i) V[i] = *(const f32x4*)(wp_ + (size_t)(4 * i) * D.ldn); } while (0)
            { f32x4 tv[16]; TD d, dn; int it = gw; bool have = it < NIT;
              LAS float* scr2 = (LAS float*)(L + wid * 16640);
              if (have) { TDESC(it, d); TLOAD(d, tv); }
              while (have) {
                const int itn = it + NGW; const bool hn = itn < NIT;
                const int nblk = d.Nc / 64, kb = d.item / nblk, nb = d.item % nblk, k0 = 64 * kb, n0 = 64 * nb;
                const int n4 = (lane & 15) * 4, kq = lane >> 4;
                const int on0 = !d.remap || n0 < 1024 ? n0 : (n0 < 2048 ? 1024 + ((n0 - 1024) >> 7) * 256 + ((n0 - 1024) & 127) : 1024 + ((n0 - 2048) >> 7) * 256 + 128 + ((n0 - 2048) & 127));
                const float csl = (n0 + n4 < d.ncs) ? d.cs : 1.f;
#pragma unroll
                for (int i = 0; i < 16; ++i) { const int kk = 4 * i + kq; float sc = csl; if (d.rs) sc *= d.rs[k0 + kk];
                    scr2[(n4 + 0) * 65 + kk] = tv[i][0] * sc; scr2[(n4 + 1) * 65 + kk] = tv[i][1] * sc; scr2[(n4 + 2) * 65 + kk] = tv[i][2] * sc; scr2[(n4 + 3) * 65 + kk] = tv[i][3] * sc; }
                if (hn) { TDESC(itn, dn); TLOAD(dn, tv); }
                asm volatile("s_waitcnt lgkmcnt(0)" ::: "memory");
                const int c = lane & 7;
#pragma unroll
                for (int j = 0; j < 8; ++j) { const int n = (lane >> 3) + 8 * j; const LAS float* sp = scr2 + n * 65 + 8 * c;
                    v4u o; o.x = pk2(sp[0], sp[1]); o.y = pk2(sp[2], sp[3]); o.z = pk2(sp[4], sp[5]); o.w = pk2(sp[6], sp[7]);
                    *(v4u*)(d.WT + (size_t)(on0 + n) * d.ldk + k0 + 8 * c) = o; }
                asm volatile("s_waitcnt lgkmcnt(0)" ::: "memory");
                d = dn; it = itn; have = hn;
              } }
#undef TDESC
#undef TLOAD
            for (int t = gw; t < 2 * 4 * 16 * 16; t += NGW) {
                const int nb = t & 15, c8 = (t >> 4) & 15, g = (t >> 8) & 3, i = t >> 10, n = nb * 64 + lane;
                const float* pw = ARGIN(I_POOLW) + ((size_t)(i * 4 + g) * 128 + c8 * 8) * 128; const float* psc = ARGIN(I_POOLS) + i * 512 + g * 128;
                const float* wo = ARGIN(I_ABWOUT) + (size_t)i * 1024 * 1024 + (size_t)(512 + g * 128) * 1024 + n;
                float a[8];
#pragma unroll
                for (int e = 0; e < 8; ++e) a[e] = 0.f;
#pragma unroll 8
                for (int d = 0; d < 128; ++d) { const float w = wo[(size_t)d * 1024] * psc[d];
#pragma unroll
                    for (int e = 0; e < 8; ++e) a[e] += pw[e * 128 + d] * w; }
                v4u o; o.x = pk2(a[0], a[1]); o.y = pk2(a[2], a[3]); o.z = pk2(a[4], a[5]); o.w = pk2(a[6], a[7]);
                *(v4u*)(WOUT + (size_t)i * 1024 * 1024 + (size_t)n * 1024 + 512 + g * 128 + c8 * 8) = o;
            }
            for (int row = gw; row < 16 * NMEM; row += NGW) {
                const f32x4* xr = (const f32x4*)(ARGIN(I_MEM) + (size_t)row * DM) + lane; const f32x4* gr = (const f32x4*)(ARGIN(I_MEMG)) + lane;
                f32x4 v[4]; float s = 0.f;
#pragma unroll
                for (int j = 0; j < 4; ++j) { v[j] = xr[64 * j]; s += (v[j][0] * v[j][0] + v[j][1] * v[j][1]) + (v[j][2] * v[j][2] + v[j][3] * v[j][3]); }
                const float rstd = __builtin_amdgcn_rsqf(wave_sum(s) * (1.f / DM) + EPS);
                v2u* o8 = (v2u*)(MEMN + (size_t)row * DM) + lane;
#pragma unroll
                for (int j = 0; j < 4; ++j) { const f32x4 g4 = gr[64 * j]; v2u w; w.x = pk2(v[j][0] * rstd * g4[0], v[j][1] * rstd * g4[1]); w.y = pk2(v[j][2] * rstd * g4[2], v[j][3] * rstd * g4[3]); o8[64 * j] = w; }
            }
            for (int row = gw; row < M; row += 2 * NGW) {
                const int row1 = row + NGW;
                const f32x4* xr0 = (const f32x4*)(ARGIN(I_X) + (size_t)row * DM) + lane; const f32x4* xr1 = (const f32x4*)(ARGIN(I_X) + (size_t)row1 * DM) + lane;
                f32x4 v0[4], v1[4];
#pragma unroll
                for (int j = 0; j < 4; ++j) { v0[j] = xr0[64 * j]; v1[j] = xr1[64 * j]; }
                v2u* o80 = (v2u*)(HB + (size_t)row * DM) + lane; v2u* o81 = (v2u*)(HB + (size_t)row1 * DM) + lane;
                float s0 = 0.f, s1 = 0.f;
#pragma unroll
                for (int j = 0; j < 4; ++j) { s0 += (v0[j][0] * v0[j][0] + v0[j][1] * v0[j][1]) + (v0[j][2] * v0[j][2] + v0[j][3] * v0[j][3]); s1 += (v1[j][0] * v1[j][0] + v1[j][1] * v1[j][1]) + (v1[j][2] * v1[j][2] + v1[j][3] * v1[j][3]);
                    v2u w; w.x = pk2(v0[j][0], v0[j][1]); w.y = pk2(v0[j][2], v0[j][3]); o80[64 * j] = w; w.x = pk2(v1[j][0], v1[j][1]); w.y = pk2(v1[j][2], v1[j][3]); o81[64 * j] = w; }
                s0 = wave_sum(s0); s1 = wave_sum(s1);
                if (lane < 16) { SSQ[(size_t)row * 16 + lane] = (lane == 0) ? s0 : 0.f; SSQ[(size_t)row1 * 16 + lane] = (lane == 0) ? s1 : 0.f; }
            }
            for (int e = bid * 512 + tid; e < 4 * TABN; e += G * 512) {
                const int h = e / TABN, d = e % TABN - 256; float v;
                if (d < 0) v = -INFINITY;
                else { int bk; if (d < 16) bk = d; else { bk = 16 + (int)(__builtin_amdgcn_logf((float)d * 0.0625f) * (16.0f / 3.0f)); bk = bk < 31 ? bk : 31; }
                       v = (ARGIN(I_RELB)[bk * 4 + h] - ARGIN(I_RELB)[31 * 4 + h]) * LOG2E; }
                TAB[e] = v;
            }
            if (bid == 0 && tid < 2) {
                float a = 0.f, b = 0.f;
                for (int d = 0; d < 64; ++d) { a += ARGIN(I_LQ1)[tid * 64 + d] * ARGIN(I_LK1)[tid * 64 + d]; b += ARGIN(I_LQ2)[tid * 64 + d] * ARGIN(I_LK2)[tid * 64 + d]; }
                LAM[tid] = __builtin_amdgcn_exp2f(a * LOG2E) - __builtin_amdgcn_exp2f(b * LOG2E) + (tid == 0 ? LAMBDA_INIT0 : LAMBDA_INIT2);
            }
#endif
        ph0 = 1; if (ph0 < ph_hi) grid.sync();
#undef ARGIN
    }
    (void)xcd_barrier_post((unsigned*)args.ws, (volatile LAS unsigned*)(L + XB_ST_OFF));
    for (int ph = ph0; ph < ph_hi; ++ph) {
        int kind, l; decode_phase(ph, kind, l); const int li = l >> 1;
        int tid_ = threadIdx.x, G_ = gridDim.x, bid_ = blockIdx.x; asm volatile("" : "+v"(tid_), "+s"(G_), "+s"(bid_));
        const int tid = tid_, lane = tid & 63, wid = __builtin_amdgcn_readfirstlane(tid >> 6), G = G_, bid = bid_, gw = bid * NWAVES + wid, NGW = G * NWAVES;
        const __attribute__((address_space(4))) Args* ap = (const __attribute__((address_space(4))) Args*)__builtin_amdgcn_kernarg_segment_ptr();
        asm volatile("" : "+s"(ap));
#define ARGIN(i) (ap->in[i])
        unsigned char* ws = ap->ws;
        float* out = ap->out;
        float* TAB = (float*)(ws + WS_SMALL); float* LAM = (float*)(ws + WS_SMALL + 16384);
        bf16* WIN = (bf16*)(ws + WS_WIN); bf16* WOUT = (bf16*)(ws + WS_WOUT); bf16* CIN = (bf16*)(ws + WS_CIN); bf16* COUT = (bf16*)(ws + WS_COUT);
        bf16* WQ = (bf16*)(ws + WS_WQ); bf16* WK = (bf16*)(ws + WS_WK); bf16* WV = (bf16*)(ws + WS_WV); bf16* WO = (bf16*)(ws + WS_WO); bf16* W1 = (bf16*)(ws + WS_W1); bf16* W2 = (bf16*)(ws + WS_W2);
        bf16* MEMN = (bf16*)(ws + WS_MEMN); bf16* KB = (bf16*)(ws + WS_KB); bf16* VT = (bf16*)(ws + WS_VT); float* SSQ = (float*)(ws + WS_SSQ);
        bf16* HB = (bf16*)(ws + WS_HB); bf16* MIX = (bf16*)(ws + WS_MIX); bf16* BIG = (bf16*)(ws + WS_BIG); bf16* ORAW = (bf16*)(ws + WS_ORAW);
        if (kind == K_MIXPROJ || kind == K_XQ) {
            if (kind == K_MIXPROJ && l == 0) {
                for (int z = 0; z < 2; ++z) {
                    pg8::Gemm g{z == 0 ? MEMN : WV, z == 0 ? WK : MEMN, 4096, 4096, 1024}; pg8::StaticOrder S; S.init(4096, 4096, G, bid);
                    pg8::EpiProj<0, false> E{0x7fffffff, 0, z == 0 ? KB : VT, 4096, nullptr, nullptr, 0};
#ifndef DIS_G0
                    pg8::gemm_phase<pg8::EpiProj<0, false>, pg8::StaticOrder, true, true>(L, g, S, E);
#endif
                }
            }
            const bf16* Bt; int N;
            if (kind == K_XQ) { Bt = WQ + (size_t)l * 1024 * 1024; N = 1024; }
            else if ((l & 1) == 0) { Bt = WIN + (size_t)li * 2048 * 1024; N = 2048; }
            else { Bt = CIN + (size_t)li * 3072 * 1024; N = 3072; }
            pg8::Gemm g{HB, Bt, M, N, 1024}; pg8::StaticOrder S; S.init(M, N, G, bid);
#define PG8_LAS __attribute__((address_space(3)))
            const PG8_LAS float* rsl = nullptr; int pm0 = 0;
            if (G == 256) {
                PG8_LAS float* rw = (PG8_LAS float*)(L + 131072); pg8::Unit u0, uu; S.next(0, u0); pm0 = u0.pm; int last = -1;
                for (int i = 0; S.next(i, uu); ++i) { const int slot = (uu.pm - pm0) >> 3; if (slot != last && slot >= 0 && slot < 8) { if (tid < 256) rw[slot * 256 + tid] = pg8::row_rstd(SSQ, uu.pm * 256 + tid); last = slot; } }
                asm volatile("s_waitcnt vmcnt(0) lgkmcnt(0)" ::: "memory"); __syncthreads(); rsl = rw;
            }
            pg8::EpiProj<0, true> E{N == 3072 ? 4 : 0x7fffffff, 1024, BIG, N == 3072 ? 2048 : N, SSQ, rsl, pm0};
#ifndef DIS_G1
            pg8::gemm_phase<pg8::EpiProj<0, true>, pg8::StaticOrder, true, true>(L, g, S, E);
#endif
            if (kind == K_XQ) {
                asm volatile("s_waitcnt vmcnt(0)" ::: "memory"); __syncthreads();
                pg8::Unit xu;
                for (int i = 0; S.next(i, xu); ++i) { const int tm = xu.pm, h = xu.pn, b = tm >> 4;
#ifndef DIS_XAT
                    xat::unit(L, BIG + (size_t)tm * 256 * 1024 + h * 256, KB + (size_t)b * 256 * 4096 + l * 1024 + h * 256, VT + (size_t)(l * 1024 + h * 256) * 4096 + b * 256, MIX + (size_t)tm * 256 * 1024 + h * 256);
#endif
                }
            }
        }
        else if (kind == K_UP) {
            pg8::Gemm g{HB, W1 + (size_t)l * 4096 * 1024, M, 4096, 1024}; pg8::StaticOrder S; S.init(M, 4096, G, bid);
            const PG8_LAS float* rsl = nullptr; int pm0 = 0;
            if (G == 256) {
                PG8_LAS float* rw = (PG8_LAS float*)(L + 131072); pg8::Unit u0, uu; S.next(0, u0); pm0 = u0.pm; int last = -1;
                for (int i = 0; S.next(i, uu); ++i) { const int slot = (uu.pm - pm0) >> 3; if (slot != last && slot >= 0 && slot < 8) { if (tid < 256) rw[slot * 256 + tid] = pg8::row_rstd(SSQ, uu.pm * 256 + tid); last = slot; } }
                asm volatile("s_waitcnt vmcnt(0) lgkmcnt(0)" ::: "memory"); __syncthreads(); rsl = rw;
            }
            pg8::EpiProj<1, true> E{0x7fffffff, 0, BIG, 4096, SSQ, rsl, pm0};
#ifndef DIS_G2
            pg8::gemm_phase<pg8::EpiProj<1, true>, pg8::StaticOrder, true, true>(L, g, S, E);
#endif
        }
        else if (kind == K_MIXOUT || kind == K_XO || kind == K_DOWN) {
            const bf16* A; const bf16* Bt; int K = 1024;
            if (kind == K_MIXOUT) { A = MIX; Bt = ((l & 1) == 0 ? WOUT : COUT) + (size_t)li * 1024 * 1024; }
            else if (kind == K_XO) { A = MIX; Bt = WO + (size_t)l * 1024 * 1024; }
            else { A = BIG; Bt = W2 + (size_t)l * 1024 * 4096; K = 4096; }
            pg8::Gemm g{A, Bt, M, 1024, K}; pg8::StaticOrder S; S.init(M, 1024, G, bid);
            pg8::EpiResid E{HB, SSQ};
#ifndef DIS_G3
            pg8::gemm_phase<pg8::EpiResid, pg8::StaticOrder, true, true>(L, g, S, E);
#endif
        }
        else if (kind == K_ATTN) {
            const LAS float* tab = (const LAS float*)(L + TAB_OFF); int cur_h = -1;
            for (int item = bid; item < 256; item += G) {
                const int it2 = (item & 7) * 32 + (item >> 3), b = it2 >> 4, h = (it2 >> 2) & 3, sq = it2 & 3;
                if (h != cur_h) { __syncthreads(); { LAS float* tw = (LAS float*)(L + TAB_OFF); const float t0v = TAB[h * TABN + tid]; const float t1v = TAB[h * TABN + (tid < TABN - 512 ? tid + 512 : tid)]; tw[tid] = t0v; if (tid < TABN - 512) tw[tid + 512] = t1v; } cur_h = h; asm volatile("s_waitcnt vmcnt(0) lgkmcnt(0)" ::: "memory"); __syncthreads(); }
                for (int qi = 0; qi < 4; ++qi) {
                    const int qb = qi == 0 ? 15 - sq : qi == 1 ? 8 + sq : qi == 2 ? 7 - sq : sq;
                    for (int vh = 0; vh < 4; ++vh) { const int mp = vh >> 1, j = vh & 1;
#ifndef DIS_ATTN
                        attn_body::attn_unit<8>(b, qb, (const attn_body::bf16*)(BIG + h * 128 + mp * 64), (const attn_body::bf16*)(BIG + 512 + h * 128 + mp * 64), (const attn_body::bf16*)(BIG + 1024 + h * 128 + j * 64),
                                                (attn_body::bf16*)(ORAW + mp * 512 + h * 128 + j * 64), tab, (char*)lds);
#endif
                        asm volatile("s_waitcnt vmcnt(0)" ::: "memory");
                    }
                    __syncthreads();
                    { int lane_ = threadIdx.x & 63; asm volatile("" : "+v"(lane_));
                      const float lam = LAM[li], post = 1.0f - (li == 0 ? LAMBDA_INIT0 : LAMBDA_INIT2);
                      const f32x4* gp = (const f32x4*)(ARGIN(I_SUBLN) + li * 128 + (lane_ & 15) * 8); const f32x4 ga = gp[0], gb = gp[1];
                      const size_t rowbase = (size_t)b * SEQ + (size_t)qb * 256 + wid * 32 + (lane_ >> 4); const int cofs = h * 128 + (lane_ & 15) * 8;
                      v4u aa[8], cc[8];
#pragma unroll
                      for (int it = 0; it < 8; ++it) { const size_t row = rowbase + it * 4; aa[it] = *(const v4u*)(ORAW + row * 1024 + cofs); cc[it] = *(const v4u*)(ORAW + row * 1024 + 512 + cofs); }
#pragma unroll
                      for (int it = 0; it < 8; ++it) { const size_t row = rowbase + it * 4; const v4u a = aa[it], c = cc[it];
                        float v[8] = {bf_lo(a.x) - lam * bf_lo(c.x), bf_hi(a.x) - lam * bf_hi(c.x), bf_lo(a.y) - lam * bf_lo(c.y), bf_hi(a.y) - lam * bf_hi(c.y),
                                      bf_lo(a.z) - lam * bf_lo(c.z), bf_hi(a.z) - lam * bf_hi(c.z), bf_lo(a.w) - lam * bf_lo(c.w), bf_hi(a.w) - lam * bf_hi(c.w)};
                        float sv = 0.f;
#pragma unroll
                        for (int e = 0; e < 8; ++e) sv += v[e] * v[e];
                        sv += __shfl_xor(sv, 1); sv += __shfl_xor(sv, 2); sv += __shfl_xor(sv, 4); sv += __shfl_xor(sv, 8);
                        const float r = __builtin_amdgcn_rsqf(sv * (1.0f / 128.0f) + EPS) * post;
                        v4u o; o.x = pk2(v[0] * r * ga[0], v[1] * r * ga[1]); o.y = pk2(v[2] * r * ga[2], v[3] * r * ga[3]); o.z = pk2(v[4] * r * gb[0], v[5] * r * gb[1]); o.w = pk2(v[6] * r * gb[2], v[7] * r * gb[3]);
                        *(v4u*)(MIX + row * 1024 + cofs) = o; }
                    }
                }
            }
#ifndef DIS_POOL
            { const int w = 2 << (lane >> 4);
              for (int task = gw; task < M / 32; task += NGW) {
                const int row0 = task * 32, t0 = row0 & (SEQ - 1);
                const bf16* up = BIG + (size_t)row0 * 2048 + 1536 + lane * 8; bf16* op = MIX + (size_t)row0 * 1024 + 512 + lane * 8;
                float sum[8];
#pragma unroll
                for (int e = 0; e < 8; ++e) sum[e] = 0.f;
                if (t0 > 0) for (int jj = 1; jj <= w; ++jj) {   const v4u q = *(const v4u*)(up - (size_t)jj * 2048);
                    sum[0] += bf_lo(q.x); sum[1] += bf_hi(q.x); sum[2] += bf_lo(q.y); sum[3] += bf_hi(q.y); sum[4] += bf_lo(q.z); sum[5] += bf_hi(q.z); sum[6] += bf_lo(q.w); sum[7] += bf_hi(q.w); }
                for (int i0 = 0; i0 < 32; i0 += 4) {
                    v4u qq[4], oo[4];
#pragma unroll
                    for (int k = 0; k < 4; ++k) { qq[k] = *(const v4u*)(up + (size_t)(i0 + k) * 2048); oo[k] = *(const v4u*)(up + ((long)(i0 + k) - w) * 2048); }
#pragma unroll
                    for (int k = 0; k < 4; ++k) { const int i = i0 + k; const v4u q = qq[k], o = oo[k];
                    float cur[8] = {bf_lo(q.x), bf_hi(q.x), bf_lo(q.y), bf_hi(q.y), bf_lo(q.z), bf_hi(q.z), bf_lo(q.w), bf_hi(q.w)};
#pragma unroll
                    for (int e = 0; e < 8; ++e) sum[e] += cur[e];
                    const int t = t0 + i;
                    if (t - w >= 0) {
                        sum[0] -= bf_lo(o.x); sum[1] -= bf_hi(o.x); sum[2] -= bf_lo(o.y); sum[3] -= bf_hi(o.y); sum[4] -= bf_lo(o.z); sum[5] -= bf_hi(o.z); sum[6] -= bf_lo(o.w); sum[7] -= bf_hi(o.w); }
                    const float rc = 1.0f / (float)((t + 1) < w ? (t + 1) : w);
                    v4u r; r.x = pk2(sum[0] * rc - cur[0], sum[1] * rc - cur[1]); r.y = pk2(sum[2] * rc - cur[2], sum[3] * rc - cur[3]); r.z = pk2(sum[4] * rc - cur[4], sum[5] * rc - cur[5]); r.w = pk2(sum[6] * rc - cur[6], sum[7] * rc - cur[7]);
                    *(v4u*)(op + (size_t)i * 1024) = r; }
                }
              } }
#endif
        }
        else if (kind == K_CONV) {
#ifndef DIS_CONV
            for (int task = gw; task < (M / 32) * 2; task += NGW) {
                const int row0 = (task >> 1) * 32, t0 = row0 & (SEQ - 1), ch = (task & 1) * 512 + lane * 8;
                const float* cw = ARGIN(I_CW) + (size_t)li * 3 * 1024 + ch;
                float w0[8], w1[8], w2[8];
#pragma unroll
                for (int e = 0; e < 8; ++e) { w0[e] = cw[e]; w1[e] = cw[1024 + e]; w2[e] = cw[2048 + e]; }
                const bf16* pp = BIG + (size_t)row0 * 2048 + ch; bf16* op = MIX + (size_t)row0 * 1024 + ch;
                float z1[8], z2[8];
#pragma unroll
                for (int e = 0; e < 8; ++e) { z1[e] = 0.f; z2[e] = 0.f; }
                if (t0 > 0) {
                    const v4u q1 = *(const v4u*)(pp - 2048 + 1024), q2 = *(const v4u*)(pp - 2 * 2048 + 1024);
                    z1[0] = bf_lo(q1.x); z1[1] = bf_hi(q1.x); z1[2] = bf_lo(q1.y); z1[3] = bf_hi(q1.y); z1[4] = bf_lo(q1.z); z1[5] = bf_hi(q1.z); z1[6] = bf_lo(q1.w); z1[7] = bf_hi(q1.w);
                    z2[0] = bf_lo(q2.x); z2[1] = bf_hi(q2.x); z2[2] = bf_lo(q2.y); z2[3] = bf_hi(q2.y); z2[4] = bf_lo(q2.z); z2[5] = bf_hi(q2.z); z2[6] = bf_lo(q2.w); z2[7] = bf_hi(q2.w);
                }
                for (int i0 = 0; i0 < 32; i0 += 4) {
                    v4u bqq[4], zqq[4];
#pragma unroll
                    for (int k = 0; k < 4; ++k) { bqq[k] = *(const v4u*)(pp + (size_t)(i0 + k) * 2048); zqq[k] = *(const v4u*)(pp + (size_t)(i0 + k) * 2048 + 1024); }
#pragma unroll
                    for (int k = 0; k < 4; ++k) { const int i = i0 + k; const v4u bq = bqq[k], zq = zqq[k];
                    const float bb[8] = {bf_lo(bq.x), bf_hi(bq.x), bf_lo(bq.y), bf_hi(bq.y), bf_lo(bq.z), bf_hi(bq.z), bf_lo(bq.w), bf_hi(bq.w)};
                    const float z[8] = {bf_lo(zq.x), bf_hi(zq.x), bf_lo(zq.y), bf_hi(zq.y), bf_lo(zq.z), bf_hi(zq.z), bf_lo(zq.w), bf_hi(zq.w)};
                    float y[8];
#pragma unroll
                    for (int e = 0; e < 8; ++e) { y[e] = bb[e] * (z2[e] * w0[e] + z1[e] * w1[e] + z[e] * w2[e]); z2[e] = z1[e]; z1[e] = z[e]; }
                    v4u r; r.x = pk2(y[0], y[1]); r.y = pk2(y[2], y[3]); r.z = pk2(y[4], y[5]); r.w = pk2(y[6], y[7]);
                    *(v4u*)(op + (size_t)i * 1024) = r; }
                }
            }
#endif
        }
        else {
            const f32x4* gr = (const f32x4*)(ARGIN(I_FING) + lane * 8);
            const f32x4 g0 = gr[0], g1 = gr[1], g2 = gr[128], g3 = gr[129];
            for (int row0 = gw; row0 < M; row0 += 2 * NGW) {
                v4u h0[2], h1[2];
#pragma unroll
                for (int k = 0; k < 2; ++k) { const bf16* hp = HB + (size_t)(row0 + k * NGW) * DM + lane * 8; h0[k] = *(const v4u*)(hp); h1[k] = *(const v4u*)(hp + 512); }
#pragma unroll
                for (int k = 0; k < 2; ++k) { float* op = out + (size_t)(row0 + k * NGW) * DM + lane * 8;
                    const f32x4 a0 = {bf_lo(h0[k].x), bf_hi(h0[k].x), bf_lo(h0[k].y), bf_hi(h0[k].y)}, a1 = {bf_lo(h0[k].z), bf_hi(h0[k].z), bf_lo(h0[k].w), bf_hi(h0[k].w)};
                    const f32x4 a2 = {bf_lo(h1[k].x), bf_hi(h1[k].x), bf_lo(h1[k].y), bf_hi(h1[k].y)}, a3 = {bf_lo(h1[k].z), bf_hi(h1[k].z), bf_lo(h1[k].w), bf_hi(h1[k].w)};
                    float sq = ((a0[0] * a0[0] + a0[1] * a0[1]) + (a0[2] * a0[2] + a0[3] * a0[3])) + ((a1[0] * a1[0] + a1[1] * a1[1]) + (a1[2] * a1[2] + a1[3] * a1[3]))
                             + ((a2[0] * a2[0] + a2[1] * a2[1]) + (a2[2] * a2[2] + a2[3] * a2[3])) + ((a3[0] * a3[0] + a3[1] * a3[1]) + (a3[2] * a3[2] + a3[3] * a3[3]));
                    const float r = __builtin_amdgcn_rsqf(wave_sum(sq) * (1.f / DM) + EPS);
                    *(f32x4*)(op) = a0 * r * g0; *(f32x4*)(op + 4) = a1 * r * g1; *(f32x4*)(op + 512) = a2 * r * g2; *(f32x4*)(op + 516) = a3 * r * g3; }
            }
        }
        if (ph + 1 < ph_hi) { XcdBarrier xb_; xb_.bar = (unsigned*)ws; xb_.x = xb_xcc_id(); xb_.st = (volatile LAS unsigned*)(L + XB_ST_OFF); xcd_barrier(xb_); }
    }
}


#ifndef N_LAUNCH_MODE
#define N_LAUNCH_MODE 1
#endif
extern "C" void kernel_launch(void* const* d_in, const int* in_sizes, int n_in, void* d_out, int out_size, void* d_ws, size_t ws_size, hipStream_t stream) {
    static int grid = 0;
    if (grid == 0) {
        if (n_in != 25 || in_sizes[0] != M * DM || out_size != M * DM || ws_size < WS_END) { fprintf(stderr, "kernel_launch: unexpected shapes (n_in %d, in0 %d, out %d, ws %zu); nothing launched\n", n_in, n_in > 0 ? in_sizes[0] : -1, out_size, ws_size); grid = -1; return; }
        int dev = 0, cus = 0, per_cu = 0;
        hipGetDevice(&dev); hipDeviceGetAttribute(&cus, hipDeviceAttributeMultiprocessorCount, dev);
        if (hipFuncSetAttribute((const void*)trunk_fwd, hipFuncAttributeMaxDynamicSharedMemorySize, LDS_BYTES) != hipSuccess) { fprintf(stderr, "kernel_launch: hipFuncSetAttribute failed\n"); grid = -1; return; }
        if (hipOccupancyMaxActiveBlocksPerMultiprocessor(&per_cu, (const void*)trunk_fwd, NWAVES * 64, LDS_BYTES) != hipSuccess || per_cu < 1) { fprintf(stderr, "kernel_launch: occupancy query gave %d\n", per_cu); per_cu = 1; }
        (void)hipGetLastError();
        grid = cus;
    }
    if (grid < 0) return;
    Args a{};
    for (int i = 0; i < 25; ++i) a.in[i] = (const float*)d_in[i];
    a.out = (float*)d_out; a.ws = (unsigned char*)d_ws;
#if N_LAUNCH_MODE == 1
    a.lo = 0; a.hi = NPHASE;
    { void* kargs[] = {&a}; hipError_t e = hipLaunchCooperativeKernel((const void*)trunk_fwd, dim3(grid), dim3(NWAVES * 64), kargs, LDS_BYTES, stream);
      if (e != hipSuccess) fprintf(stderr, "cooperative launch failed: %s (grid %d)\n", hipGetErrorString(e), grid); }
#elif N_LAUNCH_MODE == 0
    for (int p = 0; p < NPHASE; ++p) { a.lo = p; a.hi = p + 1; void* kargs[] = {&a};
        hipError_t e = hipLaunchCooperativeKernel((const void*)trunk_fwd, dim3(grid), dim3(NWAVES * 64), kargs, LDS_BYTES, stream);
        if (e != hipSuccess) { fprintf(stderr, "launch %d failed: %s (grid %d)\n", p, hipGetErrorString(e), grid); break; } }
#endif
}
```

```cpp
#include <hip/hip_runtime.h>
#include <hip/hip_cooperative_groups.h>
#include <hip/hip_bf16.h>
#include <cstdio>
#include <cstdint>
#include <cmath>
namespace cg = cooperative_groups;
namespace pg8 {
#define PG8_LAS __attribute__((address_space(3)))
typedef unsigned short bf16_t;
typedef short bf16x8 __attribute__((ext_vector_type(8)));
typedef float f32x4 __attribute__((ext_vector_type(4)));
typedef unsigned u32x4 __attribute__((ext_vector_type(4)));
constexpr int BM = 256, BK = 64, HALF = 128, HTB = HALF * BK * 2  , STAGE_BYTES = 8 * HTB, NXCD = 8, WGM = 8;

__host__ __device__ __forceinline__ int lds_byte(int r, int c) { const int st = (r >> 4) * 2 + (c >> 5), rr = r & 15, cc = c & 31, ob = rr * 64 + cc * 2; return st * 1024 + (ob ^ (((ob >> 9) & 1) << 5)); }
__host__ __device__ __forceinline__ void stage_rc(int b, int& R, int& C) { const int st = b / 1024, sb = b % 1024, swz = sb ^ (((sb >> 9) & 1) << 5); R = (st >> 1) * 16 + swz / 64; C = (st & 1) * 32 + (swz % 64) / 2; }
__host__ __device__ __forceinline__ int perm32(int rho) { const int n = rho >> 4, i = rho & 15; return 8 * (i >> 2) + 4 * n + (i & 3); }

struct Unit { int pm, pn; };
struct Gemm { const bf16_t* A; const bf16_t* Bt; int M, N, K; };

struct StaticOrder {
    int nM, nN, nwg, G, c;
    __host__ __device__ void init(int M, int N, int G_, int c_) { nM = M / BM; nN = N / BM; nwg = nM * nN; G = G_; c = c_; }
    __host__ __device__ bool next(int i, Unit& u) const {
        const long L = (long)i * G + c; if (L >= nwg) return false;
        int wgid = (int)L; { const int q = nwg / NXCD, r = nwg % NXCD, xcd = wgid % NXCD, off = wgid / NXCD; wgid = (xcd < r ? xcd * (q + 1) : r * (q + 1) + (xcd - r) * q) + off; }
        const int nig = WGM * nN, gid = wgid / nig, fm = gid * WGM, gsz = (nM - fm) < WGM ? (nM - fm) : WGM;
        u.pm = fm + ((wgid % nig) % gsz); u.pn = (wgid % nig) / gsz; return true;
    }
    __device__ __forceinline__ void a_ready(const Unit&) const {}
    __device__ __forceinline__ void done(const Unit&) const {}
};

__device__ __forceinline__ unsigned cvt_pk_bf16(float lo, float hi) { unsigned r; asm volatile("v_cvt_pk_bf16_f32 %0, %1, %2" : "=v"(r) : "v"(lo), "v"(hi)); return r; }
typedef float f32x2 __attribute__((ext_vector_type(2)));
__device__ __forceinline__ float row_rstd(const float* ssq, int row) {
    const f32x4* p = (const f32x4*)(ssq + (size_t)row * 16);
    const f32x4 a = p[0], b = p[1], c = p[2], d = p[3];
    const float s = (((a[0] + a[1]) + (a[2] + a[3])) + ((b[0] + b[1]) + (b[2] + b[3]))) + (((c[0] + c[1]) + (c[2] + c[3])) + ((d[0] + d[1]) + (d[2] + d[3])));
    return __builtin_amdgcn_rsqf(s * (1.0f / 1024.0f) + 1e-6f);
}
template <int ACT  , bool SCALE> struct EpiProj {
    static constexpr bool PERM = true, AFTER_DRAIN = false;
    int zfrom, zcol;
    bf16_t* O; int ldc; const float* ssq; const PG8_LAS float* rsl; int pm0;
    __device__ __forceinline__ void operator()(const f32x4 (&acc)[2][2][4][2], const Unit& u, int wr, int wc, int fr, int fq) const {
        const int row0 = u.pm * BM + wr * 64 + fr, col0 = u.pn * BM + wc * 32 + 8 * fq;
        if constexpr (ACT == 0 && SCALE) { if (u.pn >= zfrom) {
            const int zc = zcol + (u.pn - zfrom) * HALF + wc * 32 + 8 * fq;
#pragma unroll
            for (int ai = 0; ai < 2; ++ai)
#pragma unroll
                for (int m = 0; m < 4; ++m) { const int row = row0 + ai * HALF + m * 16;
                    const float sc = rsl ? rsl[((u.pm - pm0) >> 3) * 256 + (row & 255)] : row_rstd(ssq, row);
                    const f32x4 z0 = (acc[ai][0][m][0] * sc) * (acc[ai][1][m][0] * sc), z1 = (acc[ai][0][m][1] * sc) * (acc[ai][1][m][1] * sc);
                    u32x4 w; w.x = cvt_pk_bf16(z0[0], z0[1]); w.y = cvt_pk_bf16(z0[2], z0[3]); w.z = cvt_pk_bf16(z1[0], z1[1]); w.w = cvt_pk_bf16(z1[2], z1[3]);
                    __builtin_nontemporal_store(w, (u32x4*)(O + (size_t)row * ldc + zc)); }
            return; } }
#pragma unroll
        for (int ai = 0; ai < 2; ++ai)
#pragma unroll
            for (int m = 0; m < 4; ++m) { const int row = row0 + ai * HALF + m * 16; bf16_t* rowp = O + (size_t)row * ldc + col0;
                float sc = 1.f; if (SCALE) sc = rsl ? rsl[((u.pm - pm0) >> 3) * 256 + (row & 255)] : row_rstd(ssq, row);
#pragma unroll
                for (int bj = 0; bj < 2; ++bj) { f32x4 v0 = acc[ai][bj][m][0] * sc, v1 = acc[ai][bj][m][1] * sc;
                    if (ACT == 1) {
#pragma unroll
                        for (int j = 0; j < 4; ++j) { const float a = __builtin_fmaxf(v0[j], 0.f), b = __builtin_fmaxf(v1[j], 0.f); v0[j] = a * a; v1[j] = b * b; } }
                    u32x4 w; w.x = cvt_pk_bf16(v0[0], v0[1]); w.y = cvt_pk_bf16(v0[2], v0[3]); w.z = cvt_pk_bf16(v1[0], v1[1]); w.w = cvt_pk_bf16(v1[2], v1[3]);
                    __builtin_nontemporal_store(w, (u32x4*)(rowp + bj * HALF)); } }
    }
};
struct EpiResid {
    static constexpr bool PERM = true, AFTER_DRAIN = false;
    bf16_t* hb; float* ssq;
    __device__ __forceinline__ void operator()(const f32x4 (&acc)[2][2][4][2], const Unit& u, int wr, int wc, int fr, int fq) const {
        const int row0 = u.pm * BM + wr * 64 + fr, col0 = u.pn * BM + wc * 32 + 8 * fq;
        u32x4 hv[2][4][2];
#pragma unroll
        for (int ai = 0; ai < 2; ++ai)
#pragma unroll
            for (int m = 0; m < 4; ++m)
#pragma unroll
                for (int bj = 0; bj < 2; ++bj) hv[ai][m][bj] = *(const u32x4*)(hb + (size_t)(row0 + ai * HALF + m * 16) * 1024 + col0 + bj * HALF);
#pragma unroll
        for (int ai = 0; ai < 2; ++ai)
#pragma unroll
            for (int m = 0; m < 4; ++m) { const int row = row0 + ai * HALF + m * 16; float s = 0.f;
#pragma unroll
                for (int bj = 0; bj < 2; ++bj) { const size_t off = (size_t)row * 1024 + col0 + bj * HALF;
                    const u32x4 h4 = hv[ai][m][bj];
                    const f32x4 b0 = {__uint_as_float(h4.x << 16), __uint_as_float(h4.x & 0xffff0000u), __uint_as_float(h4.y << 16), __uint_as_float(h4.y & 0xffff0000u)};
                    const f32x4 b1 = {__uint_as_float(h4.z << 16), __uint_as_float(h4.z & 0xffff0000u), __uint_as_float(h4.w << 16), __uint_as_float(h4.w & 0xffff0000u)};
                    const f32x4 v0 = acc[ai][bj][m][0] + b0, v1 = acc[ai][bj][m][1] + b1;
                    u32x4 w; w.x = cvt_pk_bf16(v0[0], v0[1]); w.y = cvt_pk_bf16(v0[2], v0[3]); w.z = cvt_pk_bf16(v1[0], v1[1]); w.w = cvt_pk_bf16(v1[2], v1[3]);
                    *(u32x4*)(hb + off) = w;
                    s += ((v0[0] * v0[0] + v0[1] * v0[1]) + (v0[2] * v0[2] + v0[3] * v0[3])) + ((v1[0] * v1[0] + v1[1] * v1[1]) + (v1[2] * v1[2] + v1[3] * v1[3])); }
                s += __shfl_xor(s, 16); s += __shfl_xor(s, 32);
                if (fq == 0) ssq[(size_t)row * 16 + u.pn * 4 + wc] = s; }
    }
};
template <class Epi, class Sched, bool ALIGN_EPI = false, bool SP2 = false>
__device__ __forceinline__ void gemm_phase(PG8_LAS unsigned char* lds, const Gemm g, const Sched& S, const Epi& E) {
    int tid_ = threadIdx.x; asm volatile("" : "+v"(tid_));
    const int tid = tid_, wid = __builtin_amdgcn_readfirstlane(tid >> 6), lane = tid & 63, wr = wid >> 2, wc = wid & 3, fr = lane & 15, fq = lane >> 4;
    const int K = g.K, nt = K / BK;
    unsigned voffA[2], voffB[2];
#pragma unroll
    for (int i = 0; i < 2; ++i) { int R, C; stage_rc(tid * 16 + i * 8192, R, C); const int Rb = Epi::PERM ? ((R & ~31) + perm32(R & 31)) : R;
        voffA[i] = (unsigned)(R * K + C) * 2u; voffB[i] = (unsigned)(Rb * K + C) * 2u; }
    const size_t kstep = (size_t)(BK * 2);
    const size_t hstep = (size_t)HALF * K * 2;
    const size_t tstep = 2 * hstep;
    const unsigned ldsw = (unsigned)wid * 1024u;
    const int aoff = lds_byte(wr * 64 + fr, fq * 8), boff = lds_byte(wc * 32 + fr, fq * 8);
#define PG8_SA(b, h) (((b) * 2 + (h)) * HTB)
#define PG8_SB(b, h) ((4 + (b) * 2 + (h)) * HTB)
#define PG8_STAGE(bufoff, gbase, voff) do { _Pragma("unroll") for (int _i = 0; _i < 2; ++_i) \
        __builtin_amdgcn_global_load_lds((const unsigned*)((const char*)(gbase) + (voff)[_i]), (PG8_LAS unsigned*)(lds + (bufoff) + ldsw + _i * 8192), 16, 0, 0); } while (0)
#define PG8_LDA(dst, b, h) do { _Pragma("unroll") for (int m = 0; m < 4; ++m) _Pragma("unroll") for (int k = 0; k < 2; ++k) dst[m][k] = *(const PG8_LAS bf16x8*)(lds + PG8_SA(b, h) + aoff + m * 2048 + k * 1024); } while (0)
#define PG8_LDB(dst, b, h) do { _Pragma("unroll") for (int n = 0; n < 2; ++n) _Pragma("unroll") for (int k = 0; k < 2; ++k) dst[n][k] = *(const PG8_LAS bf16x8*)(lds + PG8_SB(b, h) + boff + n * 2048 + k * 1024); } while (0)
#define PG8_MMA(ai, bj, At, Bt) do { __builtin_amdgcn_s_setprio(1); _Pragma("unroll") for (int m = 0; m < 4; ++m) _Pragma("unroll") for (int n = 0; n < 2; ++n) _Pragma("unroll") for (int k = 0; k < 2; ++k) \
        acc[ai][bj][m][n] = __builtin_amdgcn_mfma_f32_16x16x32_bf16(Bt[n][k], At[m][k], acc[ai][bj][m][n], 0, 0, 0); __builtin_amdgcn_s_setprio(0); } while (0)
#define PG8_WAIT_V(n) asm volatile("s_waitcnt vmcnt(" #n ")" ::: "memory")
#define PG8_WAIT_L(n) asm volatile("s_waitcnt lgkmcnt(" #n ")" ::: "memory")
#define PG8_BAR __builtin_amdgcn_s_barrier()
#define PG8_SCHED __builtin_amdgcn_sched_barrier(0)
    Unit cur, nxt; int ui = 0;
    if (!S.next(0, cur)) return;
    f32x4 acc[2][2][4][2];
#pragma unroll
    for (int a = 0; a < 2; ++a)
#pragma unroll
        for (int b = 0; b < 2; ++b)
#pragma unroll
            for (int m = 0; m < 4; ++m)
#pragma unroll
                for (int n = 0; n < 2; ++n) acc[a][b][m][n] = (f32x4){0.f, 0.f, 0.f, 0.f};
    bf16x8 At[4][2], B0[2][2], B1[2][2];
    const char* cA = (const char*)g.A + (size_t)cur.pm * tstep; const char* cB = (const char*)g.Bt + (size_t)cur.pn * tstep;
    S.a_ready(cur);
    if constexpr (SP2) {
        PG8_STAGE(PG8_SB(0, 0), cB, voffB); PG8_STAGE(PG8_SB(0, 1), cB + hstep, voffB); PG8_STAGE(PG8_SA(0, 0), cA, voffA); PG8_STAGE(PG8_SA(0, 1), cA + hstep, voffA);
        if (wr == 1) PG8_BAR;
        PG8_WAIT_V(2); PG8_BAR;
        PG8_STAGE(PG8_SB(1, 0), cB + kstep, voffB); PG8_STAGE(PG8_SA(1, 0), cA + kstep, voffA); PG8_STAGE(PG8_SB(1, 1), cB + hstep + kstep, voffB);
        PG8_WAIT_V(6); PG8_BAR;
    } else {
        PG8_STAGE(PG8_SB(0, 0), cB, voffB); PG8_STAGE(PG8_SA(0, 0), cA, voffA); PG8_STAGE(PG8_SB(0, 1), cB + hstep, voffB); PG8_STAGE(PG8_SA(0, 1), cA + hstep, voffA);
        if (wr == 1) PG8_BAR;
        PG8_WAIT_V(4); PG8_BAR;
        PG8_STAGE(PG8_SB(1, 0), cB + kstep, voffB); PG8_STAGE(PG8_SA(1, 0), cA + kstep, voffA); PG8_STAGE(PG8_SB(1, 1), cB + hstep + kstep, voffB);
        PG8_WAIT_V(6); PG8_BAR;
    }
    for (;;) {
        const bool has_next = S.next(ui + 1, nxt);
        const char* nA = has_next ? (const char*)g.A + (size_t)nxt.pm * tstep : cA; const char* nB = has_next ? (const char*)g.Bt + (size_t)nxt.pn * tstep : cB;
        for (int t = 0; t < nt; t += 2) {
            const bool last = (t == nt - 2);
            const char* a1 = cA + (size_t)(t + 1) * kstep;
            const char* a2 = last ? nA : cA + (size_t)(t + 2) * kstep; const char* b2 = last ? nB : cB + (size_t)(t + 2) * kstep;
            const char* a3 = a2 + kstep; const char* b3 = b2 + kstep;
            if (last && has_next) S.a_ready(nxt);
            if constexpr (SP2) {
            PG8_LDB(B0, 0, 0); PG8_LDB(B1, 0, 1); PG8_SCHED; PG8_LDA(At, 0, 0); PG8_STAGE(PG8_SA(1, 1), a1 + hstep, voffA);
            PG8_WAIT_V(8); PG8_WAIT_L(0); PG8_BAR; PG8_MMA(0, 0, At, B0); PG8_MMA(0, 1, At, B1); PG8_BAR; PG8_SCHED;
            PG8_LDA(At, 0, 1); PG8_STAGE(PG8_SB(0, 0), b2, voffB); PG8_STAGE(PG8_SB(0, 1), b2 + hstep, voffB); PG8_STAGE(PG8_SA(0, 0), a2, voffA);
            PG8_WAIT_V(8); PG8_WAIT_L(0); PG8_BAR; PG8_MMA(1, 0, At, B0); PG8_MMA(1, 1, At, B1); PG8_BAR; PG8_SCHED;
            PG8_LDB(B0, 1, 0); PG8_LDB(B1, 1, 1); PG8_SCHED; PG8_LDA(At, 1, 0); PG8_STAGE(PG8_SA(0, 1), a2 + hstep, voffA);
            PG8_WAIT_V(8); PG8_WAIT_L(0); PG8_BAR; PG8_MMA(0, 0, At, B0); PG8_MMA(0, 1, At, B1); PG8_BAR; PG8_SCHED;
            PG8_LDA(At, 1, 1); PG8_STAGE(PG8_SB(1, 0), b3, voffB); PG8_STAGE(PG8_SB(1, 1), b3 + hstep, voffB); PG8_STAGE(PG8_SA(1, 0), a3, voffA);
            PG8_WAIT_V(8); PG8_WAIT_L(0); PG8_BAR; PG8_MMA(1, 0, At, B0); PG8_MMA(1, 1, At, B1); PG8_BAR; PG8_SCHED;
            } else {
            PG8_LDB(B0, 0, 0); PG8_SCHED; PG8_LDA(At, 0, 0); PG8_STAGE(PG8_SA(1, 1), a1 + hstep, voffA);
            PG8_WAIT_L(8); PG8_BAR; PG8_WAIT_L(0); PG8_MMA(0, 0, At, B0); PG8_BAR; PG8_SCHED;
            PG8_LDB(B1, 0, 1); PG8_STAGE(PG8_SB(0, 0), b2, voffB);
            PG8_BAR; PG8_WAIT_L(0); PG8_MMA(0, 1, At, B1); PG8_BAR;
            PG8_LDA(At, 0, 1); PG8_STAGE(PG8_SA(0, 0), a2, voffA);
            PG8_BAR; PG8_WAIT_L(0); PG8_MMA(1, 0, At, B0); PG8_BAR; PG8_SCHED;
            PG8_STAGE(PG8_SB(0, 1), b2 + hstep, voffB);
            PG8_WAIT_V(6); PG8_BAR; PG8_MMA(1, 1, At, B1); PG8_BAR;
            PG8_LDB(B0, 1, 0); PG8_SCHED; PG8_LDA(At, 1, 0); PG8_STAGE(PG8_SA(0, 1), a2 + hstep, voffA);
            PG8_WAIT_L(8); PG8_BAR; PG8_WAIT_L(0); PG8_MMA(0, 0, At, B0); PG8_BAR; PG8_SCHED;
            PG8_LDB(B1, 1, 1); PG8_STAGE(PG8_SB(1, 0), b3, voffB);
            PG8_BAR; PG8_WAIT_L(0); PG8_MMA(0, 1, At, B1); PG8_BAR;
            PG8_LDA(At, 1, 1); PG8_STAGE(PG8_SA(1, 0), a3, voffA);
            PG8_BAR; PG8_WAIT_L(0); PG8_MMA(1, 0, At, B0); PG8_BAR; PG8_SCHED;
            PG8_STAGE(PG8_SB(1, 1), b3 + hstep, voffB);
            PG8_WAIT_V(6); PG8_BAR; PG8_MMA(1, 1, At, B1); PG8_BAR;
            }
        }
        if constexpr (ALIGN_EPI) { if (wr == 0) PG8_BAR; }
        if constexpr (!Epi::AFTER_DRAIN) { E(acc, cur, wr, wc, fr, fq); S.done(cur); }
        if (!has_next) break;
#pragma unroll
        for (int a = 0; a < 2; ++a)
#pragma unroll
            for (int b = 0; b < 2; ++b)
#pragma unroll
                for (int m = 0; m < 4; ++m)
#pragma unroll
                    for (int n = 0; n < 2; ++n) acc[a][b][m][n] = (f32x4){0.f, 0.f, 0.f, 0.f};
        cur = nxt; cA = nA; cB = nB; ++ui;
        if constexpr (ALIGN_EPI) { if (wr == 1) PG8_BAR; }
    }
    PG8_WAIT_V(0);
    if constexpr (!ALIGN_EPI) { if (wr == 0) PG8_BAR; }
    PG8_BAR;
    if constexpr (Epi::AFTER_DRAIN) { E.fused(acc, cur, wr, wc, fr, fq, lds, wid, lane); S.done(cur); }
#undef PG8_SA
#undef PG8_SB
#undef PG8_STAGE
#undef PG8_LDA
#undef PG8_LDB
#undef PG8_MMA
#undef PG8_WAIT_V
#undef PG8_WAIT_L
#undef PG8_BAR
#undef PG8_SCHED
}
}
#include <hip/hip_bf16.h>
#include <cmath>
namespace attn_body {
using bf16=__hip_bfloat16;
using bf16x8=__attribute__((ext_vector_type(8)))short;
using s16x4=__attribute__((ext_vector_type(4)))short;
using f32x16=__attribute__((ext_vector_type(16)))float;
using u32x4=__attribute__((ext_vector_type(4)))unsigned;
constexpr int BATCH=16,SEQ=4096,D=64,PQ=2048,PO=1024;
constexpr int NW=8,QBLK=32,QB=QBLK*NW,KVBLK=64,NQB=SEQ/QB;
constexpr int ATTN_UNIT_ROWS=QB;
__device__ __forceinline__ int crow(int r,int hi){return (r&3)+8*(r>>2)+4*hi;}
#define SBAR() __builtin_amdgcn_sched_barrier(0)
__device__ __forceinline__ void cmask(f32x16&p0,f32x16&p1,int jb,int qrel,int hi,const __attribute__((address_space(3))) float*tab){
  asm volatile("s_nop 15\n\ts_nop 7":"+v"(p0),"+v"(p1));
  const __attribute__((address_space(3))) float*tp=tab+(qrel-64*jb-4*hi+256);
  #pragma unroll
  for(int r=0;r<16;++r){const int o=(r&3)+8*(r>>2); float a0=tp[-o], a1=tp[-o-32]; asm volatile("v_add_f32_e32 %0, %1, %0":"+v"(p0[r]):"v"(a0)); asm volatile("v_add_f32_e32 %0, %1, %0":"+v"(p1[r]):"v"(a1));}
}

constexpr int NSLOT=3, SLOTB=8192;
constexpr int LDS_K=0, LDS_V=NSLOT*SLOTB, LDS_WS=2*NSLOT*SLOTB, LDS_TAB=LDS_WS+NW*64*4, LDS_OST=LDS_TAB+3072, LDS_BYTES=LDS_OST+NW*4096;
constexpr float C2=0.125f*1.4426950408889634f;
__device__ __forceinline__ void glds16(const void*gsrc,unsigned lds_dst){unsigned keep;
  asm volatile("s_mov_b32 %0, m0\n\ts_mov_b32 m0, %2\n\ts_nop 0\n\tglobal_load_lds_dwordx4 %1, off\n\ts_mov_b32 m0, %0":"=&s"(keep):"v"(gsrc),"s"(lds_dst):"memory");}
__device__ __forceinline__ float max3f(float a,float b,float c){float r;asm("v_max3_f32 %0, %1, %2, %3":"=v"(r):"v"(a),"v"(b),"v"(c));return r;}
__device__ __forceinline__ float max2f(float a,float b){float r;asm("v_max_f32_e32 %0, %1, %2":"=v"(r):"v"(a),"v"(b));return r;}
__device__ __forceinline__ float fadd_s(float a,float b){float r;asm("v_add_f32_e32 %0, %1, %2":"=v"(r):"v"(a),"v"(b));return r;}
__device__ __forceinline__ float fsub_s(float a,float b){float r;asm("v_sub_f32_e32 %0, %1, %2":"=v"(r):"v"(a),"v"(b));return r;}
typedef float f32x2_t __attribute__((ext_vector_type(2))); typedef __bf16 bf16x2_t __attribute__((ext_vector_type(2)));
__device__ __forceinline__ unsigned cvtpk_s(float lo,float hi){f32x2_t v={lo,hi};bf16x2_t b=__builtin_convertvector(v,bf16x2_t);return __builtin_bit_cast(unsigned,b);}
#define WAIT_BAR(N) asm volatile("s_waitcnt vmcnt(" #N ") lgkmcnt(0)\n\ts_barrier":::"memory")

__device__ __forceinline__ void qkt(f32x16&p0,f32x16&p1,const char*Kslot,const bf16x8*qr,const f32x16&negm,int r32,int hi){
  const char*kb=Kslot+hi*1024+r32*16;
  #pragma unroll
  for(int d0=0;d0<4;++d0){
    const bf16x8 b0=*reinterpret_cast<const bf16x8*>(kb+d0*2048);
    const bf16x8 b1=*reinterpret_cast<const bf16x8*>(kb+d0*2048+512);
    if(d0==0){p0=__builtin_amdgcn_mfma_f32_32x32x16_bf16(b0,qr[0],negm,0,0,0);p1=__builtin_amdgcn_mfma_f32_32x32x16_bf16(b1,qr[0],negm,0,0,0);}
    else{p0=__builtin_amdgcn_mfma_f32_32x32x16_bf16(b0,qr[d0],p0,0,0,0);p1=__builtin_amdgcn_mfma_f32_32x32x16_bf16(b1,qr[d0],p1,0,0,0);}}
}
typedef __attribute__((address_space(3))) const char* lds_cptr;
typedef short v4i16_t __attribute__((ext_vector_type(4)));
__device__ __forceinline__ void kload8(bf16x8*kf,lds_cptr kp){
  kf[0]=*(const __attribute__((address_space(3))) bf16x8*)(kp);      kf[1]=*(const __attribute__((address_space(3))) bf16x8*)(kp+512);
  kf[2]=*(const __attribute__((address_space(3))) bf16x8*)(kp+2048); kf[3]=*(const __attribute__((address_space(3))) bf16x8*)(kp+2560);
  kf[4]=*(const __attribute__((address_space(3))) bf16x8*)(kp+4096); kf[5]=*(const __attribute__((address_space(3))) bf16x8*)(kp+4608);
  kf[6]=*(const __attribute__((address_space(3))) bf16x8*)(kp+6144); kf[7]=*(const __attribute__((address_space(3))) bf16x8*)(kp+6656);
}
__device__ __forceinline__ void kload2(bf16x8*kf,lds_cptr kp,int j){ kf[2*j]=*(const __attribute__((address_space(3))) bf16x8*)(kp+j*2048); kf[2*j+1]=*(const __attribute__((address_space(3))) bf16x8*)(kp+j*2048+512); }
__device__ __forceinline__ s16x4 vtr(lds_cptr p){ return __builtin_bit_cast(s16x4,__builtin_amdgcn_ds_read_tr16_b64_v4i16((__attribute__((address_space(3))) v4i16_t*)p)); }
__device__ __forceinline__ float rowmax(const f32x16&p0,const f32x16&p1){
  float a=max3f(p0[0],p0[1],p1[0]),b=max3f(p0[2],p0[3],p1[1]);a=max3f(a,p1[2],p1[3]);
  #pragma unroll
  for(int r=4;r<16;r+=4){a=max3f(a,p0[r],p0[r+1]);b=max3f(b,p0[r+2],p0[r+3]);a=max3f(a,p1[r],p1[r+1]);b=max3f(b,p1[r+2],p1[r+3]);}
  const float m=max2f(a,b);
  auto rr=__builtin_amdgcn_permlane32_swap(__float_as_uint(m),__float_as_uint(m),false,false);
  return max2f(__uint_as_float(rr[0]),__uint_as_float(rr[1]));
}
__device__ __forceinline__ void pv(f32x16*o,int vb,bf16x8 pa0,bf16x8 pa1,bf16x8 pa2,bf16x8 pa3){
  #pragma unroll
  for(int d0=0;d0<2;++d0){s16x4 lo[4],hi[4];
    #pragma unroll
    for(int ks=0;ks<4;++ks){
      asm volatile("ds_read_b64_tr_b16 %0,%1 offset:%c2":"=&v"(lo[ks]):"v"(vb),"i"(d0*4096+ks*1024):"memory");
      asm volatile("ds_read_b64_tr_b16 %0,%1 offset:%c2":"=&v"(hi[ks]):"v"(vb),"i"(d0*4096+ks*1024+512):"memory");}
    asm volatile("s_waitcnt lgkmcnt(0)":::"memory");SBAR();
    #define PK(k) (bf16x8){lo[k][0],lo[k][1],lo[k][2],lo[k][3],hi[k][0],hi[k][1],hi[k][2],hi[k][3]}
    o[d0]=__builtin_amdgcn_mfma_f32_32x32x16_bf16(pa0,PK(0),o[d0],0,0,0);
    o[d0]=__builtin_amdgcn_mfma_f32_32x32x16_bf16(pa1,PK(1),o[d0],0,0,0);
    o[d0]=__builtin_amdgcn_mfma_f32_32x32x16_bf16(pa2,PK(2),o[d0],0,0,0);
    o[d0]=__builtin_amdgcn_mfma_f32_32x32x16_bf16(pa3,PK(3),o[d0],0,0,0);
    #undef PK
  }
}

#ifndef ATTN_STORE16
#define ATTN_STORE16(p,v) (*(u32x4*)(p)=(v))
#endif
template<int THRL> __device__ __forceinline__ void attn_unit(int b,int qb,const bf16*Q,const bf16*__restrict__ K,const bf16*__restrict__ V,bf16*O,const __attribute__((address_space(3))) float*tab,char*shm){
  int tid_=threadIdx.x; asm volatile("":"+v"(tid_)); const int tid=tid_,lane=tid&63,r32=lane&31,hi=lane>>5; const int wid=__builtin_amdgcn_readfirstlane(tid>>6);
  const long rowbase=(long)b*SEQ; const int q0=qb*QB;
  const bf16*Qw=Q+(rowbase+q0+wid*QBLK)*PQ;
  const bf16*Kh=K+rowbase*PQ,*Vh=V+rowbase*PQ;
  const unsigned lds0=(unsigned)(uintptr_t)shm;
  float*wsf=(float*)(shm+LDS_WS)+wid*64;
  const bf16*ksrc=Kh+(long)lane*PQ+wid*8;
  const bf16*vsrc=Vh+(long)(16*(wid&3)+(lane>>2))*PQ+(wid>>2)*32+(lane&3)*8;
  const unsigned kdst=lds0+LDS_K+wid*1024, vdst=lds0+LDS_V+wid*1024;
  #define DMA_K(t,slot) glds16(ksrc+(long)(t)*KVBLK*PQ,(unsigned)__builtin_amdgcn_readfirstlane(kdst+(slot)))
  #define DMA_V(t,slot) glds16(vsrc+(long)(t)*KVBLK*PQ,(unsigned)__builtin_amdgcn_readfirstlane(vdst+(slot)))
  const int vb0=(int)(lds0+LDS_V)+((lane>>4)&1)*32+(lane&3)*8+(4*hi+((lane&15)>>2))*64;
  const char*Kbase=shm+LDS_K; bf16x8 kf[8];
  const lds_cptr shm3=(lds_cptr)shm; const lds_cptr kp0=shm3+LDS_K+hi*1024+r32*16; const lds_cptr vp0=shm3+LDS_V+((lane>>4)&1)*32+(lane&3)*8+(4*hi+((lane&15)>>2))*64;
  const int NT=(q0+QB)/KVBLK;
  DMA_K(0,0);DMA_V(0,0);DMA_K(1,SLOTB);
  bf16x8 qr[4];
  #pragma unroll
  for(int d0=0;d0<4;++d0)qr[d0]=*reinterpret_cast<const bf16x8*>(&Qw[(long)r32*PQ+d0*16+hi*8]);
  float mhat=0.f,l_reg=0.f;f32x16 o[2];o[0]=f32x16{};o[1]=f32x16{};f32x16 negm=f32x16{};asm volatile("":"+v"(negm));
  const int qrel=wid*QBLK+r32;
  #define CMASK(P0,P1,t) do{int jb_=(t)-(NT-4); if(jb_>=-2)cmask(P0,P1,jb_,qrel,hi,tab);}while(0)
  bool resc=false;
  #define START(P0,P1) do{ const float rm=rowmax(P0,P1); resc=false; \
    { const float dl=rm; mhat=fadd_s(mhat,dl); \
      _Pragma("unroll") for(int r=0;r<16;++r){P0[r]=fsub_s(P0[r],dl);P1[r]=fsub_s(P1[r],dl);} \
      _Pragma("unroll") for(int r=0;r<16;++r)negm[r]=-mhat; asm volatile("":"+v"(negm)); } \
    _Pragma("unroll") for(int r=0;r<16;++r)P0[r]=__builtin_amdgcn_exp2f(P0[r]); }while(0)
  #define RESC() do{ if(resc){ asm volatile("s_waitcnt lgkmcnt(0)":::"memory"); \
      _Pragma("unroll") for(int d_=0;d_<2;++d_) _Pragma("unroll") for(int r=0;r<16;++r)o[d_][r]*=wsf[crow(r,hi)]; } }while(0)
  f32x16 pA0,pA1,pB0,pB1;
  int sl_prev=0,sl_cur=0,sl_next=SLOTB;
  #define ROT() do{sl_prev=sl_cur;sl_cur=sl_next;sl_next=(sl_next==(NSLOT-1)*SLOTB)?0:sl_next+SLOTB;}while(0)
  DMA_K(2,2*SLOTB);
  WAIT_BAR(3);
  qkt(pA0,pA1,Kbase,qr,negm,r32,hi);asm volatile("s_nop 15\n\ts_nop 7":"+v"(pA0),"+v"(pA1));CMASK(pA0,pA1,0);
  START(pA0,pA1);
  _Pragma("unroll") for(int r=0;r<16;++r)pA1[r]=__builtin_amdgcn_exp2f(pA1[r]);
  WAIT_BAR(0);
  DMA_K(3,0);DMA_V(1,SLOTB);
  ROT();
  kload8(kf,kp0+sl_cur);
  WAIT_BAR(2);
  s16x4 vlo[8],vhi[8]; u32x4 pw0,pw1,pw2,pw3;
  #define PKW(P,B) cvtpk_s(P[B],P[B+1])
  #define PAF(k) __builtin_bit_cast(bf16x8,pw##k)
  #define VFR(i) (bf16x8){vlo[i][0],vlo[i][1],vlo[i][2],vlo[i][3],vhi[i][0],vhi[i][1],vhi[i][2],vhi[i][3]}
  #define PIN(x) asm volatile("":"+v"(x))
  #define MX3(a,b,c) __builtin_fmaxf(__builtin_fmaxf((a),(b)),(c))
  #define GAPA(MF,A0,A1,A2,A3,W0,W1,PW) do{ MF; sacc+=A0; sacc+=A1; sacc+=A2; sacc+=A3; PIN(sacc); W0; W1; PIN(PW); SBAR(); }while(0)
  #define EX(v) __builtin_amdgcn_exp2f(v)
  #define GAPB(MF,X,B) do{ MF; X[B]=EX(X[B]); X[B+1]=EX(X[B+1]); X[B+2]=EX(X[B+2]); X[B+3]=EX(X[B+3]); PIN(X); SBAR(); }while(0)
  #define VRD(i) do{ vlo[i]=vtr(vp_+(((i)>>2)*4096+((i)&3)*1024)); vhi[i]=vtr(vp_+(((i)>>2)*4096+((i)&3)*1024+512)); }while(0)
  #define KRD(G,j) do{ if(G){ kload2(kf,kp0+sl_next,j); SBAR(); } }while(0)
  #define STEP(C0,C1,P0,P1,t,GK,GV,GL) do{ SBAR(); \
    const lds_cptr vp_=vp0+sl_prev; \
    VRD(0); SBAR(); float sacc=(P0[0]+P0[1]); \
    GAPA(C0=__builtin_amdgcn_mfma_f32_32x32x16_bf16(kf[0],qr[0],negm,0,0,0), P0[2],P0[3],P0[4],P0[5],     pw0[0]=PKW(P0,0), pw0[1]=PKW(P0,2), pw0); \
    VRD(4); SBAR(); GAPA(C1=__builtin_amdgcn_mfma_f32_32x32x16_bf16(kf[1],qr[0],negm,0,0,0), P0[6],P0[7],P0[8],P0[9],     pw0[2]=PKW(P0,4), pw0[3]=PKW(P0,6), pw0); \
    VRD(1); SBAR(); GAPA(C0=__builtin_amdgcn_mfma_f32_32x32x16_bf16(kf[2],qr[1],C0,0,0,0),   P0[10],P0[11],P0[12],P0[13], pw1[0]=PKW(P0,8), pw1[1]=PKW(P0,10), pw1); \
    VRD(5); SBAR(); GAPA(C1=__builtin_amdgcn_mfma_f32_32x32x16_bf16(kf[3],qr[1],C1,0,0,0),   P0[14],P0[15],P1[0],P1[1],   pw1[2]=PKW(P0,12),pw1[3]=PKW(P0,14), pw1); \
    VRD(2); SBAR(); GAPA(C0=__builtin_amdgcn_mfma_f32_32x32x16_bf16(kf[4],qr[2],C0,0,0,0),   P1[2],P1[3],P1[4],P1[5],     pw2[0]=PKW(P1,0), pw2[1]=PKW(P1,2), pw2); \
    VRD(6); SBAR(); GAPA(C1=__builtin_amdgcn_mfma_f32_32x32x16_bf16(kf[5],qr[2],C1,0,0,0),   P1[6],P1[7],P1[8],P1[9],     pw2[2]=PKW(P1,4), pw2[3]=PKW(P1,6), pw2); \
    VRD(3); SBAR(); GAPA(C0=__builtin_amdgcn_mfma_f32_32x32x16_bf16(kf[6],qr[3],C0,0,0,0),   P1[10],P1[11],P1[12],P1[13], pw3[0]=PKW(P1,8), pw3[1]=PKW(P1,10), pw3); \
    VRD(7); SBAR(); GAPA(C1=__builtin_amdgcn_mfma_f32_32x32x16_bf16(kf[7],qr[3],C1,0,0,0),   P1[14],P1[15],0.f,0.f,       pw3[2]=PKW(P1,12),pw3[3]=PKW(P1,14), pw3); \
    l_reg+=sacc; \
    if(GK){DMA_K((t)+3,sl_cur);} if(GV){DMA_V((t)+1,sl_next);} \
    CMASK(C0,C1,t); \
    { float a=MX3(C0[0],C0[1],C1[0]),b=MX3(C0[2],C0[3],C1[1]); a=MX3(a,C1[2],C1[3]); \
      _Pragma("unroll") for(int r=4;r<16;r+=4){a=MX3(a,C0[r],C0[r+1]);b=MX3(b,C0[r+2],C0[r+3]);a=MX3(a,C1[r],C1[r+1]);b=MX3(b,C1[r+2],C1[r+3]);} \
      float rm=__builtin_fmaxf(a,b); { auto rr=__builtin_amdgcn_permlane32_swap(__float_as_uint(rm),__float_as_uint(rm),false,false); rm=__builtin_fmaxf(__uint_as_float(rr[0]),__uint_as_float(rr[1])); } \
      resc=false; \
      if(__builtin_expect(__any(rm>(float)THRL),0)){ const float dl=__builtin_fmaxf(rm,0.f); mhat+=dl; \
        _Pragma("unroll") for(int r=0;r<16;++r){C0[r]-=dl;C1[r]-=dl;} \
        _Pragma("unroll") for(int r=0;r<16;++r)negm[r]=-mhat; asm volatile("":"+v"(negm)); \
        const float f=__builtin_amdgcn_exp2f(-dl); l_reg*=f; if(hi==0)wsf[r32]=f; resc=true; } } \
    SBAR(); \
    GAPB(o[0]=__builtin_amdgcn_mfma_f32_32x32x16_bf16(PAF(0),VFR(0),o[0],0,0,0), C0,0); \
    GAPB(o[1]=__builtin_amdgcn_mfma_f32_32x32x16_bf16(PAF(0),VFR(4),o[1],0,0,0), C0,4); \
    KRD(GL,0); GAPB(o[0]=__builtin_amdgcn_mfma_f32_32x32x16_bf16(PAF(1),VFR(1),o[0],0,0,0), C0,8); \
    KRD(GL,1); GAPB(o[1]=__builtin_amdgcn_mfma_f32_32x32x16_bf16(PAF(1),VFR(5),o[1],0,0,0), C0,12); \
    KRD(GL,2); GAPB(o[0]=__builtin_amdgcn_mfma_f32_32x32x16_bf16(PAF(2),VFR(2),o[0],0,0,0), C1,0); \
    KRD(GL,3); GAPB(o[1]=__builtin_amdgcn_mfma_f32_32x32x16_bf16(PAF(2),VFR(6),o[1],0,0,0), C1,4); \
    GAPB(o[0]=__builtin_amdgcn_mfma_f32_32x32x16_bf16(PAF(3),VFR(3),o[0],0,0,0), C1,8); \
    GAPB(o[1]=__builtin_amdgcn_mfma_f32_32x32x16_bf16(PAF(3),VFR(7),o[1],0,0,0), C1,12); \
    }while(0)
  int t=1;
  #undef CMASK
  #define CMASK(P0,P1,t) do{}while(0)
  for(;t+7<NT;t+=2){
    STEP(pB0,pB1,pA0,pA1,t,true,true,true);     WAIT_BAR(2); RESC(); ROT();
    STEP(pA0,pA1,pB0,pB1,t+1,true,true,true);   WAIT_BAR(2); RESC(); ROT();
  }
  #undef CMASK
  #define CMASK(P0,P1,t) do{int jb_=(t)-(NT-4); if(jb_>=-2)cmask(P0,P1,jb_,qrel,hi,tab);}while(0)
  #define ENDW(tt) do{ if((tt)+3<NT){WAIT_BAR(2);} else if((tt)+2<NT){WAIT_BAR(1);} else {WAIT_BAR(0);} }while(0)
  for(;t+1<NT;t+=2){
    STEP(pB0,pB1,pA0,pA1,t,(t+3<NT),(t+1<NT),(t+1<NT));       ENDW(t);   RESC(); ROT();
    STEP(pA0,pA1,pB0,pB1,t+1,(t+4<NT),(t+2<NT),(t+2<NT));     ENDW(t+1); RESC(); ROT();
  }
  STEP(pB0,pB1,pA0,pA1,NT-1,false,false,false); RESC();
  { float sacc=pB0[0]+pB0[1]; _Pragma("unroll") for(int r=2;r<16;++r)sacc+=pB0[r]; _Pragma("unroll") for(int r=0;r<16;++r)sacc+=pB1[r]; l_reg+=sacc;
    pw0=(u32x4){PKW(pB0,0),PKW(pB0,2),PKW(pB0,4),PKW(pB0,6)};pw1=(u32x4){PKW(pB0,8),PKW(pB0,10),PKW(pB0,12),PKW(pB0,14)};pw2=(u32x4){PKW(pB1,0),PKW(pB1,2),PKW(pB1,4),PKW(pB1,6)};pw3=(u32x4){PKW(pB1,8),PKW(pB1,10),PKW(pB1,12),PKW(pB1,14)};
    SBAR(); pv(o,vb0+sl_cur,PAF(0),PAF(1),PAF(2),PAF(3)); }
  #undef PKW
  #undef PAF
  #undef VFR
  #undef PIN
  #undef MX3
  #undef GAPA
  #undef GAPB
  #undef EX
  #undef VRD
  #undef KRD
  #undef STEP
  #undef ENDW
  {auto rr=__builtin_amdgcn_permlane32_swap(__float_as_uint(l_reg),__float_as_uint(l_reg),false,false);l_reg=__uint_as_float(rr[0])+__uint_as_float(rr[1]);}
  if(hi==0)wsf[32+r32]=l_reg;asm volatile("s_waitcnt lgkmcnt(0)":::"memory");
  float rli[16];
  #pragma unroll
  for(int r=0;r<16;++r)rli[r]=__builtin_amdgcn_rcpf(wsf[32+crow(r,hi)]);
  bf16*Ow=O+(rowbase+q0+wid*QBLK)*PO;
  { bf16*stg=(bf16*)(shm+LDS_OST)+wid*2048;
    #pragma unroll
    for(int r=0;r<16;++r){const int orow=crow(r,hi);
      #pragma unroll
      for(int d0=0;d0<2;++d0)stg[orow*64+d0*32+r32]=__float2bfloat16(o[d0][r]*rli[r]);}
    asm volatile("s_waitcnt lgkmcnt(0)":::"memory");
    #pragma unroll
    for(int i=0;i<4;++i){const int row=i*8+(lane>>3),ch=lane&7; const u32x4 v=*(const u32x4*)(stg+row*64+ch*8); ATTN_STORE16(Ow+(long)row*PO+ch*8,v);} }
  asm volatile("s_waitcnt lgkmcnt(0)\n\ts_barrier":::"memory");
  #undef DMA_K
  #undef DMA_V
  #undef CMASK
  #undef START
  #undef RESC
  #undef ROT
}
constexpr int ATTN_LDS_BYTES=LDS_BYTES;
#undef SBAR
#undef WAIT_BAR
}
namespace xat {
#define XLAS __attribute__((address_space(3)))
typedef unsigned short bf16_t;
typedef short bf16x8 __attribute__((ext_vector_type(8)));
typedef float f32x16 __attribute__((ext_vector_type(16)));
typedef unsigned u32x4 __attribute__((ext_vector_type(4)));
typedef unsigned u32x2 __attribute__((ext_vector_type(2)));
typedef float f32x2_t __attribute__((ext_vector_type(2))); typedef __bf16 bf16x2_t __attribute__((ext_vector_type(2)));
__device__ __forceinline__ unsigned cvtpk(float lo, float hi) { f32x2_t v = {lo, hi}; bf16x2_t b = __builtin_convertvector(v, bf16x2_t); return __builtin_bit_cast(unsigned, b); }
constexpr int KP = 528, CHB = 32 * KP, XS_OFF = 34816, XS_BYTES = 8704, LDS_BYTES = XS_OFF + 8 * XS_BYTES;
__device__ __forceinline__ void unit(XLAS unsigned char* lds, const bf16_t* Qg, const bf16_t* Kg, const bf16_t* Vg, bf16_t* Og) {
    int tid_ = threadIdx.x; asm volatile("" : "+v"(tid_)); const int tid = tid_, lane = tid & 63, r32 = lane & 31, hi = lane >> 5; const int wid = __builtin_amdgcn_readfirstlane(tid >> 6);
    const int sr = tid >> 4, sseg = tid & 15;
    const bf16_t* kgp = Kg + (size_t)sr * 4096 + sseg * 16;
    const bf16_t* vgp = Vg + (size_t)sr * 4096 + sseg * 16;
    const unsigned wofs = (unsigned)(sr * KP + sseg * 32);
#define XAT_SRC(c) ((c) < 8 ? kgp + (size_t)(c) * 32 * 4096 : vgp + (size_t)((c) - 8) * 32 * 4096)
    u32x4 g[2][2];
    g[0][0] = *(const u32x4*)(XAT_SRC(0)); g[0][1] = *(const u32x4*)(XAT_SRC(0) + 8); g[1][0] = *(const u32x4*)(XAT_SRC(1)); g[1][1] = *(const u32x4*)(XAT_SRC(1) + 8);
    XLAS unsigned char* xs = lds + XS_OFF + wid * XS_BYTES;
    bf16x8 qf[16];
#pragma unroll
    for (int hq = 0; hq < 2; ++hq) {
        const bf16_t* qbase = Qg + (size_t)(wid * 32 + (lane >> 4)) * 1024 + hq * 128 + (lane & 15) * 8;
        u32x4 qv[8];
#pragma unroll
        for (int i = 0; i < 8; ++i) qv[i] = *(const u32x4*)(qbase + (size_t)(4 * i) * 1024);
#pragma unroll
        for (int i = 0; i < 8; ++i) *(XLAS u32x4*)(xs + (4 * i + (lane >> 4)) * 272 + (lane & 15) * 16) = qv[i];
#pragma unroll
        for (int s = 0; s < 8; ++s) qf[hq * 8 + s] = *(const XLAS bf16x8*)(xs + r32 * 272 + s * 32 + hi * 16);
    }
    const int krow = (r32 & 0x13) | ((r32 & 4) << 1) | ((r32 & 8) >> 1);
    const unsigned kro = (unsigned)(krow * KP + hi * 16), vro = (unsigned)(r32 * KP + hi * 16);
    f32x16 S[8];
#pragma unroll
    for (int c = 0; c < 8; ++c) {
        XLAS unsigned char* buf = lds + (c & 1) * CHB;
        *(XLAS u32x4*)(buf + wofs) = g[c & 1][0]; *(XLAS u32x4*)(buf + wofs + 16) = g[c & 1][1];
        __syncthreads();
        { g[c & 1][0] = *(const u32x4*)(XAT_SRC(c + 2)); g[c & 1][1] = *(const u32x4*)(XAT_SRC(c + 2) + 8); }
        f32x16 a = {};
        bf16x8 kfa[4], kfb[4];
#pragma unroll
        for (int j = 0; j < 4; ++j) kfa[j] = *(const XLAS bf16x8*)(buf + kro + j * 32);
#pragma unroll
        for (int gq = 0; gq < 4; gq += 2) {
#pragma unroll
            for (int j = 0; j < 4; ++j) kfb[j] = *(const XLAS bf16x8*)(buf + kro + (4 * gq + 4 + j) * 32);
            __builtin_amdgcn_sched_barrier(0);
#pragma unroll
            for (int j = 0; j < 4; ++j) a = __builtin_amdgcn_mfma_f32_32x32x16_bf16(kfa[j], qf[4 * gq + j], a, 0, 0, 0);
            if (gq < 2) {
#pragma unroll
                for (int j = 0; j < 4; ++j) kfa[j] = *(const XLAS bf16x8*)(buf + kro + (4 * gq + 8 + j) * 32); }
            __builtin_amdgcn_sched_barrier(0);
#pragma unroll
            for (int j = 0; j < 4; ++j) a = __builtin_amdgcn_mfma_f32_32x32x16_bf16(kfb[j], qf[4 * gq + 4 + j], a, 0, 0, 0);
        }
        S[c] = a;
    }
    float mx = S[0][0];
#pragma unroll
    for (int c = 0; c < 8; ++c)
#pragma unroll
        for (int r = 0; r < 16; ++r) mx = __builtin_fmaxf(mx, S[c][r]);
    mx = __builtin_fmaxf(mx, __shfl_xor(mx, 32));
    float l = 0.f;
    u32x4 pw[8][2];
#pragma unroll
    for (int c = 0; c < 8; ++c) {
        f32x16 p;
#pragma unroll
        for (int r = 0; r < 16; ++r) { p[r] = __builtin_amdgcn_exp2f(S[c][r] - mx); l += p[r]; }
#pragma unroll
        for (int s = 0; s < 2; ++s) { pw[c][s].x = cvtpk(p[8 * s + 0], p[8 * s + 1]); pw[c][s].y = cvtpk(p[8 * s + 2], p[8 * s + 3]); pw[c][s].z = cvtpk(p[8 * s + 4], p[8 * s + 5]); pw[c][s].w = cvtpk(p[8 * s + 6], p[8 * s + 7]); }
    }
    l += __shfl_xor(l, 32);
    const float rl = 1.0f / l;
    bf16_t* obase = Og + (size_t)(wid * 32 + (lane >> 3)) * 1024 + (lane & 7) * 8;
#pragma unroll
    for (int db = 0; db < 8; ++db) {
        XLAS unsigned char* buf = lds + (db & 1) * CHB;
        *(XLAS u32x4*)(buf + wofs) = g[db & 1][0]; *(XLAS u32x4*)(buf + wofs + 16) = g[db & 1][1];
        __syncthreads();
        if (db < 6) { g[db & 1][0] = *(const u32x4*)(XAT_SRC(db + 10)); g[db & 1][1] = *(const u32x4*)(XAT_SRC(db + 10) + 8); }
        f32x16 o = {};
#pragma unroll
        for (int kb = 0; kb < 8; ++kb)
#pragma unroll
            for (int s = 0; s < 2; ++s) { const bf16x8 vf = *(const XLAS bf16x8*)(buf + vro + kb * 64 + s * 32); o = __builtin_amdgcn_mfma_f32_32x32x16_bf16(vf, __builtin_bit_cast(bf16x8, pw[kb][s]), o, 0, 0, 0); }
#pragma unroll
        for (int g4 = 0; g4 < 4; ++g4) { u32x2 w; w.x = cvtpk(o[4 * g4] * rl, o[4 * g4 + 1] * rl); w.y = cvtpk(o[4 * g4 + 2] * rl, o[4 * g4 + 3] * rl);
            *(XLAS u32x2*)(xs + r32 * 144 + ((db & 1) * 32 + 8 * g4 + 4 * hi) * 2) = w; }
        if (db & 1) {
#pragma unroll
            for (int i = 0; i < 4; ++i) { const u32x4 v = *(const XLAS u32x4*)(xs + (8 * i + (lane >> 3)) * 144 + (lane & 7) * 16); *(u32x4*)(obase + (size_t)(8 * i) * 1024 + (db >> 1) * 64) = v; }
        }
    }
}
#undef XAT_SRC
}
#define GAS __attribute__((address_space(1)))
#define LAS __attribute__((address_space(3)))
typedef unsigned short bf16;
typedef unsigned v4u __attribute__((ext_vector_type(4)));
typedef unsigned v2u __attribute__((ext_vector_type(2)));
typedef float f32x4 __attribute__((ext_vector_type(4)));
constexpr int NWAVES = 8;
constexpr int M = 65536, SEQ = 4096, DM = 1024, NMEM = 256, DEPTH = 4;
constexpr float LOG2E = 1.4426950408889634f;
constexpr float C2A = 0.125f * LOG2E;
constexpr float C2X = 0.0625f * LOG2E;
constexpr float LAMBDA_INIT0 = 0.2f, LAMBDA_INIT2 = 0.47071301834f;
constexpr float EPS = 1e-6f;
constexpr size_t MiB = 1u << 20;
constexpr size_t WS_SMALL = 1 * MiB;
constexpr size_t WS_WIN = 2 * MiB, WS_WOUT = 10 * MiB, WS_CIN = 14 * MiB, WS_COUT = 26 * MiB, WS_WQ = 30 * MiB, WS_WK = 38 * MiB, WS_WV = 46 * MiB, WS_WO = 54 * MiB, WS_W1 = 62 * MiB, WS_W2 = 94 * MiB;
constexpr size_t WS_MEMN = 126 * MiB, WS_KB = 134 * MiB, WS_VT = 166 * MiB, WS_SSQ = 198 * MiB, WS_HB = 202 * MiB, WS_MIX = 330 * MiB, WS_BIG = 458 * MiB, WS_ORAW = WS_BIG + 384 * MiB, WS_END = 970 * MiB;
constexpr int TABN = 704;
constexpr int LDS_BYTES = 147456, TAB_OFF = attn_body::LDS_TAB;
static_assert(attn_body::ATTN_LDS_BYTES <= 131072 && TABN * 4 <= 3072 && xat::LDS_BYTES <= 131072, "LDS map");

__device__ __forceinline__ float bf_lo(unsigned w) { return __uint_as_float(w << 16); }
__device__ __forceinline__ float bf_hi(unsigned w) { return __uint_as_float(w & 0xffff0000u); }
__device__ __forceinline__ unsigned pk2(float lo, float hi) { return pg8::cvt_pk_bf16(lo, hi); }
__device__ __forceinline__ float wave_sum(float v) {
#pragma unroll
    for (int o = 1; o < 64; o <<= 1) v += __shfl_xor(v, o);
    return v;
}
__device__ __forceinline__ void transpose_item(const float* W, int ldn, int Nc, bf16* WT, int ldk, int row_off, const float* rs, int ncs, float cs, LAS float* scr, int item, int lane) {
    const int nblk = Nc / 32, kb = item / nblk, nb = item % nblk, k0 = 64 * kb, n0 = 32 * nb;
    const float csl = (n0 + (lane & 31) < ncs) ? cs : 1.f;
#pragma unroll 8
    for (int i = 0; i < 32; ++i) { const int kk = 2 * i + (lane >> 5); float v = W[(size_t)(k0 + kk) * ldn + n0 + (lane & 31)] * csl; if (rs) v *= rs[k0 + kk]; scr[kk * 33 + (lane & 31)] = v; }
    asm volatile("s_waitcnt lgkmcnt(0)" ::: "memory");
    const int c = lane & 7;
#pragma unroll
    for (int j = 0; j < 4; ++j) { const int n = (lane >> 3) + 8 * j; const LAS float* s = scr + (8 * c) * 33 + n;
        v4u o; o.x = pk2(s[0 * 33], s[1 * 33]); o.y = pk2(s[2 * 33], s[3 * 33]); o.z = pk2(s[4 * 33], s[5 * 33]); o.w = pk2(s[6 * 33], s[7 * 33]);
        *(v4u*)(WT + (size_t)(row_off + n0 + n) * ldk + k0 + 8 * c) = o; }
    asm volatile("s_waitcnt lgkmcnt(0)" ::: "memory");
}
struct Args { const float* in[25]; float* out; unsigned char* ws; int lo, hi; };
enum { I_X = 0, I_MEM, I_RELB, I_MEMG, I_NMIXG, I_NXG, I_NMLPG, I_FING, I_ABWIN, I_ABWOUT, I_LQ1, I_LK1, I_LQ2, I_LK2, I_SUBLN, I_POOLW, I_POOLS, I_CWIN, I_CW, I_CWOUT, I_WQ, I_WKV, I_WO, I_W1, I_W2 };
enum { K_PRO = 0, K_MIXPROJ, K_ATTN, K_COMBINE, K_CONV, K_MIXOUT, K_XQ, K_XATTN, K_XO, K_UP, K_DOWN, K_FINAL };
constexpr int NPHASE = 30;
__host__ __device__ inline void decode_phase(int ph, int& kind, int& l) {
    if (ph == 0) { kind = K_PRO; l = 0; return; }
    if (ph == NPHASE - 1) { kind = K_FINAL; l = 0; return; }
    const int p0 = ph - 1; l = p0 / 7; const int p = p0 - 7 * l;
    kind = p == 0 ? K_MIXPROJ : p == 1 ? ((l & 1) == 0 ? K_ATTN : K_CONV) : p == 2 ? K_MIXOUT : p == 3 ? K_XQ : p == 4 ? K_XO : p == 5 ? K_UP : K_DOWN;
}

#define XB_TMO      128
#define XB_XCNT(j)  (256  + 64 * (j))
#define XB_XSUB(j)  (1280 + 64 * (j))
#define XB_XGEN(j)  (2304 + 64 * (j))
#define XB_TOP      3328
#define XB_TOPGEN   3392
#define XCD_BAR_WORDS 3456
#define XB_SPIN_CAP (1u << 22)

__device__ __forceinline__ unsigned xb_ld(unsigned* p)              { return __hip_atomic_load(p, __ATOMIC_RELAXED, __HIP_MEMORY_SCOPE_AGENT); }
__device__ __forceinline__ unsigned xb_add(unsigned* p, unsigned v) { return __hip_atomic_fetch_add(p, v, __ATOMIC_RELAXED, __HIP_MEMORY_SCOPE_AGENT); }
__device__ __forceinline__ unsigned xb_xcc_id() { return (unsigned)__builtin_amdgcn_s_getreg((3 << 11) | 20) & 0xFu; }
#define XB_SPIN(cond, bar) do { unsigned _sp = 0; while (cond) { __builtin_amdgcn_s_sleep(1); \
    if ((++_sp & 255u) == 0u) { if (xb_ld(&(bar)[XB_TMO])) break; if (_sp > XB_SPIN_CAP) { atomicAdd(&(bar)[XB_TMO], 1u); break; } } } } while (0)

struct XcdBarrier {
    unsigned* bar; unsigned x;
    volatile LAS unsigned* st;
};

__device__ __forceinline__ XcdBarrier xcd_barrier_post(unsigned* bar, volatile LAS unsigned* st) {
    XcdBarrier b; b.bar = bar; b.x = xb_xcc_id(); b.st = st;
    if (threadIdx.x == 0) (void)xb_add(&bar[XB_XCNT(b.x)], 1u);
    return b;
}
__device__ __forceinline__ void xcd_barrier_complete(unsigned* bar, unsigned x, unsigned& nloc, unsigned& nx) {
    const unsigned G = gridDim.x * gridDim.y * gridDim.z;
    unsigned sum, cnt, mine, sp = 0u;
    for (;;) {
        sum = 0u; cnt = 0u; mine = 0u;
#pragma unroll
        for (unsigned j = 0; j < 16; ++j) { const unsigned c = xb_ld(&bar[XB_XCNT(j)]); sum += c; cnt += (c > 0u) ? 1u : 0u; mine = (j == x) ? c : mine; }
        if (sum == G) break;
        __builtin_amdgcn_s_sleep(1);
        if ((++sp & 255u) == 0u) { if (xb_ld(&bar[XB_TMO])) break; if (sp > XB_SPIN_CAP) { atomicAdd(&bar[XB_TMO], 1u); break; } }
    }
    nloc = mine > 0u ? mine : 1u; nx = cnt > 0u ? cnt : 1u;
}

__device__ __forceinline__ void xcd_barrier(const XcdBarrier& b) {
    asm volatile("s_waitcnt vmcnt(0)" ::: "memory");
    __syncthreads();
    if (threadIdx.x == 0) {
        unsigned* bar = b.bar;
        __builtin_amdgcn_s_waitcnt(0);
        unsigned nloc = b.st[0], nx = b.st[1];
        if (nloc == 0u) { xcd_barrier_complete(bar, b.x, nloc, nx); b.st[0] = nloc; b.st[1] = nx; }
        const unsigned old = xb_add(&bar[XB_XSUB(b.x)], 1u);
        const unsigned gen = old / nloc;
        if (old + 1u == (gen + 1u) * nloc) {
            __builtin_amdgcn_fence(__ATOMIC_RELEASE, "agent");
            asm volatile("s_waitcnt vmcnt(0)" ::: "memory");
            const unsigned og = xb_add(&bar[XB_TOP], 1u);
            const unsigned tg = og / nx;
            if (og + 1u == (tg + 1u) * nx) xb_add(&bar[XB_TOPGEN], 1u);
            else XB_SPIN(xb_ld(&bar[XB_TOPGEN]) == tg, bar);
            __builtin_amdgcn_fence(__ATOMIC_ACQUIRE, "agent");
            xb_add(&bar[XB_XGEN(b.x)], 1u);
            asm volatile("s_waitcnt vmcnt(0)" ::: "memory");
        } else {
            XB_SPIN(xb_ld(&bar[XB_XGEN(b.x)]) == gen, bar);
            __builtin_amdgcn_fence(__ATOMIC_ACQUIRE, "agent");
            asm volatile("s_waitcnt vmcnt(0)" ::: "memory");
        }
    }
    __syncthreads();
}

constexpr int XB_ST_OFF = LDS_BYTES - 64;
__global__ void __launch_bounds__(NWAVES * 64, 2) trunk_fwd(Args args) {
    extern __shared__ __attribute__((aligned(16))) unsigned char lds[];
    cg::grid_group grid = cg::this_grid();
    LAS unsigned char* L = (LAS unsigned char*)lds;
    if (threadIdx.x == 0) { ((volatile LAS unsigned*)(L + XB_ST_OFF))[0] = 0u; ((volatile LAS unsigned*)(L + XB_ST_OFF))[1] = 0u; }
    __syncthreads();
    if (blockIdx.x == 0) for (int i = threadIdx.x; i < XCD_BAR_WORDS; i += NWAVES * 64) ((unsigned*)args.ws)[i] = 0u;
    const int ph_hi = args.hi; int ph0 = args.lo;
    if (ph0 == 0) {
        const int l = 0, li = 0; (void)l; (void)li;
        int tid_ = threadIdx.x, G_ = gridDim.x, bid_ = blockIdx.x; asm volatile("" : "+v"(tid_), "+s"(G_), "+s"(bid_));
        const int tid = tid_, lane = tid & 63, wid = __builtin_amdgcn_readfirstlane(tid >> 6), G = G_, bid = bid_, gw = bid * NWAVES + wid, NGW = G * NWAVES;
        const __attribute__((address_space(4))) Args* ap = (const __attribute__((address_space(4))) Args*)__builtin_amdgcn_kernarg_segment_ptr();
        asm volatile("" : "+s"(ap));
#define ARGIN(i) (ap->in[i])
        unsigned char* ws = ap->ws;
        float* out = ap->out;
        float* TAB = (float*)(ws + WS_SMALL); float* LAM = (float*)(ws + WS_SMALL + 16384);
        bf16* WIN = (bf16*)(ws + WS_WIN); bf16* WOUT = (bf16*)(ws + WS_WOUT); bf16* CIN = (bf16*)(ws + WS_CIN); bf16* COUT = (bf16*)(ws + WS_COUT);
        bf16* WQ = (bf16*)(ws + WS_WQ); bf16* WK = (bf16*)(ws + WS_WK); bf16* WV = (bf16*)(ws + WS_WV); bf16* WO = (bf16*)(ws + WS_WO); bf16* W1 = (bf16*)(ws + WS_W1); bf16* W2 = (bf16*)(ws + WS_W2);
        bf16* MEMN = (bf16*)(ws + WS_MEMN); bf16* KB = (bf16*)(ws + WS_KB); bf16* VT = (bf16*)(ws + WS_VT); float* SSQ = (float*)(ws + WS_SSQ);
        bf16* HB = (bf16*)(ws + WS_HB); bf16* MIX = (bf16*)(ws + WS_MIX); bf16* BIG = (bf16*)(ws + WS_BIG); bf16* ORAW = (bf16*)(ws + WS_ORAW);
#ifndef DIS_PRO
            LAS float* scr = (LAS float*)(L + wid * 16384);
            constexpr int NIT = 15616;
            struct TD { const float* W; const float* rs; bf16* WT; int ldn, Nc, ldk, ncs, item, remap; float cs; };
#define TDESC(R, D) do { int r = (R); D.rs = nullptr; D.ldk = 1024; D.ncs = 0; D.cs = 1.f; D.remap = 0; \
                if (r < 1024) { const int i = r >> 9; D.W = ARGIN(I_ABWIN) + (size_t)i * 1024 * 2048; D.ldn = 2048; D.Nc = 2048; D.WT = WIN + (size_t)i * 2048 * 1024; D.rs = ARGIN(I_NMIXG) + (2 * i) * 1024; D.ncs = 512; D.cs = C2A; D.item = r & 511; } \
                else if ((r -= 1024) < 256) { const int i = r >> 7; D.W = ARGIN(I_ABWOUT) + (size_t)i * 1024 * 1024; D.ldn = 1024; D.Nc = 1024; D.WT = WOUT + (size_t)i * 1024 * 1024; D.item = r & 127; } \
                else if ((r -= 256) < 1536) { const int i = r / 768; D.W = ARGIN(I_CWIN) + (size_t)i * 1024 * 3072; D.ldn = 3072; D.Nc = 3072; D.WT = CIN + (size_t)i * 3072 * 1024; D.rs = ARGIN(I_NMIXG) + (2 * i + 1) * 1024; D.item = r % 768; D.remap = 1; } \
                else if ((r -= 1536) < 512) { const int i = r >> 8; D.W = ARGIN(I_CWOUT) + (size_t)i * 1024 * 1024; D.ldn = 1024; D.Nc = 1024; D.WT = COUT + (size_t)i * 1024 * 1024; D.item = r & 255; } \
                else if ((r -= 512) < 1024) { const int i = r >> 8; D.W = ARGIN(I_WQ) + (size_t)i * 1024 * 1024; D.ldn = 1024; D.Nc = 1024; D.WT = WQ + (size_t)i * 1024 * 1024; D.rs = ARGIN(I_NXG) + i * 1024; D.ncs = 1024; D.cs = C2X; D.item = r & 255; } \
                else if ((r -= 1024) < 1024) { const int i = r >> 8; D.W = ARGIN(I_WKV) + (size_t)i * 1024 * 2048; D.ldn = 2048; D.Nc = 1024; D.WT = WK + (size_t)i * 1024 * 1024; D.item = r & 255; } \
                else if ((r -= 1024) < 1024) { const int i = r >> 8; D.W = ARGIN(I_WKV) + (size_t)i * 1024 * 2048 + 1024; D.ldn = 2048; D.Nc = 1024; D.WT = WV + (size_t)i * 1024 * 1024; D.item = r & 255; } \
                else if ((r -= 1024) < 1024) { const int i = r >> 8; D.W = ARGIN(I_WO) + (size_t)i * 1024 * 1024; D.ldn = 1024; D.Nc = 1024; D.WT = WO + (size_t)i * 1024 * 1024; D.item = r & 255; } \
                else if ((r -= 1024) < 4096) { const int i = r >> 10; D.W = ARGIN(I_W1) + (size_t)i * 1024 * 4096; D.ldn = 4096; D.Nc = 4096; D.WT = W1 + (size_t)i * 4096 * 1024; D.rs = ARGIN(I_NMLPG) + i * 1024; D.item = r & 1023; } \
                else { r -= 4096; const int i = r >> 10; D.W = ARGIN(I_W2) + (size_t)i * 4096 * 1024; D.ldn = 1024; D.Nc = 1024; D.WT = W2 + (size_t)i * 1024 * 4096; D.ldk = 4096; D.item = r & 1023; } } while (0)
#define TLOAD(D, V) do { const int nblk_ = D.Nc / 64, kb_ = D.item / nblk_, nb_ = D.item % nblk_; const float* wp_ = D.W + (size_t)(64 * kb_ + (lane >> 4)) * D.ldn + 64 * nb_ + (lane & 15) * 4; \
                _Pragma("unroll") for (int i = 0; i < 16; ++i) V[i] = *(const f32x4*)(wp_ + (size_t)(4 * i) * D.ldn); } while (0)
            { f32x4 tv[16]; TD d, dn; int it = gw; bool have = it < NIT;
              LAS float* scr2 = (LAS float*)(L + wid * 16640);
              if (have) { TDESC(it, d); TLOAD(d, tv); }
              while (have) {
                const int itn = it + NGW; const bool hn = itn < NIT;
                const int nblk = d.Nc / 64, kb = d.item / nblk, nb = d.item % nblk, k0 = 64 * kb, n0 = 64 * nb;
                const int n4 = (lane & 15) * 4, kq = lane >> 4;
                const int on0 = !d.remap || n0 < 1024 ? n0 : (n0 < 2048 ? 1024 + ((n0 - 1024) >> 7) * 256 + ((n0 - 1024) & 127) : 1024 + ((n0 - 2048) >> 7) * 256 + 128 + ((n0 - 2048) & 127));
                const float csl = (n0 + n4 < d.ncs) ? d.cs : 1.f;
#pragma unroll
                for (int i = 0; i < 16; ++i) { const int kk = 4 * i + kq; float sc = csl; if (d.rs) sc *= d.rs[k0 + kk];
                    scr2[(n4 + 0) * 65 + kk] = tv[i][0] * sc; scr2[(n4 + 1) * 65 + kk] = tv[i][1] * sc; scr2[(n4 + 2) * 65 + kk] = tv[i][2] * sc; scr2[(n4 + 3) * 65 + kk] = tv[i][3] * sc; }
                if (hn) { TDESC(itn, dn); TLOAD(dn, tv); }
                asm volatile("s_waitcnt lgkmcnt(0)" ::: "memory");
                const int c = lane & 7;
#pragma unroll
                for (int j = 0; j < 8; ++j) { const int n = (lane >> 3) + 8 * j; const LAS float* sp = scr2 + n * 65 + 8 * c;
                    v4u o; o.x = pk2(sp[0], sp[1]); o.y = pk2(sp[2], sp[3]); o.z = pk2(sp[4], sp[5]); o.w = pk2(sp[6], sp[7]);
                    *(v4u*)(d.WT + (size_t)(on0 + n) * d.ldk + k0 + 8 * c) = o; }
                asm volatile("s_waitcnt lgkmcnt(0)" ::: "memory");
                d = dn; it = itn; have = hn;
              } }
#undef TDESC
#undef TLOAD
            for (int t = gw; t < 2 * 4 * 16 * 16; t += NGW) {
                const int nb = t & 15, c8 = (t >> 4) & 15, g = (t >> 8) & 3, i = t >> 10, n = nb * 64 + lane;
                const float* pw = ARGIN(I_POOLW) + ((size_t)(i * 4 + g) * 128 + c8 * 8) * 128; const float* psc = ARGIN(I_POOLS) + i * 512 + g * 128;
                const float* wo = ARGIN(I_ABWOUT) + (size_t)i * 1024 * 1024 + (size_t)(512 + g * 128) * 1024 + n;
                float a[8];
#pragma unroll
                for (int e = 0; e < 8; ++e) a[e] = 0.f;
#pragma unroll 8
                for (int d = 0; d < 128; ++d) { const float w = wo[(size_t)d * 1024] * psc[d];
#pragma unroll
                    for (int e = 0; e < 8; ++e) a[e] += pw[e * 128 + d] * w; }
                v4u o; o.x = pk2(a[0], a[1]); o.y = pk2(a[2], a[3]); o.z = pk2(a[4], a[5]); o.w = pk2(a[6], a[7]);
                *(v4u*)(WOUT + (size_t)i * 1024 * 1024 + (size_t)n * 1024 + 512 + g * 128 + c8 * 8) = o;
            }
            for (int row = gw; row < 16 * NMEM; row += NGW) {
                const f32x4* xr = (const f32x4*)(ARGIN(I_MEM) + (size_t)row * DM) + lane; const f32x4* gr = (const f32x4*)(ARGIN(I_MEMG)) + lane;
                f32x4 v[4]; float s = 0.f;
#pragma unroll
                for (int j = 0; j < 4; ++j) { v[j] = xr[64 * j]; s += (v[j][0] * v[j][0] + v[j][1] * v[j][1]) + (v[j][2] * v[j][2] + v[j][3] * v[j][3]); }
                const float rstd = __builtin_amdgcn_rsqf(wave_sum(s) * (1.f / DM) + EPS);
                v2u* o8 = (v2u*)(MEMN + (size_t)row * DM) + lane;
#pragma unroll
                for (int j = 0; j < 4; ++j) { const f32x4 g4 = gr[64 * j]; v2u w; w.x = pk2(v[j][0] * rstd * g4[0], v[j][1] * rstd * g4[1]); w.y = pk2(v[j][2] * rstd * g4[2], v[j][3] * rstd * g4[3]); o8[64 * j] = w; }
            }
            for (int row = gw; row < M; row += 2 * NGW) {
                const int row1 = row + NGW;
                const f32x4* xr0 = (const f32x4*)(ARGIN(I_X) + (size_t)row * DM) + lane; const f32x4* xr1 = (const f32x4*)(ARGIN(I_X) + (size_t)row1 * DM) + lane;
                f32x4 v0[4], v1[4];
#pragma unroll
                for (int j = 0; j < 4; ++j) { v0[j] = xr0[64 * j]; v1[j] = xr1[64 * j]; }
                v2u* o80 = (v2u*)(HB + (size_t)row * DM) + lane; v2u* o81 = (v2u*)(HB + (size_t)row1 * DM) + lane;
                float s0 = 0.f, s1 = 0.f;
#pragma unroll
                for (int j = 0; j < 4; ++j) { s0 += (v0[j][0] * v0[j][0] + v0[j][1] * v0[j][1]) + (v0[j][2] * v0[j][2] + v0[j][3] * v0[j][3]); s1 += (v1[j][0] * v1[j][0] + v1[j][1] * v1[j][1]) + (v1[j][2] * v1[j][2] + v1[j][3] * v1[j][3]);
                    v2u w; w.x = pk2(v0[j][0], v0[j][1]); w.y = pk2(v0[j][2], v0[j][3]); o80[64 * j] = w; w.x = pk2(v1[j][0], v1[j][1]); w.y = pk2(v1[j][2], v1[j][3]); o81[64 * j] = w; }
                s0 = wave_sum(s0); s1 = wave_sum(s1);
                if (lane < 16) { SSQ[(size_t)row * 16 + lane] = (lane == 0) ? s0 : 0.f; SSQ[(size_t)row1 * 16 + lane] = (lane == 0) ? s1 : 0.f; }
            }
            for (int e = bid * 512 + tid; e < 4 * TABN; e += G * 512) {
                const int h = e / TABN, d = e % TABN - 256; float v;
                if (d < 0) v = -INFINITY;
                else { int bk; if (d < 16) bk = d; else { bk = 16 + (int)(__builtin_amdgcn_logf((float)d * 0.0625f) * (16.0f / 3.0f)); bk = bk < 31 ? bk : 31; }
                       v = (ARGIN(I_RELB)[bk * 4 + h] - ARGIN(I_RELB)[31 * 4 + h]) * LOG2E; }
                TAB[e] = v;
            }
            if (bid == 0 && tid < 2) {
                float a = 0.f, b = 0.f;
                for (int d = 0; d < 64; ++d) { a += ARGIN(I_LQ1)[tid * 64 + d] * ARGIN(I_LK1)[tid * 64 + d]; b += ARGIN(I_LQ2)[tid * 64 + d] * ARGIN(I_LK2)[tid * 64 + d]; }
                LAM[tid] = __builtin_amdgcn_exp2f(a * LOG2E) - __builtin_amdgcn_exp2f(b * LOG2E) + (tid == 0 ? LAMBDA_INIT0 : LAMBDA_INIT2);
            }
#endif
        ph0 = 1; if (ph0 < ph_hi) grid.sync();
#undef ARGIN
    }
    (void)xcd_barrier_post((unsigned*)args.ws, (volatile LAS unsigned*)(L + XB_ST_OFF));
    for (int ph = ph0; ph < ph_hi; ++ph) {
        int kind, l; decode_phase(ph, kind, l); const int li = l >> 1;
        int tid_ = threadIdx.x, G_ = gridDim.x, bid_ = blockIdx.x; asm volatile("" : "+v"(tid_), "+s"(G_), "+s"(bid_));
        const int tid = tid_, lane = tid & 63, wid = __builtin_amdgcn_readfirstlane(tid >> 6), G = G_, bid = bid_, gw = bid * NWAVES + wid, NGW = G * NWAVES;
        const __attribute__((address_space(4))) Args* ap = (const __attribute__((address_space(4))) Args*)__builtin_amdgcn_kernarg_segment_ptr();
        asm volatile("" : "+s"(ap));
#define ARGIN(i) (ap->in[i])
        unsigned char* ws = ap->ws;
        float* out = ap->out;
        float* TAB = (float*)(ws + WS_SMALL); float* LAM = (float*)(ws + WS_SMALL + 16384);
        bf16* WIN = (bf16*)(ws + WS_WIN); bf16* WOUT = (bf16*)(ws + WS_WOUT); bf16* CIN = (bf16*)(ws + WS_CIN); bf16* COUT = (bf16*)(ws + WS_COUT);
        bf16* WQ = (bf16*)(ws + WS_WQ); bf16* WK = (bf16*)(ws + WS_WK); bf16* WV = (bf16*)(ws + WS_WV); bf16* WO = (bf16*)(ws + WS_WO); bf16* W1 = (bf16*)(ws + WS_W1); bf16* W2 = (bf16*)(ws + WS_W2);
        bf16* MEMN = (bf16*)(ws + WS_MEMN); bf16* KB = (bf16*)(ws + WS_KB); bf16* VT = (bf16*)(ws + WS_VT); float* SSQ = (float*)(ws + WS_SSQ);
        bf16* HB = (bf16*)(ws + WS_HB); bf16* MIX = (bf16*)(ws + WS_MIX); bf16* BIG = (bf16*)(ws + WS_BIG); bf16* ORAW = (bf16*)(ws + WS_ORAW);
        if (kind == K_MIXPROJ || kind == K_XQ) {
            if (kind == K_MIXPROJ && l == 0) {
                for (int z = 0; z < 2; ++z) {
                    pg8::Gemm g{z == 0 ? MEMN : WV, z == 0 ? WK : MEMN, 4096, 4096, 1024}; pg8::StaticOrder S; S.init(4096, 4096, G, bid);
                    pg8::EpiProj<0, false> E{0x7fffffff, 0, z == 0 ? KB : VT, 4096, nullptr, nullptr, 0};
#ifndef DIS_G0
                    pg8::gemm_phase<pg8::EpiProj<0, false>, pg8::StaticOrder, true, true>(L, g, S, E);
#endif
                }
            }
            const bf16* Bt; int N;
            if (kind == K_XQ) { Bt = WQ + (size_t)l * 1024 * 1024; N = 1024; }
            else if ((l & 1) == 0) { Bt = WIN + (size_t)li * 2048 * 1024; N = 2048; }
            else { Bt = CIN + (size_t)li * 3072 * 1024; N = 3072; }
            pg8::Gemm g{HB, Bt, M, N, 1024}; pg8::StaticOrder S; S.init(M, N, G, bid);
#define PG8_LAS __attribute__((address_space(3)))
            const PG8_LAS float* rsl = nullptr; int pm0 = 0;
            if (G == 256) {
                PG8_LAS float* rw = (PG8_LAS float*)(L + 131072); pg8::Unit u0, uu; S.next(0, u0); pm0 = u0.pm; int last = -1;
                for (int i = 0; S.next(i, uu); ++i) { const int slot = (uu.pm - pm0) >> 3; if (slot != last && slot >= 0 && slot < 8) { if (tid < 256) rw[slot * 256 + tid] = pg8::row_rstd(SSQ, uu.pm * 256 + tid); last = slot; } }
                asm volatile("s_waitcnt vmcnt(0) lgkmcnt(0)" ::: "memory"); __syncthreads(); rsl = rw;
            }
            pg8::EpiProj<0, true> E{N == 3072 ? 4 : 0x7fffffff, 1024, BIG, N == 3072 ? 2048 : N, SSQ, rsl, pm0};
#ifndef DIS_G1
            pg8::gemm_phase<pg8::EpiProj<0, true>, pg8::StaticOrder, true, true>(L, g, S, E);
#endif
            if (kind == K_XQ) {
                asm volatile("s_waitcnt vmcnt(0)" ::: "memory"); __syncthreads();
                pg8::Unit xu;
                for (int i = 0; S.next(i, xu); ++i) { const int tm = xu.pm, h = xu.pn, b = tm >> 4;
#ifndef DIS_XAT
                    xat::unit(L, BIG + (size_t)tm * 256 * 1024 + h * 256, KB + (size_t)b * 256 * 4096 + l * 1024 + h * 256, VT + (size_t)(l * 1024 + h * 256) * 4096 + b * 256, MIX + (size_t)tm * 256 * 1024 + h * 256);
#endif
                }
            }
        }
        else if (kind == K_UP) {
            pg8::Gemm g{HB, W1 + (size_t)l * 4096 * 1024, M, 4096, 1024}; pg8::StaticOrder S; S.init(M, 4096, G, bid);
            const PG8_LAS float* rsl = nullptr; int pm0 = 0;
            if (G == 256) {
                PG8_LAS float* rw = (PG8_LAS float*)(L + 131072); pg8::Unit u0, uu; S.next(0, u0); pm0 = u0.pm; int last = -1;
                for (int i = 0; S.next(i, uu); ++i) { const int slot = (uu.pm - pm0) >> 3; if (slot != last && slot >= 0 && slot < 8) { if (tid < 256) rw[slot * 256 + tid] = pg8::row_rstd(SSQ, uu.pm * 256 + tid); last = slot; } }
                asm volatile("s_waitcnt vmcnt(0) lgkmcnt(0)" ::: "memory"); __syncthreads(); rsl = rw;
            }
            pg8::EpiProj<1, true> E{0x7fffffff, 0, BIG, 4096, SSQ, rsl, pm0};
#ifndef DIS_G2
            pg8::gemm_phase<pg8::EpiProj<1, true>, pg8::StaticOrder, true, true>(L, g, S, E);
#endif
        }
        else if (kind == K_MIXOUT || kind == K_XO || kind == K_DOWN) {
            const bf16* A; const bf16* Bt; int K = 1024;
            if (kind == K_MIXOUT) { A = MIX; Bt = ((l & 1) == 0 ? WOUT : COUT) + (size_t)li * 1024 * 1024; }
            else if (kind == K_XO) { A = MIX; Bt = WO + (size_t)l * 1024 * 1024; }
            else { A = BIG; Bt = W2 + (size_t)l * 1024 * 4096; K = 4096; }
            pg8::Gemm g{A, Bt, M, 1024, K}; pg8::StaticOrder S; S.init(M, 1024, G, bid);
            pg8::EpiResid E{HB, SSQ};
#ifndef DIS_G3
            pg8::gemm_phase<pg8::EpiResid, pg8::StaticOrder, true, true>(L, g, S, E);
#endif
        }
        else if (kind == K_ATTN) {
            const LAS float* tab = (const LAS float*)(L + TAB_OFF); int cur_h = -1;
            for (int item = bid; item < 256; item += G) {
                const int it2 = (item & 7) * 32 + (item >> 3), b = it2 >> 4, h = (it2 >> 2) & 3, sq = it2 & 3;
                if (h != cur_h) { __syncthreads(); { LAS float* tw = (LAS float*)(L + TAB_OFF); const float t0v = TAB[h * TABN + tid]; const float t1v = TAB[h * TABN + (tid < TABN - 512 ? tid + 512 : tid)]; tw[tid] = t0v; if (tid < TABN - 512) tw[tid + 512] = t1v; } cur_h = h; asm volatile("s_waitcnt vmcnt(0) lgkmcnt(0)" ::: "memory"); __syncthreads(); }
                for (int qi = 0; qi < 4; ++qi) {
                    const int qb = qi == 0 ? 15 - sq : qi == 1 ? 8 + sq : qi == 2 ? 7 - sq : sq;
                    for (int vh = 0; vh < 4; ++vh) { const int mp = vh >> 1, j = vh & 1;
#ifndef DIS_ATTN
                        attn_body::attn_unit<8>(b, qb, (const attn_body::bf16*)(BIG + h * 128 + mp * 64), (const attn_body::bf16*)(BIG + 512 + h * 128 + mp * 64), (const attn_body::bf16*)(BIG + 1024 + h * 128 + j * 64),
                                                (attn_body::bf16*)(ORAW + mp * 512 + h * 128 + j * 64), tab, (char*)lds);
#endif
                        asm volatile("s_waitcnt vmcnt(0)" ::: "memory");
                    }
                    __syncthreads();
                    { int lane_ = threadIdx.x & 63; asm volatile("" : "+v"(lane_));
                      const float lam = LAM[li], post = 1.0f - (li == 0 ? LAMBDA_INIT0 : LAMBDA_INIT2);
                      const f32x4* gp = (const f32x4*)(ARGIN(I_SUBLN) + li * 128 + (lane_ & 15) * 8); const f32x4 ga = gp[0], gb = gp[1];
                      const size_t rowbase = (size_t)b * SEQ + (size_t)qb * 256 + wid * 32 + (lane_ >> 4); const int cofs = h * 128 + (lane_ & 15) * 8;
                      v4u aa[8], cc[8];
#pragma unroll
                      for (int it = 0; it < 8; ++it) { const size_t row = rowbase + it * 4; aa[it] = *(const v4u*)(ORAW + row * 1024 + cofs); cc[it] = *(const v4u*)(ORAW + row * 1024 + 512 + cofs); }
#pragma unroll
                      for (int it = 0; it < 8; ++it) { const size_t row = rowbase + it * 4; const v4u a = aa[it], c = cc[it];
                        float v[8] = {bf_lo(a.x) - lam * bf_lo(c.x), bf_hi(a.x) - lam * bf_hi(c.x), bf_lo(a.y) - lam * bf_lo(c.y), bf_hi(a.y) - lam * bf_hi(c.y),
                                      bf_lo(a.z) - lam * bf_lo(c.z), bf_hi(a.z) - lam * bf_hi(c.z), bf_lo(a.w) - lam * bf_lo(c.w), bf_hi(a.w) - lam * bf_hi(c.w)};
                        float sv = 0.f;
#pragma unroll
                        for (int e = 0; e < 8; ++e) sv += v[e] * v[e];
                        sv += __shfl_xor(sv, 1); sv += __shfl_xor(sv, 2); sv += __shfl_xor(sv, 4); sv += __shfl_xor(sv, 8);
                        const float r = __builtin_amdgcn_rsqf(sv * (1.0f / 128.0f) + EPS) * post;
                        v4u o; o.x = pk2(v[0] * r * ga[0], v[1] * r * ga[1]); o.y = pk2(v[2] * r * ga[2], v[3] * r * ga[3]); o.z = pk2(v[4] * r * gb[0], v[5] * r * gb[1]); o.w = pk2(v[6] * r * gb[2], v[7] * r * gb[3]);
                        *(v4u*)(MIX + row * 1024 + cofs) = o; }
                    }
                }
            }
#ifndef DIS_POOL
            { const int w = 2 << (lane >> 4);
              for (int task = gw; task < M / 32; task += NGW) {
                const int row0 = task * 32, t0 = row0 & (SEQ - 1);
                const bf16* up = BIG + (size_t)row0 * 2048 + 1536 + lane * 8; bf16* op = MIX + (size_t)row0 * 1024 + 512 + lane * 8;
                float sum[8];
#pragma unroll
                for (int e = 0; e < 8; ++e) sum[e] = 0.f;
                if (t0 > 0) for (int jj = 1; jj <= w; ++jj) {   const v4u q = *(const v4u*)(up - (size_t)jj * 2048);
                    sum[0] += bf_lo(q.x); sum[1] += bf_hi(q.x); sum[2] += bf_lo(q.y); sum[3] += bf_hi(q.y); sum[4] += bf_lo(q.z); sum[5] += bf_hi(q.z); sum[6] += bf_lo(q.w); sum[7] += bf_hi(q.w); }
                for (int i0 = 0; i0 < 32; i0 += 4) {
                    v4u qq[4], oo[4];
#pragma unroll
                    for (int k = 0; k < 4; ++k) { qq[k] = *(const v4u*)(up + (size_t)(i0 + k) * 2048); oo[k] = *(const v4u*)(up + ((long)(i0 + k) - w) * 2048); }
#pragma unroll
                    for (int k = 0; k < 4; ++k) { const int i = i0 + k; const v4u q = qq[k], o = oo[k];
                    float cur[8] = {bf_lo(q.x), bf_hi(q.x), bf_lo(q.y), bf_hi(q.y), bf_lo(q.z), bf_hi(q.z), bf_lo(q.w), bf_hi(q.w)};
#pragma unroll
                    for (int e = 0; e < 8; ++e) sum[e] += cur[e];
                    const int t = t0 + i;
                    if (t - w >= 0) {
                        sum[0] -= bf_lo(o.x); sum[1] -= bf_hi(o.x); sum[2] -= bf_lo(o.y); sum[3] -= bf_hi(o.y); sum[4] -= bf_lo(o.z); sum[5] -= bf_hi(o.z); sum[6] -= bf_lo(o.w); sum[7] -= bf_hi(o.w); }
                    const float rc = 1.0f / (float)((t + 1) < w ? (t + 1) : w);
                    v4u r; r.x = pk2(sum[0] * rc - cur[0], sum[1] * rc - cur[1]); r.y = pk2(sum[2] * rc - cur[2], sum[3] * rc - cur[3]); r.z = pk2(sum[4] * rc - cur[4], sum[5] * rc - cur[5]); r.w = pk2(sum[6] * rc - cur[6], sum[7] * rc - cur[7]);
                    *(v4u*)(op + (size_t)i * 1024) = r; }
                }
              } }
#endif
        }
        else if (kind == K_CONV) {
#ifndef DIS_CONV
            for (int task = gw; task < (M / 32) * 2; task += NGW) {
                const int row0 = (task >> 1) * 32, t0 = row0 & (SEQ - 1), ch = (task & 1) * 512 + lane * 8;
                const float* cw = ARGIN(I_CW) + (size_t)li * 3 * 1024 + ch;
                float w0[8], w1[8], w2[8];
#pragma unroll
                for (int e = 0; e < 8; ++e) { w0[e] = cw[e]; w1[e] = cw[1024 + e]; w2[e] = cw[2048 + e]; }
                const bf16* pp = BIG + (size_t)row0 * 2048 + ch; bf16* op = MIX + (size_t)row0 * 1024 + ch;
                float z1[8], z2[8];
#pragma unroll
                for (int e = 0; e < 8; ++e) { z1[e] = 0.f; z2[e] = 0.f; }
                if (t0 > 0) {
                    const v4u q1 = *(const v4u*)(pp - 2048 + 1024), q2 = *(const v4u*)(pp - 2 * 2048 + 1024);
                    z1[0] = bf_lo(q1.x); z1[1] = bf_hi(q1.x); z1[2] = bf_lo(q1.y); z1[3] = bf_hi(q1.y); z1[4] = bf_lo(q1.z); z1[5] = bf_hi(q1.z); z1[6] = bf_lo(q1.w); z1[7] = bf_hi(q1.w);
                    z2[0] = bf_lo(q2.x); z2[1] = bf_hi(q2.x); z2[2] = bf_lo(q2.y); z2[3] = bf_hi(q2.y); z2[4] = bf_lo(q2.z); z2[5] = bf_hi(q2.z); z2[6] = bf_lo(q2.w); z2[7] = bf_hi(q2.w);
                }
                for (int i0 = 0; i0 < 32; i0 += 4) {
                    v4u bqq[4], zqq[4];
#pragma unroll
                    for (int k = 0; k < 4; ++k) { bqq[k] = __builtin_nontemporal_load((const v4u*)(pp + (size_t)(i0 + k) * 2048)); zqq[k] = __builtin_nontemporal_load((const v4u*)(pp + (size_t)(i0 + k) * 2048 + 1024)); }
#pragma unroll
                    for (int k = 0; k < 4; ++k) { const int i = i0 + k; const v4u bq = bqq[k], zq = zqq[k];
                    const float bb[8] = {bf_lo(bq.x), bf_hi(bq.x), bf_lo(bq.y), bf_hi(bq.y), bf_lo(bq.z), bf_hi(bq.z), bf_lo(bq.w), bf_hi(bq.w)};
                    const float z[8] = {bf_lo(zq.x), bf_hi(zq.x), bf_lo(zq.y), bf_hi(zq.y), bf_lo(zq.z), bf_hi(zq.z), bf_lo(zq.w), bf_hi(zq.w)};
                    float y[8];
#pragma unroll
                    for (int e = 0; e < 8; ++e) { y[e] = bb[e] * (z2[e] * w0[e] + z1[e] * w1[e] + z[e] * w2[e]); z2[e] = z1[e]; z1[e] = z[e]; }
                    v4u r; r.x = pk2(y[0], y[1]); r.y = pk2(y[2], y[3]); r.z = pk2(y[4], y[5]); r.w = pk2(y[6], y[7]);
                    *(v4u*)(op + (size_t)i * 1024) = r; }
                }
            }
#endif
        }
        else {
            const f32x4* gr = (const f32x4*)(ARGIN(I_FING) + lane * 8);
            const f32x4 g0 = gr[0], g1 = gr[1], g2 = gr[128], g3 = gr[129];
            for (int row0 = gw; row0 < M; row0 += 2 * NGW) {
                v4u h0[2], h1[2];
#pragma unroll
                for (int k = 0; k < 2; ++k) { const bf16* hp = HB + (size_t)(row0 + k * NGW) * DM + lane * 8; h0[k] = *(const v4u*)(hp); h1[k] = *(const v4u*)(hp + 512); }
#pragma unroll
                for (int k = 0; k < 2; ++k) { float* op = out + (size_t)(row0 + k * NGW) * DM + lane * 8;
                    const f32x4 a0 = {bf_lo(h0[k].x), bf_hi(h0[k].x), bf_lo(h0[k].y), bf_hi(h0[k].y)}, a1 = {bf_lo(h0[k].z), bf_hi(h0[k].z), bf_lo(h0[k].w), bf_hi(h0[k].w)};
                    const f32x4 a2 = {bf_lo(h1[k].x), bf_hi(h1[k].x), bf_lo(h1[k].y), bf_hi(h1[k].y)}, a3 = {bf_lo(h1[k].z), bf_hi(h1[k].z), bf_lo(h1[k].w), bf_hi(h1[k].w)};
                    float sq = ((a0[0] * a0[0] + a0[1] * a0[1]) + (a0[2] * a0[2] + a0[3] * a0[3])) + ((a1[0] * a1[0] + a1[1] * a1[1]) + (a1[2] * a1[2] + a1[3] * a1[3]))
                             + ((a2[0] * a2[0] + a2[1] * a2[1]) + (a2[2] * a2[2] + a2[3] * a2[3])) + ((a3[0] * a3[0] + a3[1] * a3[1]) + (a3[2] * a3[2] + a3[3] * a3[3]));
                    const float r = __builtin_amdgcn_rsqf(wave_sum(sq) * (1.f / DM) + EPS);
                    *(f32x4*)(op) = a0 * r * g0; *(f32x4*)(op + 4) = a1 * r * g1; *(f32x4*)(op + 512) = a2 * r * g2; *(f32x4*)(op + 516) = a3 * r * g3; }
            }
        }
        if (ph + 1 < ph_hi) { XcdBarrier xb_; xb_.bar = (unsigned*)ws; xb_.x = xb_xcc_id(); xb_.st = (volatile LAS unsigned*)(L + XB_ST_OFF); xcd_barrier(xb_); }
    }
}


#ifndef N_LAUNCH_MODE
#define N_LAUNCH_MODE 1
#endif
extern "C" void kernel_launch(void* const* d_in, const int* in_sizes, int n_in, void* d_out, int out_size, void* d_ws, size_t ws_size, hipStream_t stream) {
    static int grid = 0;
    if (grid == 0) {
        if (n_in != 25 || in_sizes[0] != M * DM || out_size != M * DM || ws_size < WS_END) { fprintf(stderr, "kernel_launch: unexpected shapes (n_in %d, in0 %d, out %d, ws %zu); nothing launched\n", n_in, n_in > 0 ? in_sizes[0] : -1, out_size, ws_size); grid = -1; return; }
        int dev = 0, cus = 0, per_cu = 0;
        hipGetDevice(&dev); hipDeviceGetAttribute(&cus, hipDeviceAttributeMultiprocessorCount, dev);
        if (hipFuncSetAttribute((const void*)trunk_fwd, hipFuncAttributeMaxDynamicSharedMemorySize, LDS_BYTES) != hipSuccess) { fprintf(stderr, "kernel_launch: hipFuncSetAttribute failed\n"); grid = -1; return; }
        if (hipOccupancyMaxActiveBlocksPerMultiprocessor(&per_cu, (const void*)trunk_fwd, NWAVES * 64, LDS_BYTES) != hipSuccess || per_cu < 1) { fprintf(stderr, "kernel_launch: occupancy query gave %d\n", per_cu); per_cu = 1; }
        (void)hipGetLastError();
        grid = cus;
    }
    if (grid < 0) return;
    Args a{};
    for (int i = 0; i < 25; ++i) a.in[i] = (const float*)d_in[i];
    a.out = (float*)d_out; a.ws = (unsigned char*)d_ws;
#if N_LAUNCH_MODE == 1
    a.lo = 0; a.hi = NPHASE;
    { void* kargs[] = {&a}; hipError_t e = hipLaunchCooperativeKernel((const void*)trunk_fwd, dim3(grid), dim3(NWAVES * 64), kargs, LDS_BYTES, stream);
      if (e != hipSuccess) fprintf(stderr, "cooperative launch failed: %s (grid %d)\n", hipGetErrorString(e), grid); }
#elif N_LAUNCH_MODE == 0
    for (int p = 0; p < NPHASE; ++p) { a.lo = p; a.hi = p + 1; void* kargs[] = {&a};
        hipError_t e = hipLaunchCooperativeKernel((const void*)trunk_fwd, dim3(grid), dim3(NWAVES * 64), kargs, LDS_BYTES, stream);
        if (e != hipSuccess) { fprintf(stderr, "launch %d failed: %s (grid %d)\n", p, hipGetErrorString(e), grid); break; } }
#endif
}
```

```cpp
#include <hip/hip_runtime.h>
#include <hip/hip_cooperative_groups.h>
#include <hip/hip_bf16.h>
#include <cstdio>
#include <cstdint>
#include <cmath>
namespace cg = cooperative_groups;
namespace pg8 {
#define PG8_LAS __attribute__((address_space(3)))
typedef unsigned short bf16_t;
typedef short bf16x8 __attribute__((ext_vector_type(8)));
typedef float f32x4 __attribute__((ext_vector_type(4)));
typedef unsigned u32x4 __attribute__((ext_vector_type(4)));
constexpr int BM = 256, BK = 64, HALF = 128, HTB = HALF * BK * 2  , STAGE_BYTES = 8 * HTB, NXCD = 8, WGM = 8;

__host__ __device__ __forceinline__ int lds_byte(int r, int c) { const int st = (r >> 4) * 2 + (c >> 5), rr = r & 15, cc = c & 31, ob = rr * 64 + cc * 2; return st * 1024 + (ob ^ (((ob >> 9) & 1) << 5)); }
__host__ __device__ __forceinline__ void stage_rc(int b, int& R, int& C) { const int st = b / 1024, sb = b % 1024, swz = sb ^ (((sb >> 9) & 1) << 5); R = (st >> 1) * 16 + swz / 64; C = (st & 1) * 32 + (swz % 64) / 2; }
__host__ __device__ __forceinline__ int perm32(int rho) { const int n = rho >> 4, i = rho & 15; return 8 * (i >> 2) + 4 * n + (i & 3); }

struct Unit { int pm, pn; };
struct Gemm { const bf16_t* A; const bf16_t* Bt; int M, N, K; };

struct StaticOrder {
    int nM, nN, nwg, G, c;
    __host__ __device__ void init(int M, int N, int G_, int c_) { nM = M / BM; nN = N / BM; nwg = nM * nN; G = G_; c = c_; }
    __host__ __device__ bool next(int i, Unit& u) const {
        const long L = (long)i * G + c; if (L >= nwg) return false;
        int wgid = (int)L; { const int q = nwg / NXCD, r = nwg % NXCD, xcd = wgid % NXCD, off = wgid / NXCD; wgid = (xcd < r ? xcd * (q + 1) : r * (q + 1) + (xcd - r) * q) + off; }
        const int nig = WGM * nN, gid = wgid / nig, fm = gid * WGM, gsz = (nM - fm) < WGM ? (nM - fm) : WGM;
        u.pm = fm + ((wgid % nig) % gsz); u.pn = (wgid % nig) / gsz; return true;
    }
    __device__ __forceinline__ void a_ready(const Unit&) const {}
    __device__ __forceinline__ void done(const Unit&) const {}
};

__device__ __forceinline__ unsigned cvt_pk_bf16(float lo, float hi) { unsigned r; asm volatile("v_cvt_pk_bf16_f32 %0, %1, %2" : "=v"(r) : "v"(lo), "v"(hi)); return r; }
typedef float f32x2 __attribute__((ext_vector_type(2)));
__device__ __forceinline__ float row_rstd(const float* ssq, int row) {
    const f32x4* p = (const f32x4*)(ssq + (size_t)row * 16);
    const f32x4 a = p[0], b = p[1], c = p[2], d = p[3];
    const float s = (((a[0] + a[1]) + (a[2] + a[3])) + ((b[0] + b[1]) + (b[2] + b[3]))) + (((c[0] + c[1]) + (c[2] + c[3])) + ((d[0] + d[1]) + (d[2] + d[3])));
    return __builtin_amdgcn_rsqf(s * (1.0f / 1024.0f) + 1e-6f);
}
template <int ACT  , bool SCALE> struct EpiProj {
    static constexpr bool PERM = true, AFTER_DRAIN = false;
    int zfrom, zcol;
    bf16_t* O; int ldc; const float* ssq; const PG8_LAS float* rsl; int pm0;
    __device__ __forceinline__ void operator()(const f32x4 (&acc)[2][2][4][2], const Unit& u, int wr, int wc, int fr, int fq) const {
        const int row0 = u.pm * BM + wr * 64 + fr, col0 = u.pn * BM + wc * 32 + 8 * fq;
        if constexpr (ACT == 0 && SCALE) { if (u.pn >= zfrom) {
            const int zc = zcol + (u.pn - zfrom) * HALF + wc * 32 + 8 * fq;
#pragma unroll
            for (int ai = 0; ai < 2; ++ai)
#pragma unroll
                for (int m = 0; m < 4; ++m) { const int row = row0 + ai * HALF + m * 16;
                    const float sc = rsl ? rsl[((u.pm - pm0) >> 3) * 256 + (row & 255)] : row_rstd(ssq, row);
                    const f32x4 z0 = (acc[ai][0][m][0] * sc) * (acc[ai][1][m][0] * sc), z1 = (acc[ai][0][m][1] * sc) * (acc[ai][1][m][1] * sc);
                    u32x4 w; w.x = cvt_pk_bf16(z0[0], z0[1]); w.y = cvt_pk_bf16(z0[2], z0[3]); w.z = cvt_pk_bf16(z1[0], z1[1]); w.w = cvt_pk_bf16(z1[2], z1[3]);
                    __builtin_nontemporal_store(w, (u32x4*)(O + (size_t)row * ldc + zc)); }
            return; } }
#pragma unroll
        for (int ai = 0; ai < 2; ++ai)
#pragma unroll
            for (int m = 0; m < 4; ++m) { const int row = row0 + ai * HALF + m * 16; bf16_t* rowp = O + (size_t)row * ldc + col0;
                float sc = 1.f; if (SCALE) sc = rsl ? rsl[((u.pm - pm0) >> 3) * 256 + (row & 255)] : row_rstd(ssq, row);
#pragma unroll
                for (int bj = 0; bj < 2; ++bj) { f32x4 v0 = acc[ai][bj][m][0] * sc, v1 = acc[ai][bj][m][1] * sc;
                    if (ACT == 1) {
#pragma unroll
                        for (int j = 0; j < 4; ++j) { const float a = __builtin_fmaxf(v0[j], 0.f), b = __builtin_fmaxf(v1[j], 0.f); v0[j] = a * a; v1[j] = b * b; } }
                    u32x4 w; w.x = cvt_pk_bf16(v0[0], v0[1]); w.y = cvt_pk_bf16(v0[2], v0[3]); w.z = cvt_pk_bf16(v1[0], v1[1]); w.w = cvt_pk_bf16(v1[2], v1[3]);
                    __builtin_nontemporal_store(w, (u32x4*)(rowp + bj * HALF)); } }
    }
};
struct EpiResid {
    static constexpr bool PERM = true, AFTER_DRAIN = false;
    bf16_t* hb; float* ssq;
    __device__ __forceinline__ void operator()(const f32x4 (&acc)[2][2][4][2], const Unit& u, int wr, int wc, int fr, int fq) const {
        const int row0 = u.pm * BM + wr * 64 + fr, col0 = u.pn * BM + wc * 32 + 8 * fq;
        u32x4 hv[2][4][2];
#pragma unroll
        for (int ai = 0; ai < 2; ++ai)
#pragma unroll
            for (int m = 0; m < 4; ++m)
#pragma unroll
                for (int bj = 0; bj < 2; ++bj) hv[ai][m][bj] = *(const u32x4*)(hb + (size_t)(row0 + ai * HALF + m * 16) * 1024 + col0 + bj * HALF);
#pragma unroll
        for (int ai = 0; ai < 2; ++ai)
#pragma unroll
            for (int m = 0; m < 4; ++m) { const int row = row0 + ai * HALF + m * 16; float s = 0.f;
#pragma unroll
                for (int bj = 0; bj < 2; ++bj) { const size_t off = (size_t)row * 1024 + col0 + bj * HALF;
                    const u32x4 h4 = hv[ai][m][bj];
                    const f32x4 b0 = {__uint_as_float(h4.x << 16), __uint_as_float(h4.x & 0xffff0000u), __uint_as_float(h4.y << 16), __uint_as_float(h4.y & 0xffff0000u)};
                    const f32x4 b1 = {__uint_as_float(h4.z << 16), __uint_as_float(h4.z & 0xffff0000u), __uint_as_float(h4.w << 16), __uint_as_float(h4.w & 0xffff0000u)};
                    const f32x4 v0 = acc[ai][bj][m][0] + b0, v1 = acc[ai][bj][m][1] + b1;
                    u32x4 w; w.x = cvt_pk_bf16(v0[0], v0[1]); w.y = cvt_pk_bf16(v0[2], v0[3]); w.z = cvt_pk_bf16(v1[0], v1[1]); w.w = cvt_pk_bf16(v1[2], v1[3]);
                    *(u32x4*)(hb + off) = w;
                    s += ((v0[0] * v0[0] + v0[1] * v0[1]) + (v0[2] * v0[2] + v0[3] * v0[3])) + ((v1[0] * v1[0] + v1[1] * v1[1]) + (v1[2] * v1[2] + v1[3] * v1[3])); }
                s += __shfl_xor(s, 16); s += __shfl_xor(s, 32);
                if (fq == 0) ssq[(size_t)row * 16 + u.pn * 4 + wc] = s; }
    }
};
template <class Epi, class Sched, bool ALIGN_EPI = false, bool SP2 = false>
__device__ __forceinline__ void gemm_phase(PG8_LAS unsigned char* lds, const Gemm g, const Sched& S, const Epi& E) {
    int tid_ = threadIdx.x; asm volatile("" : "+v"(tid_));
    const int tid = tid_, wid = __builtin_amdgcn_readfirstlane(tid >> 6), lane = tid & 63, wr = wid >> 2, wc = wid & 3, fr = lane & 15, fq = lane >> 4;
    const int K = g.K, nt = K / BK;
    unsigned voffA[2], voffB[2];
#pragma unroll
    for (int i = 0; i < 2; ++i) { int R, C; stage_rc(tid * 16 + i * 8192, R, C); const int Rb = Epi::PERM ? ((R & ~31) + perm32(R & 31)) : R;
        voffA[i] = (unsigned)(R * K + C) * 2u; voffB[i] = (unsigned)(Rb * K + C) * 2u; }
    const size_t kstep = (size_t)(BK * 2);
    const size_t hstep = (size_t)HALF * K * 2;
    const size_t tstep = 2 * hstep;
    const unsigned ldsw = (unsigned)wid * 1024u;
    const int aoff = lds_byte(wr * 64 + fr, fq * 8), boff = lds_byte(wc * 32 + fr, fq * 8);
#define PG8_SA(b, h) (((b) * 2 + (h)) * HTB)
#define PG8_SB(b, h) ((4 + (b) * 2 + (h)) * HTB)
#define PG8_STAGE(bufoff, gbase, voff) do { _Pragma("unroll") for (int _i = 0; _i < 2; ++_i) \
        __builtin_amdgcn_global_load_lds((const unsigned*)((const char*)(gbase) + (voff)[_i]), (PG8_LAS unsigned*)(lds + (bufoff) + ldsw + _i * 8192), 16, 0, 0); } while (0)
#define PG8_LDA(dst, b, h) do { _Pragma("unroll") for (int m = 0; m < 4; ++m) _Pragma("unroll") for (int k = 0; k < 2; ++k) dst[m][k] = *(const PG8_LAS bf16x8*)(lds + PG8_SA(b, h) + aoff + m * 2048 + k * 1024); } while (0)
#define PG8_LDB(dst, b, h) do { _Pragma("unroll") for (int n = 0; n < 2; ++n) _Pragma("unroll") for (int k = 0; k < 2; ++k) dst[n][k] = *(const PG8_LAS bf16x8*)(lds + PG8_SB(b, h) + boff + n * 2048 + k * 1024); } while (0)
#define PG8_MMA(ai, bj, At, Bt) do { __builtin_amdgcn_s_setprio(1); _Pragma("unroll") for (int m = 0; m < 4; ++m) _Pragma("unroll") for (int n = 0; n < 2; ++n) _Pragma("unroll") for (int k = 0; k < 2; ++k) \
        acc[ai][bj][m][n] = __builtin_amdgcn_mfma_f32_16x16x32_bf16(Bt[n][k], At[m][k], acc[ai][bj][m][n], 0, 0, 0); __builtin_amdgcn_s_setprio(0); } while (0)
#define PG8_WAIT_V(n) asm volatile("s_waitcnt vmcnt(" #n ")" ::: "memory")
#define PG8_WAIT_L(n) asm volatile("s_waitcnt lgkmcnt(" #n ")" ::: "memory")
#define PG8_BAR __builtin_amdgcn_s_barrier()
#define PG8_SCHED __builtin_amdgcn_sched_barrier(0)
    Unit cur, nxt; int ui = 0;
    if (!S.next(0, cur)) return;
    f32x4 acc[2][2][4][2];
#pragma unroll
    for (int a = 0; a < 2; ++a)
#pragma unroll
        for (int b = 0; b < 2; ++b)
#pragma unroll
            for (int m = 0; m < 4; ++m)
#pragma unroll
                for (int n = 0; n < 2; ++n) acc[a][b][m][n] = (f32x4){0.f, 0.f, 0.f, 0.f};
    bf16x8 At[4][2], B0[2][2], B1[2][2];
    const char* cA = (const char*)g.A + (size_t)cur.pm * tstep; const char* cB = (const char*)g.Bt + (size_t)cur.pn * tstep;
    S.a_ready(cur);
    if constexpr (SP2) {
        PG8_STAGE(PG8_SB(0, 0), cB, voffB); PG8_STAGE(PG8_SB(0, 1), cB + hstep, voffB); PG8_STAGE(PG8_SA(0, 0), cA, voffA); PG8_STAGE(PG8_SA(0, 1), cA + hstep, voffA);
        if (wr == 1) PG8_BAR;
        PG8_WAIT_V(2); PG8_BAR;
        PG8_STAGE(PG8_SB(1, 0), cB + kstep, voffB); PG8_STAGE(PG8_SA(1, 0), cA + kstep, voffA); PG8_STAGE(PG8_SB(1, 1), cB + hstep + kstep, voffB);
        PG8_WAIT_V(6); PG8_BAR;
    } else {
        PG8_STAGE(PG8_SB(0, 0), cB, voffB); PG8_STAGE(PG8_SA(0, 0), cA, voffA); PG8_STAGE(PG8_SB(0, 1), cB + hstep, voffB); PG8_STAGE(PG8_SA(0, 1), cA + hstep, voffA);
        if (wr == 1) PG8_BAR;
        PG8_WAIT_V(4); PG8_BAR;
        PG8_STAGE(PG8_SB(1, 0), cB + kstep, voffB); PG8_STAGE(PG8_SA(1, 0), cA + kstep, voffA); PG8_STAGE(PG8_SB(1, 1), cB + hstep + kstep, voffB);
        PG8_WAIT_V(6); PG8_BAR;
    }
    for (;;) {
        const bool has_next = S.next(ui + 1, nxt);
        const char* nA = has_next ? (const char*)g.A + (size_t)nxt.pm * tstep : cA; const char* nB = has_next ? (const char*)g.Bt + (size_t)nxt.pn * tstep : cB;
        for (int t = 0; t < nt; t += 2) {
            const bool last = (t == nt - 2);
            const char* a1 = cA + (size_t)(t + 1) * kstep;
            const char* a2 = last ? nA : cA + (size_t)(t + 2) * kstep; const char* b2 = last ? nB : cB + (size_t)(t + 2) * kstep;
            const char* a3 = a2 + kstep; const char* b3 = b2 + kstep;
            if (last && has_next) S.a_ready(nxt);
            if constexpr (SP2) {
            PG8_LDB(B0, 0, 0); PG8_LDB(B1, 0, 1); PG8_SCHED; PG8_LDA(At, 0, 0); PG8_STAGE(PG8_SA(1, 1), a1 + hstep, voffA);
            PG8_WAIT_V(8); PG8_WAIT_L(0); PG8_BAR; PG8_MMA(0, 0, At, B0); PG8_MMA(0, 1, At, B1); PG8_BAR; PG8_SCHED;
            PG8_LDA(At, 0, 1); PG8_STAGE(PG8_SB(0, 0), b2, voffB); PG8_STAGE(PG8_SB(0, 1), b2 + hstep, voffB); PG8_STAGE(PG8_SA(0, 0), a2, voffA);
            PG8_WAIT_V(8); PG8_WAIT_L(0); PG8_BAR; PG8_MMA(1, 0, At, B0); PG8_MMA(1, 1, At, B1); PG8_BAR; PG8_SCHED;
            PG8_LDB(B0, 1, 0); PG8_LDB(B1, 1, 1); PG8_SCHED; PG8_LDA(At, 1, 0); PG8_STAGE(PG8_SA(0, 1), a2 + hstep, voffA);
            PG8_WAIT_V(8); PG8_WAIT_L(0); PG8_BAR; PG8_MMA(0, 0, At, B0); PG8_MMA(0, 1, At, B1); PG8_BAR; PG8_SCHED;
            PG8_LDA(At, 1, 1); PG8_STAGE(PG8_SB(1, 0), b3, voffB); PG8_STAGE(PG8_SB(1, 1), b3 + hstep, voffB); PG8_STAGE(PG8_SA(1, 0), a3, voffA);
            PG8_WAIT_V(8); PG8_WAIT_L(0); PG8_BAR; PG8_MMA(1, 0, At, B0); PG8_MMA(1, 1, At, B1); PG8_BAR; PG8_SCHED;
            } else {
            PG8_LDB(B0, 0, 0); PG8_SCHED; PG8_LDA(At, 0, 0); PG8_STAGE(PG8_SA(1, 1), a1 + hstep, voffA);
            PG8_WAIT_L(8); PG8_BAR; PG8_WAIT_L(0); PG8_MMA(0, 0, At, B0); PG8_BAR; PG8_SCHED;
            PG8_LDB(B1, 0, 1); PG8_STAGE(PG8_SB(0, 0), b2, voffB);
            PG8_BAR; PG8_WAIT_L(0); PG8_MMA(0, 1, At, B1); PG8_BAR;
            PG8_LDA(At, 0, 1); PG8_STAGE(PG8_SA(0, 0), a2, voffA);
            PG8_BAR; PG8_WAIT_L(0); PG8_MMA(1, 0, At, B0); PG8_BAR; PG8_SCHED;
            PG8_STAGE(PG8_SB(0, 1), b2 + hstep, voffB);
            PG8_WAIT_V(6); PG8_BAR; PG8_MMA(1, 1, At, B1); PG8_BAR;
            PG8_LDB(B0, 1, 0); PG8_SCHED; PG8_LDA(At, 1, 0); PG8_STAGE(PG8_SA(0, 1), a2 + hstep, voffA);
            PG8_WAIT_L(8); PG8_BAR; PG8_WAIT_L(0); PG8_MMA(0, 0, At, B0); PG8_BAR; PG8_SCHED;
            PG8_LDB(B1, 1, 1); PG8_STAGE(PG8_SB(1, 0), b3, voffB);
            PG8_BAR; PG8_WAIT_L(0); PG8_MMA(0, 1, At, B1); PG8_BAR;
            PG8_LDA(At, 1, 1); PG8_STAGE(PG8_SA(1, 0), a3, voffA);
            PG8_BAR; PG8_WAIT_L(0); PG8_MMA(1, 0, At, B0); PG8_BAR; PG8_SCHED;
            PG8_STAGE(PG8_SB(1, 1), b3 + hstep, voffB);
            PG8_WAIT_V(6); PG8_BAR; PG8_MMA(1, 1, At, B1); PG8_BAR;
            }
        }
        if constexpr (ALIGN_EPI) { if (wr == 0) PG8_BAR; }
        if constexpr (!Epi::AFTER_DRAIN) { E(acc, cur, wr, wc, fr, fq); S.done(cur); }
        if (!has_next) break;
#pragma unroll
        for (int a = 0; a < 2; ++a)
#pragma unroll
            for (int b = 0; b < 2; ++b)
#pragma unroll
                for (int m = 0; m < 4; ++m)
#pragma unroll
                    for (int n = 0; n < 2; ++n) acc[a][b][m][n] = (f32x4){0.f, 0.f, 0.f, 0.f};
        cur = nxt; cA = nA; cB = nB; ++ui;
        if constexpr (ALIGN_EPI) { if (wr == 1) PG8_BAR; }
    }
    PG8_WAIT_V(0);
    if constexpr (!ALIGN_EPI) { if (wr == 0) PG8_BAR; }
    PG8_BAR;
    if constexpr (Epi::AFTER_DRAIN) { E.fused(acc, cur, wr, wc, fr, fq, lds, wid, lane); S.done(cur); }
#undef PG8_SA
#undef PG8_SB
#undef PG8_STAGE
#undef PG8_LDA
#undef PG8_LDB
#undef PG8_MMA
#undef PG8_WAIT_V
#undef PG8_WAIT_L
#undef PG8_BAR
#undef PG8_SCHED
}
}
#include <hip/hip_bf16.h>
#include <cmath>
namespace attn_body {
using bf16=__hip_bfloat16;
using bf16x8=__attribute__((ext_vector_type(8)))short;
using s16x4=__attribute__((ext_vector_type(4)))short;
using f32x16=__attribute__((ext_vector_type(16)))float;
using u32x4=__attribute__((ext_vector_type(4)))unsigned;
constexpr int BATCH=16,SEQ=4096,D=64,PQ=2048,PO=1024;
constexpr int NW=8,QBLK=32,QB=QBLK*NW,KVBLK=64,NQB=SEQ/QB;
constexpr int ATTN_UNIT_ROWS=QB;
__device__ __forceinline__ int crow(int r,int hi){return (r&3)+8*(r>>2)+4*hi;}
#define SBAR() __builtin_amdgcn_sched_barrier(0)
__device__ __forceinline__ void cmask(f32x16&p0,f32x16&p1,int jb,int qrel,int hi,const __attribute__((address_space(3))) float*tab){
  asm volatile("s_nop 15\n\ts_nop 7":"+v"(p0),"+v"(p1));
  const __attribute__((address_space(3))) float*tp=tab+(qrel-64*jb-4*hi+256);
  #pragma unroll
  for(int r=0;r<16;++r){const int o=(r&3)+8*(r>>2); float a0=tp[-o], a1=tp[-o-32]; asm volatile("v_add_f32_e32 %0, %1, %0":"+v"(p0[r]):"v"(a0)); asm volatile("v_add_f32_e32 %0, %1, %0":"+v"(p1[r]):"v"(a1));}
}

constexpr int NSLOT=3, SLOTB=8192;
constexpr int LDS_K=0, LDS_V=NSLOT*SLOTB, LDS_WS=2*NSLOT*SLOTB, LDS_TAB=LDS_WS+NW*64*4, LDS_OST=LDS_TAB+3072, LDS_BYTES=LDS_OST+NW*4096;
constexpr float C2=0.125f*1.4426950408889634f;
__device__ __forceinline__ void glds16(const void*gsrc,unsigned lds_dst){unsigned keep;
  asm volatile("s_mov_b32 %0, m0\n\ts_mov_b32 m0, %2\n\ts_nop 0\n\tglobal_load_lds_dwordx4 %1, off\n\ts_mov_b32 m0, %0":"=&s"(keep):"v"(gsrc),"s"(lds_dst):"memory");}
__device__ __forceinline__ float max3f(float a,float b,float c){float r;asm("v_max3_f32 %0, %1, %2, %3":"=v"(r):"v"(a),"v"(b),"v"(c));return r;}
__device__ __forceinline__ float max2f(float a,float b){float r;asm("v_max_f32_e32 %0, %1, %2":"=v"(r):"v"(a),"v"(b));return r;}
__device__ __forceinline__ float fadd_s(float a,float b){float r;asm("v_add_f32_e32 %0, %1, %2":"=v"(r):"v"(a),"v"(b));return r;}
__device__ __forceinline__ float fsub_s(float a,float b){float r;asm("v_sub_f32_e32 %0, %1, %2":"=v"(r):"v"(a),"v"(b));return r;}
typedef float f32x2_t __attribute__((ext_vector_type(2))); typedef __bf16 bf16x2_t __attribute__((ext_vector_type(2)));
__device__ __forceinline__ unsigned cvtpk_s(float lo,float hi){f32x2_t v={lo,hi};bf16x2_t b=__builtin_convertvector(v,bf16x2_t);return __builtin_bit_cast(unsigned,b);}
#define WAIT_BAR(N) asm volatile("s_waitcnt vmcnt(" #N ") lgkmcnt(0)\n\ts_barrier":::"memory")

__device__ __forceinline__ void qkt(f32x16&p0,f32x16&p1,const char*Kslot,const bf16x8*qr,const f32x16&negm,int r32,int hi){
  const char*kb=Kslot+hi*1024+r32*16;
  #pragma unroll
  for(int d0=0;d0<4;++d0){
    const bf16x8 b0=*reinterpret_cast<const bf16x8*>(kb+d0*2048);
    const bf16x8 b1=*reinterpret_cast<const bf16x8*>(kb+d0*2048+512);
    if(d0==0){p0=__builtin_amdgcn_mfma_f32_32x32x16_bf16(b0,qr[0],negm,0,0,0);p1=__builtin_amdgcn_mfma_f32_32x32x16_bf16(b1,qr[0],negm,0,0,0);}
    else{p0=__builtin_amdgcn_mfma_f32_32x32x16_bf16(b0,qr[d0],p0,0,0,0);p1=__builtin_amdgcn_mfma_f32_32x32x16_bf16(b1,qr[d0],p1,0,0,0);}}
}
typedef __attribute__((address_space(3))) const char* lds_cptr;
typedef short v4i16_t __attribute__((ext_vector_type(4)));
__device__ __forceinline__ void kload8(bf16x8*kf,lds_cptr kp){
  kf[0]=*(const __attribute__((address_space(3))) bf16x8*)(kp);      kf[1]=*(const __attribute__((address_space(3))) bf16x8*)(kp+512);
  kf[2]=*(const __attribute__((address_space(3))) bf16x8*)(kp+2048); kf[3]=*(const __attribute__((address_space(3))) bf16x8*)(kp+2560);
  kf[4]=*(const __attribute__((address_space(3))) bf16x8*)(kp+4096); kf[5]=*(const __attribute__((address_space(3))) bf16x8*)(kp+4608);
  kf[6]=*(const __attribute__((address_space(3))) bf16x8*)(kp+6144); kf[7]=*(const __attribute__((address_space(3))) bf16x8*)(kp+6656);
}
__device__ __forceinline__ void kload2(bf16x8*kf,lds_cptr kp,int j){ kf[2*j]=*(const __attribute__((address_space(3))) bf16x8*)(kp+j*2048); kf[2*j+1]=*(const __attribute__((address_space(3))) bf16x8*)(kp+j*2048+512); }
__device__ __forceinline__ s16x4 vtr(lds_cptr p){ return __builtin_bit_cast(s16x4,__builtin_amdgcn_ds_read_tr16_b64_v4i16((__attribute__((address_space(3))) v4i16_t*)p)); }
__device__ __forceinline__ float rowmax(const f32x16&p0,const f32x16&p1){
  float a=max3f(p0[0],p0[1],p1[0]),b=max3f(p0[2],p0[3],p1[1]);a=max3f(a,p1[2],p1[3]);
  #pragma unroll
  for(int r=4;r<16;r+=4){a=max3f(a,p0[r],p0[r+1]);b=max3f(b,p0[r+2],p0[r+3]);a=max3f(a,p1[r],p1[r+1]);b=max3f(b,p1[r+2],p1[r+3]);}
  const float m=max2f(a,b);
  auto rr=__builtin_amdgcn_permlane32_swap(__float_as_uint(m),__float_as_uint(m),false,false);
  return max2f(__uint_as_float(rr[0]),__uint_as_float(rr[1]));
}
__device__ __forceinline__ void pv(f32x16*o,int vb,bf16x8 pa0,bf16x8 pa1,bf16x8 pa2,bf16x8 pa3){
  #pragma unroll
  for(int d0=0;d0<2;++d0){s16x4 lo[4],hi[4];
    #pragma unroll
    for(int ks=0;ks<4;++ks){
      asm volatile("ds_read_b64_tr_b16 %0,%1 offset:%c2":"=&v"(lo[ks]):"v"(vb),"i"(d0*4096+ks*1024):"memory");
      asm volatile("ds_read_b64_tr_b16 %0,%1 offset:%c2":"=&v"(hi[ks]):"v"(vb),"i"(d0*4096+ks*1024+512):"memory");}
    asm volatile("s_waitcnt lgkmcnt(0)":::"memory");SBAR();
    #define PK(k) (bf16x8){lo[k][0],lo[k][1],lo[k][2],lo[k][3],hi[k][0],hi[k][1],hi[k][2],hi[k][3]}
    o[d0]=__builtin_amdgcn_mfma_f32_32x32x16_bf16(pa0,PK(0),o[d0],0,0,0);
    o[d0]=__builtin_amdgcn_mfma_f32_32x32x16_bf16(pa1,PK(1),o[d0],0,0,0);
    o[d0]=__builtin_amdgcn_mfma_f32_32x32x16_bf16(pa2,PK(2),o[d0],0,0,0);
    o[d0]=__builtin_amdgcn_mfma_f32_32x32x16_bf16(pa3,PK(3),o[d0],0,0,0);
    #undef PK
  }
}

#ifndef ATTN_STORE16
#define ATTN_STORE16(p,v) (*(u32x4*)(p)=(v))
#endif
template<int THRL> __device__ __forceinline__ void attn_unit(int b,int qb,const bf16*Q,const bf16*__restrict__ K,const bf16*__restrict__ V,bf16*O,const __attribute__((address_space(3))) float*tab,char*shm){
  int tid_=threadIdx.x; asm volatile("":"+v"(tid_)); const int tid=tid_,lane=tid&63,r32=lane&31,hi=lane>>5; const int wid=__builtin_amdgcn_readfirstlane(tid>>6);
  const long rowbase=(long)b*SEQ; const int q0=qb*QB;
  const bf16*Qw=Q+(rowbase+q0+wid*QBLK)*PQ;
  const bf16*Kh=K+rowbase*PQ,*Vh=V+rowbase*PQ;
  const unsigned lds0=(unsigned)(uintptr_t)shm;
  float*wsf=(float*)(shm+LDS_WS)+wid*64;
  const bf16*ksrc=Kh+(long)lane*PQ+wid*8;
  const bf16*vsrc=Vh+(long)(16*(wid&3)+(lane>>2))*PQ+(wid>>2)*32+(lane&3)*8;
  const unsigned kdst=lds0+LDS_K+wid*1024, vdst=lds0+LDS_V+wid*1024;
  #define DMA_K(t,slot) glds16(ksrc+(long)(t)*KVBLK*PQ,(unsigned)__builtin_amdgcn_readfirstlane(kdst+(slot)))
  #define DMA_V(t,slot) glds16(vsrc+(long)(t)*KVBLK*PQ,(unsigned)__builtin_amdgcn_readfirstlane(vdst+(slot)))
  const int vb0=(int)(lds0+LDS_V)+((lane>>4)&1)*32+(lane&3)*8+(4*hi+((lane&15)>>2))*64;
  const char*Kbase=shm+LDS_K; bf16x8 kf[8];
  const lds_cptr shm3=(lds_cptr)shm; const lds_cptr kp0=shm3+LDS_K+hi*1024+r32*16; const lds_cptr vp0=shm3+LDS_V+((lane>>4)&1)*32+(lane&3)*8+(4*hi+((lane&15)>>2))*64;
  const int NT=(q0+QB)/KVBLK;
  DMA_K(0,0);DMA_V(0,0);DMA_K(1,SLOTB);
  bf16x8 qr[4];
  #pragma unroll
  for(int d0=0;d0<4;++d0)qr[d0]=*reinterpret_cast<const bf16x8*>(&Qw[(long)r32*PQ+d0*16+hi*8]);
  float mhat=0.f,l_reg=0.f;f32x16 o[2];o[0]=f32x16{};o[1]=f32x16{};f32x16 negm=f32x16{};asm volatile("":"+v"(negm));
  const int qrel=wid*QBLK+r32;
  #define CMASK(P0,P1,t) do{int jb_=(t)-(NT-4); if(jb_>=-2)cmask(P0,P1,jb_,qrel,hi,tab);}while(0)
  bool resc=false;
  #define START(P0,P1) do{ const float rm=rowmax(P0,P1); resc=false; \
    { const float dl=rm; mhat=fadd_s(mhat,dl); \
      _Pragma("unroll") for(int r=0;r<16;++r){P0[r]=fsub_s(P0[r],dl);P1[r]=fsub_s(P1[r],dl);} \
      _Pragma("unroll") for(int r=0;r<16;++r)negm[r]=-mhat; asm volatile("":"+v"(negm)); } \
    _Pragma("unroll") for(int r=0;r<16;++r)P0[r]=__builtin_amdgcn_exp2f(P0[r]); }while(0)
  #define RESC() do{ if(resc){ asm volatile("s_waitcnt lgkmcnt(0)":::"memory"); \
      _Pragma("unroll") for(int d_=0;d_<2;++d_) _Pragma("unroll") for(int r=0;r<16;++r)o[d_][r]*=wsf[crow(r,hi)]; } }while(0)
  f32x16 pA0,pA1,pB0,pB1;
  int sl_prev=0,sl_cur=0,sl_next=SLOTB;
  #define ROT() do{sl_prev=sl_cur;sl_cur=sl_next;sl_next=(sl_next==(NSLOT-1)*SLOTB)?0:sl_next+SLOTB;}while(0)
  DMA_K(2,2*SLOTB);
  WAIT_BAR(3);
  qkt(pA0,pA1,Kbase,qr,negm,r32,hi);asm volatile("s_nop 15\n\ts_nop 7":"+v"(pA0),"+v"(pA1));CMASK(pA0,pA1,0);
  START(pA0,pA1);
  _Pragma("unroll") for(int r=0;r<16;++r)pA1[r]=__builtin_amdgcn_exp2f(pA1[r]);
  WAIT_BAR(0);
  DMA_K(3,0);DMA_V(1,SLOTB);
  ROT();
  kload8(kf,kp0+sl_cur);
  WAIT_BAR(2);
  s16x4 vlo[8],vhi[8]; u32x4 pw0,pw1,pw2,pw3;
  #define PKW(P,B) cvtpk_s(P[B],P[B+1])
  #define PAF(k) __builtin_bit_cast(bf16x8,pw##k)
  #define VFR(i) (bf16x8){vlo[i][0],vlo[i][1],vlo[i][2],vlo[i][3],vhi[i][0],vhi[i][1],vhi[i][2],vhi[i][3]}
  #define PIN(x) asm volatile("":"+v"(x))
  #define MX3(a,b,c) __builtin_fmaxf(__builtin_fmaxf((a),(b)),(c))
  #define GAPA(MF,A0,A1,A2,A3,W0,W1,PW) do{ MF; sacc+=A0; sacc+=A1; sacc+=A2; sacc+=A3; PIN(sacc); W0; W1; PIN(PW); SBAR(); }while(0)
  #define EX(v) __builtin_amdgcn_exp2f(v)
  #define GAPB(MF,X,B) do{ MF; X[B]=EX(X[B]); X[B+1]=EX(X[B+1]); X[B+2]=EX(X[B+2]); X[B+3]=EX(X[B+3]); PIN(X); SBAR(); }while(0)
  #define VRD(i) do{ vlo[i]=vtr(vp_+(((i)>>2)*4096+((i)&3)*1024)); vhi[i]=vtr(vp_+(((i)>>2)*4096+((i)&3)*1024+512)); }while(0)
  #define KRD(G,j) do{ if(G){ kload2(kf,kp0+sl_next,j); SBAR(); } }while(0)
  #define STEP(C0,C1,P0,P1,t,GK,GV,GL) do{ SBAR(); \
    const lds_cptr vp_=vp0+sl_prev; \
    VRD(0); SBAR(); float sacc=(P0[0]+P0[1]); \
    GAPA(C0=__builtin_amdgcn_mfma_f32_32x32x16_bf16(kf[0],qr[0],negm,0,0,0), P0[2],P0[3],P0[4],P0[5],     pw0[0]=PKW(P0,0), pw0[1]=PKW(P0,2), pw0); \
    VRD(4); SBAR(); GAPA(C1=__builtin_amdgcn_mfma_f32_32x32x16_bf16(kf[1],qr[0],negm,0,0,0), P0[6],P0[7],P0[8],P0[9],     pw0[2]=PKW(P0,4), pw0[3]=PKW(P0,6), pw0); \
    VRD(1); SBAR(); GAPA(C0=__builtin_amdgcn_mfma_f32_32x32x16_bf16(kf[2],qr[1],C0,0,0,0),   P0[10],P0[11],P0[12],P0[13], pw1[0]=PKW(P0,8), pw1[1]=PKW(P0,10), pw1); \
    VRD(5); SBAR(); GAPA(C1=__builtin_amdgcn_mfma_f32_32x32x16_bf16(kf[3],qr[1],C1,0,0,0),   P0[14],P0[15],P1[0],P1[1],   pw1[2]=PKW(P0,12),pw1[3]=PKW(P0,14), pw1); \
    VRD(2); SBAR(); GAPA(C0=__builtin_amdgcn_mfma_f32_32x32x16_bf16(kf[4],qr[2],C0,0,0,0),   P1[2],P1[3],P1[4],P1[5],     pw2[0]=PKW(P1,0), pw2[1]=PKW(P1,2), pw2); \
    VRD(6); SBAR(); GAPA(C1=__builtin_amdgcn_mfma_f32_32x32x16_bf16(kf[5],qr[2],C1,0,0,0),   P1[6],P1[7],P1[8],P1[9],     pw2[2]=PKW(P1,4), pw2[3]=PKW(P1,6), pw2); \
    VRD(3); SBAR(); GAPA(C0=__builtin_amdgcn_mfma_f32_32x32x16_bf16(kf[6],qr[3],C0,0,0,0),   P1[10],P1[11],P1[12],P1[13], pw3[0]=PKW(P1,8), pw3[1]=PKW(P1,10), pw3); \
    VRD(7); SBAR(); GAPA(C1=__builtin_amdgcn_mfma_f32_32x32x16_bf16(kf[7],qr[3],C1,0,0,0),   P1[14],P1[15],0.f,0.f,       pw3[2]=PKW(P1,12),pw3[3]=PKW(P1,14), pw3); \
    l_reg+=sacc; \
    if(GK){DMA_K((t)+3,sl_cur);} if(GV){DMA_V((t)+1,sl_next);} \
    CMASK(C0,C1,t); \
    { float a=MX3(C0[0],C0[1],C1[0]),b=MX3(C0[2],C0[3],C1[1]); a=MX3(a,C1[2],C1[3]); \
      _Pragma("unroll") for(int r=4;r<16;r+=4){a=MX3(a,C0[r],C0[r+1]);b=MX3(b,C0[r+2],C0[r+3]);a=MX3(a,C1[r],C1[r+1]);b=MX3(b,C1[r+2],C1[r+3]);} \
      float rm=__builtin_fmaxf(a,b); { auto rr=__builtin_amdgcn_permlane32_swap(__float_as_uint(rm),__float_as_uint(rm),false,false); rm=__builtin_fmaxf(__uint_as_float(rr[0]),__uint_as_float(rr[1])); } \
      resc=false; \
      if(__builtin_expect(__any(rm>(float)THRL),0)){ const float dl=__builtin_fmaxf(rm,0.f); mhat+=dl; \
        _Pragma("unroll") for(int r=0;r<16;++r){C0[r]-=dl;C1[r]-=dl;} \
        _Pragma("unroll") for(int r=0;r<16;++r)negm[r]=-mhat; asm volatile("":"+v"(negm)); \
        const float f=__builtin_amdgcn_exp2f(-dl); l_reg*=f; if(hi==0)wsf[r32]=f; resc=true; } } \
    SBAR(); \
    GAPB(o[0]=__builtin_amdgcn_mfma_f32_32x32x16_bf16(PAF(0),VFR(0),o[0],0,0,0), C0,0); \
    GAPB(o[1]=__builtin_amdgcn_mfma_f32_32x32x16_bf16(PAF(0),VFR(4),o[1],0,0,0), C0,4); \
    KRD(GL,0); GAPB(o[0]=__builtin_amdgcn_mfma_f32_32x32x16_bf16(PAF(1),VFR(1),o[0],0,0,0), C0,8); \
    KRD(GL,1); GAPB(o[1]=__builtin_amdgcn_mfma_f32_32x32x16_bf16(PAF(1),VFR(5),o[1],0,0,0), C0,12); \
    KRD(GL,2); GAPB(o[0]=__builtin_amdgcn_mfma_f32_32x32x16_bf16(PAF(2),VFR(2),o[0],0,0,0), C1,0); \
    KRD(GL,3); GAPB(o[1]=__builtin_amdgcn_mfma_f32_32x32x16_bf16(PAF(2),VFR(6),o[1],0,0,0), C1,4); \
    GAPB(o[0]=__builtin_amdgcn_mfma_f32_32x32x16_bf16(PAF(3),VFR(3),o[0],0,0,0), C1,8); \
    GAPB(o[1]=__builtin_amdgcn_mfma_f32_32x32x16_bf16(PAF(3),VFR(7),o[1],0,0,0), C1,12); \
    }while(0)
  int t=1;
  #undef CMASK
  #define CMASK(P0,P1,t) do{}while(0)
  for(;t+7<NT;t+=2){
    STEP(pB0,pB1,pA0,pA1,t,true,true,true);     WAIT_BAR(2); RESC(); ROT();
    STEP(pA0,pA1,pB0,pB1,t+1,true,true,true);   WAIT_BAR(2); RESC(); ROT();
  }
  #undef CMASK
  #define CMASK(P0,P1,t) do{int jb_=(t)-(NT-4); if(jb_>=-2)cmask(P0,P1,jb_,qrel,hi,tab);}while(0)
  #define ENDW(tt) do{ if((tt)+3<NT){WAIT_BAR(2);} else if((tt)+2<NT){WAIT_BAR(1);} else {WAIT_BAR(0);} }while(0)
  for(;t+1<NT;t+=2){
    STEP(pB0,pB1,pA0,pA1,t,(t+3<NT),(t+1<NT),(t+1<NT));       ENDW(t);   RESC(); ROT();
    STEP(pA0,pA1,pB0,pB1,t+1,(t+4<NT),(t+2<NT),(t+2<NT));     ENDW(t+1); RESC(); ROT();
  }
  STEP(pB0,pB1,pA0,pA1,NT-1,false,false,false); RESC();
  { float sacc=pB0[0]+pB0[1]; _Pragma("unroll") for(int r=2;r<16;++r)sacc+=pB0[r]; _Pragma("unroll") for(int r=0;r<16;++r)sacc+=pB1[r]; l_reg+=sacc;
    pw0=(u32x4){PKW(pB0,0),PKW(pB0,2),PKW(pB0,4),PKW(pB0,6)};pw1=(u32x4){PKW(pB0,8),PKW(pB0,10),PKW(pB0,12),PKW(pB0,14)};pw2=(u32x4){PKW(pB1,0),PKW(pB1,2),PKW(pB1,4),PKW(pB1,6)};pw3=(u32x4){PKW(pB1,8),PKW(pB1,10),PKW(pB1,12),PKW(pB1,14)};
    SBAR(); pv(o,vb0+sl_cur,PAF(0),PAF(1),PAF(2),PAF(3)); }
  #undef PKW
  #undef PAF
  #undef VFR
  #undef PIN
  #undef MX3
  #undef GAPA
  #undef GAPB
  #undef EX
  #undef VRD
  #undef KRD
  #undef STEP
  #undef ENDW
  {auto rr=__builtin_amdgcn_permlane32_swap(__float_as_uint(l_reg),__float_as_uint(l_reg),false,false);l_reg=__uint_as_float(rr[0])+__uint_as_float(rr[1]);}
  if(hi==0)wsf[32+r32]=l_reg;asm volatile("s_waitcnt lgkmcnt(0)":::"memory");
  float rli[16];
  #pragma unroll
  for(int r=0;r<16;++r)rli[r]=__builtin_amdgcn_rcpf(wsf[32+crow(r,hi)]);
  bf16*Ow=O+(rowbase+q0+wid*QBLK)*PO;
  { bf16*stg=(bf16*)(shm+LDS_OST)+wid*2048;
    #pragma unroll
    for(int r=0;r<16;++r){const int orow=crow(r,hi);
      #pragma unroll
      for(int d0=0;d0<2;++d0)stg[orow*64+d0*32+r32]=__float2bfloat16(o[d0][r]*rli[r]);}
    asm volatile("s_waitcnt lgkmcnt(0)":::"memory");
    #pragma unroll
    for(int i=0;i<4;++i){const int row=i*8+(lane>>3),ch=lane&7; const u32x4 v=*(const u32x4*)(stg+row*64+ch*8); ATTN_STORE16(Ow+(long)row*PO+ch*8,v);} }
  asm volatile("s_waitcnt lgkmcnt(0)\n\ts_barrier":::"memory");
  #undef DMA_K
  #undef DMA_V
  #undef CMASK
  #undef START
  #undef RESC
  #undef ROT
}
constexpr int ATTN_LDS_BYTES=LDS_BYTES;
#undef SBAR
#undef WAIT_BAR
}
namespace xat {
#define XLAS __attribute__((address_space(3)))
typedef unsigned short bf16_t;
typedef short bf16x8 __attribute__((ext_vector_type(8)));
typedef float f32x16 __attribute__((ext_vector_type(16)));
typedef unsigned u32x4 __attribute__((ext_vector_type(4)));
typedef unsigned u32x2 __attribute__((ext_vector_type(2)));
typedef float f32x2_t __attribute__((ext_vector_type(2))); typedef __bf16 bf16x2_t __attribute__((ext_vector_type(2)));
__device__ __forceinline__ unsigned cvtpk(float lo, float hi) { f32x2_t v = {lo, hi}; bf16x2_t b = __builtin_convertvector(v, bf16x2_t); return __builtin_bit_cast(unsigned, b); }
constexpr int KP = 528, CHB = 32 * KP, XS_OFF = 34816, XS_BYTES = 8704, LDS_BYTES = XS_OFF + 8 * XS_BYTES;
__device__ __forceinline__ void unit(XLAS unsigned char* lds, const bf16_t* Qg, const bf16_t* Kg, const bf16_t* Vg, bf16_t* Og) {
    int tid_ = threadIdx.x; asm volatile("" : "+v"(tid_)); const int tid = tid_, lane = tid & 63, r32 = lane & 31, hi = lane >> 5; const int wid = __builtin_amdgcn_readfirstlane(tid >> 6);
    const int sr = tid >> 4, sseg = tid & 15;
    const bf16_t* kgp = Kg + (size_t)sr * 4096 + sseg * 16;
    const bf16_t* vgp = Vg + (size_t)sr * 4096 + sseg * 16;
    const unsigned wofs = (unsigned)(sr * KP + sseg * 32);
#define XAT_SRC(c) ((c) < 8 ? kgp + (size_t)(c) * 32 * 4096 : vgp + (size_t)((c) - 8) * 32 * 4096)
    u32x4 g[2][2];
    g[0][0] = *(const u32x4*)(XAT_SRC(0)); g[0][1] = *(const u32x4*)(XAT_SRC(0) + 8); g[1][0] = *(const u32x4*)(XAT_SRC(1)); g[1][1] = *(const u32x4*)(XAT_SRC(1) + 8);
    XLAS unsigned char* xs = lds + XS_OFF + wid * XS_BYTES;
    bf16x8 qf[16];
#pragma unroll
    for (int hq = 0; hq < 2; ++hq) {
        const bf16_t* qbase = Qg + (size_t)(wid * 32 + (lane >> 4)) * 1024 + hq * 128 + (lane & 15) * 8;
        u32x4 qv[8];
#pragma unroll
        for (int i = 0; i < 8; ++i) qv[i] = *(const u32x4*)(qbase + (size_t)(4 * i) * 1024);
#pragma unroll
        for (int i = 0; i < 8; ++i) *(XLAS u32x4*)(xs + (4 * i + (lane >> 4)) * 272 + (lane & 15) * 16) = qv[i];
#pragma unroll
        for (int s = 0; s < 8; ++s) qf[hq * 8 + s] = *(const XLAS bf16x8*)(xs + r32 * 272 + s * 32 + hi * 16);
    }
    const int krow = (r32 & 0x13) | ((r32 & 4) << 1) | ((r32 & 8) >> 1);
    const unsigned kro = (unsigned)(krow * KP + hi * 16), vro = (unsigned)(r32 * KP + hi * 16);
    f32x16 S[8];
#pragma unroll
    for (int c = 0; c < 8; ++c) {
        XLAS unsigned char* buf = lds + (c & 1) * CHB;
        *(XLAS u32x4*)(buf + wofs) = g[c & 1][0]; *(XLAS u32x4*)(buf + wofs + 16) = g[c & 1][1];
        __syncthreads();
        { g[c & 1][0] = *(const u32x4*)(XAT_SRC(c + 2)); g[c & 1][1] = *(const u32x4*)(XAT_SRC(c + 2) + 8); }
        f32x16 a = {};
        bf16x8 kfa[4], kfb[4];
#pragma unroll
        for (int j = 0; j < 4; ++j) kfa[j] = *(const XLAS bf16x8*)(buf + kro + j * 32);
#pragma unroll
        for (int gq = 0; gq < 4; gq += 2) {
#pragma unroll
            for (int j = 0; j < 4; ++j) kfb[j] = *(const XLAS bf16x8*)(buf + kro + (4 * gq + 4 + j) * 32);
            __builtin_amdgcn_sched_barrier(0);
#pragma unroll
            for (int j = 0; j < 4; ++j) a = __builtin_amdgcn_mfma_f32_32x32x16_bf16(kfa[j], qf[4 * gq + j], a, 0, 0, 0);
            if (gq < 2) {
#pragma unroll
                for (int j = 0; j < 4; ++j) kfa[j] = *(const XLAS bf16x8*)(buf + kro + (4 * gq + 8 + j) * 32); }
            __builtin_amdgcn_sched_barrier(0);
#pragma unroll
            for (int j = 0; j < 4; ++j) a = __builtin_amdgcn_mfma_f32_32x32x16_bf16(kfb[j], qf[4 * gq + 4 + j], a, 0, 0, 0);
        }
        S[c] = a;
    }
    float mx = S[0][0];
#pragma unroll
    for (int c = 0; c < 8; ++c)
#pragma unroll
        for (int r = 0; r < 16; ++r) mx = __builtin_fmaxf(mx, S[c][r]);
    mx = __builtin_fmaxf(mx, __shfl_xor(mx, 32));
    float l = 0.f;
    u32x4 pw[8][2];
#pragma unroll
    for (int c = 0; c < 8; ++c) {
        f32x16 p;
#pragma unroll
        for (int r = 0; r < 16; ++r) { p[r] = __builtin_amdgcn_exp2f(S[c][r] - mx); l += p[r]; }
#pragma unroll
        for (int s = 0; s < 2; ++s) { pw[c][s].x = cvtpk(p[8 * s + 0], p[8 * s + 1]); pw[c][s].y = cvtpk(p[8 * s + 2], p[8 * s + 3]); pw[c][s].z = cvtpk(p[8 * s + 4], p[8 * s + 5]); pw[c][s].w = cvtpk(p[8 * s + 6], p[8 * s + 7]); }
    }
    l += __shfl_xor(l, 32);
    const float rl = 1.0f / l;
    bf16_t* obase = Og + (size_t)(wid * 32 + (lane >> 3)) * 1024 + (lane & 7) * 8;
#pragma unroll
    for (int db = 0; db < 8; ++db) {
        XLAS unsigned char* buf = lds + (db & 1) * CHB;
        *(XLAS u32x4*)(buf + wofs) = g[db & 1][0]; *(XLAS u32x4*)(buf + wofs + 16) = g[db & 1][1];
        __syncthreads();
        if (db < 6) { g[db & 1][0] = *(const u32x4*)(XAT_SRC(db + 10)); g[db & 1][1] = *(const u32x4*)(XAT_SRC(db + 10) + 8); }
        f32x16 o = {};
#pragma unroll
        for (int kb = 0; kb < 8; ++kb)
#pragma unroll
            for (int s = 0; s < 2; ++s) { const bf16x8 vf = *(const XLAS bf16x8*)(buf + vro + kb * 64 + s * 32); o = __builtin_amdgcn_mfma_f32_32x32x16_bf16(vf, __builtin_bit_cast(bf16x8, pw[kb][s]), o, 0, 0, 0); }
#pragma unroll
        for (int g4 = 0; g4 < 4; ++g4) { u32x2 w; w.x = cvtpk(o[4 * g4] * rl, o[4 * g4 + 1] * rl); w.y = cvtpk(o[4 * g4 + 2] * rl, o[4 * g4 + 3] * rl);
            *(XLAS u32x2*)(xs + r32 * 144 + ((db & 1) * 32 + 8 * g4 + 4 * hi) * 2) = w; }
        if (db & 1) {
#pragma unroll
            for (int i = 0; i < 4; ++i) { const u32x4 v = *(const XLAS u32x4*)(xs + (8 * i + (lane >> 3)) * 144 + (lane & 7) * 16); *(u32x4*)(obase + (size_t)(8 * i) * 1024 + (db >> 1) * 64) = v; }
        }
    }
}
#undef XAT_SRC
}
#define GAS __attribute__((address_space(1)))
#define LAS __attribute__((address_space(3)))
typedef unsigned short bf16;
typedef unsigned v4u __attribute__((ext_vector_type(4)));
typedef unsigned v2u __attribute__((ext_vector_type(2)));
typedef float f32x4 __attribute__((ext_vector_type(4)));
constexpr int NWAVES = 8;
constexpr int M = 65536, SEQ = 4096, DM = 1024, NMEM = 256, DEPTH = 4;
constexpr float LOG2E = 1.4426950408889634f;
constexpr float C2A = 0.125f * LOG2E;
constexpr float C2X = 0.0625f * LOG2E;
constexpr float LAMBDA_INIT0 = 0.2f, LAMBDA_INIT2 = 0.47071301834f;
constexpr float EPS = 1e-6f;
constexpr size_t MiB = 1u << 20;
constexpr size_t WS_SMALL = 1 * MiB;
constexpr size_t WS_WIN = 2 * MiB, WS_WOUT = 10 * MiB, WS_CIN = 14 * MiB, WS_COUT = 26 * MiB, WS_WQ = 30 * MiB, WS_WK = 38 * MiB, WS_WV = 46 * MiB, WS_WO = 54 * MiB, WS_W1 = 62 * MiB, WS_W2 = 94 * MiB;
constexpr size_t WS_MEMN = 126 * MiB, WS_KB = 134 * MiB, WS_VT = 166 * MiB, WS_SSQ = 198 * MiB, WS_HB = 202 * MiB, WS_MIX = 330 * MiB, WS_BIG = 458 * MiB, WS_ORAW = WS_BIG + 384 * MiB, WS_END = 970 * MiB;
constexpr int TABN = 704;
constexpr int LDS_BYTES = 147456, TAB_OFF = attn_body::LDS_TAB;
static_assert(attn_body::ATTN_LDS_BYTES <= 131072 && TABN * 4 <= 3072 && xat::LDS_BYTES <= 131072, "LDS map");

__device__ __forceinline__ float bf_lo(unsigned w) { return __uint_as_float(w << 16); }
__device__ __forceinline__ float bf_hi(unsigned w) { return __uint_as_float(w & 0xffff0000u); }
__device__ __forceinline__ unsigned pk2(float lo, float hi) { return pg8::cvt_pk_bf16(lo, hi); }
__device__ __forceinline__ float wave_sum(float v) {
#pragma unroll
    for (int o = 1; o < 64; o <<= 1) v += __shfl_xor(v, o);
    return v;
}
__device__ __forceinline__ void transpose_item(const float* W, int ldn, int Nc, bf16* WT, int ldk, int row_off, const float* rs, int ncs, float cs, LAS float* scr, int item, int lane) {
    const int nblk = Nc / 32, kb = item / nblk, nb = item % nblk, k0 = 64 * kb, n0 = 32 * nb;
    const float csl = (n0 + (lane & 31) < ncs) ? cs : 1.f;
#pragma unroll 8
    for (int i = 0; i < 32; ++i) { const int kk = 2 * i + (lane >> 5); float v = W[(size_t)(k0 + kk) * ldn + n0 + (lane & 31)] * csl; if (rs) v *= rs[k0 + kk]; scr[kk * 33 + (lane & 31)] = v; }
    asm volatile("s_waitcnt lgkmcnt(0)" ::: "memory");
    const int c = lane & 7;
#pragma unroll
    for (int j = 0; j < 4; ++j) { const int n = (lane >> 3) + 8 * j; const LAS float* s = scr + (8 * c) * 33 + n;
        v4u o; o.x = pk2(s[0 * 33], s[1 * 33]); o.y = pk2(s[2 * 33], s[3 * 33]); o.z = pk2(s[4 * 33], s[5 * 33]); o.w = pk2(s[6 * 33], s[7 * 33]);
        *(v4u*)(WT + (size_t)(row_off + n0 + n) * ldk + k0 + 8 * c) = o; }
    asm volatile("s_waitcnt lgkmcnt(0)" ::: "memory");
}
struct Args { const float* in[25]; float* out; unsigned char* ws; int lo, hi; };
enum { I_X = 0, I_MEM, I_RELB, I_MEMG, I_NMIXG, I_NXG, I_NMLPG, I_FING, I_ABWIN, I_ABWOUT, I_LQ1, I_LK1, I_LQ2, I_LK2, I_SUBLN, I_POOLW, I_POOLS, I_CWIN, I_CW, I_CWOUT, I_WQ, I_WKV, I_WO, I_W1, I_W2 };
enum { K_PRO = 0, K_MIXPROJ, K_ATTN, K_COMBINE, K_CONV, K_MIXOUT, K_XQ, K_XATTN, K_XO, K_UP, K_DOWN, K_FINAL };
constexpr int NPHASE = 30;
__host__ __device__ inline void decode_phase(int ph, int& kind, int& l) {
    if (ph == 0) { kind = K_PRO; l = 0; return; }
    if (ph == NPHASE - 1) { kind = K_FINAL; l = 0; return; }
    const int p0 = ph - 1; l = p0 / 7; const int p = p0 - 7 * l;
    kind = p == 0 ? K_MIXPROJ : p == 1 ? ((l & 1) == 0 ? K_ATTN : K_CONV) : p == 2 ? K_MIXOUT : p == 3 ? K_XQ : p == 4 ? K_XO : p == 5 ? K_UP : K_DOWN;
}

#define XB_TMO      128
#define XB_XCNT(j)  (256  + 64 * (j))
#define XB_XSUB(j)  (1280 + 64 * (j))
#define XB_XGEN(j)  (2304 + 64 * (j))
#define XB_TOP      3328
#define XB_TOPGEN   3392
#define XCD_BAR_WORDS 3456
#define XB_SPIN_CAP (1u << 22)

__device__ __forceinline__ unsigned xb_ld(unsigned* p)              { return __hip_atomic_load(p, __ATOMIC_RELAXED, __HIP_MEMORY_SCOPE_AGENT); }
__device__ __forceinline__ unsigned xb_add(unsigned* p, unsigned v) { return __hip_atomic_fetch_add(p, v, __ATOMIC_RELAXED, __HIP_MEMORY_SCOPE_AGENT); }
__device__ __forceinline__ unsigned xb_xcc_id() { return (unsigned)__builtin_amdgcn_s_getreg((3 << 11) | 20) & 0xFu; }
#define XB_SPIN(cond, bar) do { unsigned _sp = 0; while (cond) { __builtin_amdgcn_s_sleep(1); \
    if ((++_sp & 255u) == 0u) { if (xb_ld(&(bar)[XB_TMO])) break; if (_sp > XB_SPIN_CAP) { atomicAdd(&(bar)[XB_TMO], 1u); break; } } } } while (0)

struct XcdBarrier {
    unsigned* bar; unsigned x;
    volatile LAS unsigned* st;
};

__device__ __forceinline__ XcdBarrier xcd_barrier_post(unsigned* bar, volatile LAS unsigned* st) {
    XcdBarrier b; b.bar = bar; b.x = xb_xcc_id(); b.st = st;
    if (threadIdx.x == 0) (void)xb_add(&bar[XB_XCNT(b.x)], 1u);
    return b;
}
__device__ __forceinline__ void xcd_barrier_complete(unsigned* bar, unsigned x, unsigned& nloc, unsigned& nx) {
    const unsigned G = gridDim.x * gridDim.y * gridDim.z;
    unsigned sum, cnt, mine, sp = 0u;
    for (;;) {
        sum = 0u; cnt = 0u; mine = 0u;
#pragma unroll
        for (unsigned j = 0; j < 16; ++j) { const unsigned c = xb_ld(&bar[XB_XCNT(j)]); sum += c; cnt += (c > 0u) ? 1u : 0u; mine = (j == x) ? c : mine; }
        if (sum == G) break;
        __builtin_amdgcn_s_sleep(1);
        if ((++sp & 255u) == 0u) { if (xb_ld(&bar[XB_TMO])) break; if (sp > XB_SPIN_CAP) { atomicAdd(&bar[XB_TMO], 1u); break; } }
    }
    nloc = mine > 0u ? mine : 1u; nx = cnt > 0u ? cnt : 1u;
}

__device__ __forceinline__ void xcd_barrier(const XcdBarrier& b) {
    asm volatile("s_waitcnt vmcnt(0)" ::: "memory");
    __syncthreads();
    if (threadIdx.x == 0) {
        unsigned* bar = b.bar;
        __builtin_amdgcn_s_waitcnt(0);
        unsigned nloc = b.st[0], nx = b.st[1];
        if (nloc == 0u) { xcd_barrier_complete(bar, b.x, nloc, nx); b.st[0] = nloc; b.st[1] = nx; }
        const unsigned old = xb_add(&bar[XB_XSUB(b.x)], 1u);
        const unsigned gen = old / nloc;
        if (old + 1u == (gen + 1u) * nloc) {
            __builtin_amdgcn_fence(__ATOMIC_RELEASE, "agent");
            asm volatile("s_waitcnt vmcnt(0)" ::: "memory");
            const unsigned og = xb_add(&bar[XB_TOP], 1u);
            const unsigned tg = og / nx;
            if (og + 1u == (tg + 1u) * nx) xb_add(&bar[XB_TOPGEN], 1u);
            else XB_SPIN(xb_ld(&bar[XB_TOPGEN]) == tg, bar);
            __builtin_amdgcn_fence(__ATOMIC_ACQUIRE, "agent");
            xb_add(&bar[XB_XGEN(b.x)], 1u);
            asm volatile("s_waitcnt vmcnt(0)" ::: "memory");
        } else {
            XB_SPIN(xb_ld(&bar[XB_XGEN(b.x)]) == gen, bar);
            __builtin_amdgcn_fence(__ATOMIC_ACQUIRE, "agent");
            asm volatile("s_waitcnt vmcnt(0)" ::: "memory");
        }
    }
    __syncthreads();
}

constexpr int XB_ST_OFF = LDS_BYTES - 64;
__global__ void __launch_bounds__(NWAVES * 64, 2) trunk_fwd(Args args) {
    extern __shared__ __attribute__((aligned(16))) unsigned char lds[];
    cg::grid_group grid = cg::this_grid();
    LAS unsigned char* L = (LAS unsigned char*)lds;
    if (threadIdx.x == 0) { ((volatile LAS unsigned*)(L + XB_ST_OFF))[0] = 0u; ((volatile LAS unsigned*)(L + XB_ST_OFF))[1] = 0u; }
    __syncthreads();
    if (blockIdx.x == 0) for (int i = threadIdx.x; i < XCD_BAR_WORDS; i += NWAVES * 64) ((unsigned*)args.ws)[i] = 0u;
    const int ph_hi = args.hi; int ph0 = args.lo;
    if (ph0 == 0) {
        const int l = 0, li = 0; (void)l; (void)li;
        int tid_ = threadIdx.x, G_ = gridDim.x, bid_ = blockIdx.x; asm volatile("" : "+v"(tid_), "+s"(G_), "+s"(bid_));
        const int tid = tid_, lane = tid & 63, wid = __builtin_amdgcn_readfirstlane(tid >> 6), G = G_, bid = bid_, gw = bid * NWAVES + wid, NGW = G * NWAVES;
        const __attribute__((address_space(4))) Args* ap = (const __attribute__((address_space(4))) Args*)__builtin_amdgcn_kernarg_segment_ptr();
        asm volatile("" : "+s"(ap));
#define ARGIN(i) (ap->in[i])
        unsigned char* ws = ap->ws;
        float* out = ap->out;
        float* TAB = (float*)(ws + WS_SMALL); float* LAM = (float*)(ws + WS_SMALL + 16384);
        bf16* WIN = (bf16*)(ws + WS_WIN); bf16* WOUT = (bf16*)(ws + WS_WOUT); bf16* CIN = (bf16*)(ws + WS_CIN); bf16* COUT = (bf16*)(ws + WS_COUT);
        bf16* WQ = (bf16*)(ws + WS_WQ); bf16* WK = (bf16*)(ws + WS_WK); bf16* WV = (bf16*)(ws + WS_WV); bf16* WO = (bf16*)(ws + WS_WO); bf16* W1 = (bf16*)(ws + WS_W1); bf16* W2 = (bf16*)(ws + WS_W2);
        bf16* MEMN = (bf16*)(ws + WS_MEMN); bf16* KB = (bf16*)(ws + WS_KB); bf16* VT = (bf16*)(ws + WS_VT); float* SSQ = (float*)(ws + WS_SSQ);
        bf16* HB = (bf16*)(ws + WS_HB); bf16* MIX = (bf16*)(ws + WS_MIX); bf16* BIG = (bf16*)(ws + WS_BIG); bf16* ORAW = (bf16*)(ws + WS_ORAW);
#ifndef DIS_PRO
            LAS float* scr = (LAS float*)(L + wid * 16384);
            constexpr int NIT = 15616;
            struct TD { const float* W; const float* rs; bf16* WT; int ldn, Nc, ldk, ncs, item, remap; float cs; };
#define TDESC(R, D) do { int r = (R); D.rs = nullptr; D.ldk = 1024; D.ncs = 0; D.cs = 1.f; D.remap = 0; \
                if (r < 1024) { const int i = r >> 9; D.W = ARGIN(I_ABWIN) + (size_t)i * 1024 * 2048; D.ldn = 2048; D.Nc = 2048; D.WT = WIN + (size_t)i * 2048 * 1024; D.rs = ARGIN(I_NMIXG) + (2 * i) * 1024; D.ncs = 512; D.cs = C2A; D.item = r & 511; } \
                else if ((r -= 1024) < 256) { const int i = r >> 7; D.W = ARGIN(I_ABWOUT) + (size_t)i * 1024 * 1024; D.ldn = 1024; D.Nc = 1024; D.WT = WOUT + (size_t)i * 1024 * 1024; D.item = r & 127; } \
                else if ((r -= 256) < 1536) { const int i = r / 768; D.W = ARGIN(I_CWIN) + (size_t)i * 1024 * 3072; D.ldn = 3072; D.Nc = 3072; D.WT = CIN + (size_t)i * 3072 * 1024; D.rs = ARGIN(I_NMIXG) + (2 * i + 1) * 1024; D.item = r % 768; D.remap = 1; } \
                else if ((r -= 1536) < 512) { const int i = r >> 8; D.W = ARGIN(I_CWOUT) + (size_t)i * 1024 * 1024; D.ldn = 1024; D.Nc = 1024; D.WT = COUT + (size_t)i * 1024 * 1024; D.item = r & 255; } \
                else if ((r -= 512) < 1024) { const int i = r >> 8; D.W = ARGIN(I_WQ) + (size_t)i * 1024 * 1024; D.ldn = 1024; D.Nc = 1024; D.WT = WQ + (size_t)i * 1024 * 1024; D.rs = ARGIN(I_NXG) + i * 1024; D.ncs = 1024; D.cs = C2X; D.item = r & 255; } \
                else if ((r -= 1024) < 1024) { const int i = r >> 8; D.W = ARGIN(I_WKV) + (size_t)i * 1024 * 2048; D.ldn = 2048; D.Nc = 1024; D.WT = WK + (size_t)i * 1024 * 1024; D.item = r & 255; } \
                else if ((r -= 1024) < 1024) { const int i = r >> 8; D.W = ARGIN(I_WKV) + (size_t)i * 1024 * 2048 + 1024; D.ldn = 2048; D.Nc = 1024; D.WT = WV + (size_t)i * 1024 * 1024; D.item = r & 255; } \
                else if ((r -= 1024) < 1024) { const int i = r >> 8; D.W = ARGIN(I_WO) + (size_t)i * 1024 * 1024; D.ldn = 1024; D.Nc = 1024; D.WT = WO + (size_t)i * 1024 * 1024; D.item = r & 255; } \
                else if ((r -= 1024) < 4096) { const int i = r >> 10; D.W = ARGIN(I_W1) + (size_t)i * 1024 * 4096; D.ldn = 4096; D.Nc = 4096; D.WT = W1 + (size_t)i * 4096 * 1024; D.rs = ARGIN(I_NMLPG) + i * 1024; D.item = r & 1023; } \
                else { r -= 4096; const int i = r >> 10; D.W = ARGIN(I_W2) + (size_t)i * 4096 * 1024; D.ldn = 1024; D.Nc = 1024; D.WT = W2 + (size_t)i * 1024 * 4096; D.ldk = 4096; D.item = r & 1023; } } while (0)
#define TLOAD(D, V) do { const int nblk_ = D.Nc / 64, kb_ = D.item / nblk_, nb_ = D.item % nblk_; const float* wp_ = D.W + (size_t)(64 * kb_ + (lane >> 4)) * D.ldn + 64 * nb_ + (lane & 15) * 4; \
                _Pragma("unroll") for (int i = 0; i < 16; ++i) V[i] = *(const f32x4*)(wp_ + (size_t)(4 * i) * D.ldn); } while (0)
            { f32x4 tv[16]; TD d, dn; int it = gw; bool have = it < NIT;
              LAS float* scr2 = (LAS float*)(L + wid * 16640);
              if (have) { TDESC(it, d); TLOAD(d, tv); }
              while (have) {
                const int itn = it + NGW; const bool hn = itn < NIT;
                const int nblk = d.Nc / 64, kb = d.item / nblk, nb = d.item % nblk, k0 = 64 * kb, n0 = 64 * nb;
                const int n4 = (lane & 15) * 4, kq = lane >> 4;
                const int on0 = !d.remap || n0 < 1024 ? n0 : (n0 < 2048 ? 1024 + ((n0 - 1024) >> 7) * 256 + ((n0 - 1024) & 127) : 1024 + ((n0 - 2048) >> 7) * 256 + 128 + ((n0 - 2048) & 127));
                const float csl = (n0 + n4 < d.ncs) ? d.cs : 1.f;
#pragma unroll
                for (int i = 0; i < 16; ++i) { const int kk = 4 * i + kq; float sc = csl; if (d.rs) sc *= d.rs[k0 + kk];
                    scr2[(n4 + 0) * 65 + kk] = tv[i][0] * sc; scr2[(n4 + 1) * 65 + kk] = tv[i][1] * sc; scr2[(n4 + 2) * 65 + kk] = tv[i][2] * sc; scr2[(n4 + 3) * 65 + kk] = tv[i][3] * sc; }
                if (hn) { TDESC(itn, dn); TLOAD(dn, tv); }
                asm volatile("s_waitcnt lgkmcnt(0)" ::: "memory");
                const int c = lane & 7;
#pragma unroll
                for (int j = 0; j < 8; ++j) { const int n = (lane >> 3) + 8 * j; const LAS float* sp = scr2 + n * 65 + 8 * c;
                    v4u o; o.x = pk2(sp[0], sp[1]); o.y = pk2(sp[2], sp[3]); o.z = pk2(sp[4], sp[5]); o.w = pk2(sp[6], sp[7]);
                    *(v4u*)(d.WT + (size_t)(on0 + n) * d.ldk + k0 + 8 * c) = o; }
                asm volatile("s_waitcnt lgkmcnt(0)" ::: "memory");
                d = dn; it = itn; have = hn;
              } }
#undef TDESC
#undef TLOAD
            for (int t = gw; t < 2 * 4 * 16 * 16; t += NGW) {
                const int nb = t & 15, c8 = (t >> 4) & 15, g = (t >> 8) & 3, i = t >> 10, n = nb * 64 + lane;
                const float* pw = ARGIN(I_POOLW) + ((size_t)(i * 4 + g) * 128 + c8 * 8) * 128; const float* psc = ARGIN(I_POOLS) + i * 512 + g * 128;
                const float* wo = ARGIN(I_ABWOUT) + (size_t)i * 1024 * 1024 + (size_t)(512 + g * 128) * 1024 + n;
                float a[8];
#pragma unroll
                for (int e = 0; e < 8; ++e) a[e] = 0.f;
#pragma unroll 8
                for (int d = 0; d < 128; ++d) { const float w = wo[(size_t)d * 1024] * psc[d];
#pragma unroll
                    for (int e = 0; e < 8; ++e) a[e] += pw[e * 128 + d] * w; }
                v4u o; o.x = pk2(a[0], a[1]); o.y = pk2(a[2], a[3]); o.z = pk2(a[4], a[5]); o.w = pk2(a[6], a[7]);
                *(v4u*)(WOUT + (size_t)i * 1024 * 1024 + (size_t)n * 1024 + 512 + g * 128 + c8 * 8) = o;
            }
            for (int row = gw; row < 16 * NMEM; row += NGW) {
                const f32x4* xr = (const f32x4*)(ARGIN(I_MEM) + (size_t)row * DM) + lane; const f32x4* gr = (const f32x4*)(ARGIN(I_MEMG)) + lane;
                f32x4 v[4]; float s = 0.f;
#pragma unroll
                for (int j = 0; j < 4; ++j) { v[j] = xr[64 * j]; s += (v[j][0] * v[j][0] + v[j][1] * v[j][1]) + (v[j][2] * v[j][2] + v[j][3] * v[j][3]); }
                const float rstd = __builtin_amdgcn_rsqf(wave_sum(s) * (1.f / DM) + EPS);
                v2u* o8 = (v2u*)(MEMN + (size_t)row * DM) + lane;
#pragma unroll
                for (int j = 0; j < 4; ++j) { const f32x4 g4 = gr[64 * j]; v2u w; w.x = pk2(v[j][0] * rstd * g4[0], v[j][1] * rstd * g4[1]); w.y = pk2(v[j][2] * rstd * g4[2], v[j][3] * rstd * g4[3]); o8[64 * j] = w; }
            }
            for (int row = gw; row < M; row += 2 * NGW) {
                const int row1 = row + NGW;
                const f32x4* xr0 = (const f32x4*)(ARGIN(I_X) + (size_t)row * DM) + lane; const f32x4* xr1 = (const f32x4*)(ARGIN(I_X) + (size_t)row1 * DM) + lane;
                f32x4 v0[4], v1[4];
#pragma unroll
                for (int j = 0; j < 4; ++j) { v0[j] = xr0[64 * j]; v1[j] = xr1[64 * j]; }
                v2u* o80 = (v2u*)(HB + (size_t)row * DM) + lane; v2u* o81 = (v2u*)(HB + (size_t)row1 * DM) + lane;
                float s0 = 0.f, s1 = 0.f;
#pragma unroll
                for (int j = 0; j < 4; ++j) { s0 += (v0[j][0] * v0[j][0] + v0[j][1] * v0[j][1]) + (v0[j][2] * v0[j][2] + v0[j][3] * v0[j][3]); s1 += (v1[j][0] * v1[j][0] + v1[j][1] * v1[j][1]) + (v1[j][2] * v1[j][2] + v1[j][3] * v1[j][3]);
                    v2u w; w.x = pk2(v0[j][0], v0[j][1]); w.y = pk2(v0[j][2], v0[j][3]); o80[64 * j] = w; w.x = pk2(v1[j][0], v1[j][1]); w.y = pk2(v1[j][2], v1[j][3]); o81[64 * j] = w; }
                s0 = wave_sum(s0); s1 = wave_sum(s1);
                if (lane < 16) { SSQ[(size_t)row * 16 + lane] = (lane == 0) ? s0 : 0.f; SSQ[(size_t)row1 * 16 + lane] = (lane == 0) ? s1 : 0.f; }
            }
            for (int e = bid * 512 + tid; e < 4 * TABN; e += G * 512) {
                const int h = e / TABN, d = e % TABN - 256; float v;
                if (d < 0) v = -INFINITY;
                else { int bk; if (d < 16) bk = d; else { bk = 16 + (int)(__builtin_amdgcn_logf((float)d * 0.0625f) * (16.0f / 3.0f)); bk = bk < 31 ? bk : 31; }
                       v = (ARGIN(I_RELB)[bk * 4 + h] - ARGIN(I_RELB)[31 * 4 + h]) * LOG2E; }
                TAB[e] = v;
            }
            if (bid == 0 && tid < 2) {
                float a = 0.f, b = 0.f;
                for (int d = 0; d < 64; ++d) { a += ARGIN(I_LQ1)[tid * 64 + d] * ARGIN(I_LK1)[tid * 64 + d]; b += ARGIN(I_LQ2)[tid * 64 + d] * ARGIN(I_LK2)[tid * 64 + d]; }
                LAM[tid] = __builtin_amdgcn_exp2f(a * LOG2E) - __builtin_amdgcn_exp2f(b * LOG2E) + (tid == 0 ? LAMBDA_INIT0 : LAMBDA_INIT2);
            }
#endif
        ph0 = 1; if (ph0 < ph_hi) grid.sync();
#undef ARGIN
    }
    (void)xcd_barrier_post((unsigned*)args.ws, (volatile LAS unsigned*)(L + XB_ST_OFF));
    for (int ph = ph0; ph < ph_hi; ++ph) {
        int kind, l; decode_phase(ph, kind, l); const int li = l >> 1;
        int tid_ = threadIdx.x, G_ = gridDim.x, bid_ = blockIdx.x; asm volatile("" : "+v"(tid_), "+s"(G_), "+s"(bid_));
        const int tid = tid_, lane = tid & 63, wid = __builtin_amdgcn_readfirstlane(tid >> 6), G = G_, bid = bid_, gw = bid * NWAVES + wid, NGW = G * NWAVES;
        const __attribute__((address_space(4))) Args* ap = (const __attribute__((address_space(4))) Args*)__builtin_amdgcn_kernarg_segment_ptr();
        asm volatile("" : "+s"(ap));
#define ARGIN(i) (ap->in[i])
        unsigned char* ws = ap->ws;
        float* out = ap->out;
        float* TAB = (float*)(ws + WS_SMALL); float* LAM = (float*)(ws + WS_SMALL + 16384);
        bf16* WIN = (bf16*)(ws + WS_WIN); bf16* WOUT = (bf16*)(ws + WS_WOUT); bf16* CIN = (bf16*)(ws + WS_CIN); bf16* COUT = (bf16*)(ws + WS_COUT);
        bf16* WQ = (bf16*)(ws + WS_WQ); bf16* WK = (bf16*)(ws + WS_WK); bf16* WV = (bf16*)(ws + WS_WV); bf16* WO = (bf16*)(ws + WS_WO); bf16* W1 = (bf16*)(ws + WS_W1); bf16* W2 = (bf16*)(ws + WS_W2);
        bf16* MEMN = (bf16*)(ws + WS_MEMN); bf16* KB = (bf16*)(ws + WS_KB); bf16* VT = (bf16*)(ws + WS_VT); float* SSQ = (float*)(ws + WS_SSQ);
        bf16* HB = (bf16*)(ws + WS_HB); bf16* MIX = (bf16*)(ws + WS_MIX); bf16* BIG = (bf16*)(ws + WS_BIG); bf16* ORAW = (bf16*)(ws + WS_ORAW);
        if (kind == K_MIXPROJ || kind == K_XQ) {
            if (kind == K_MIXPROJ && l == 0) {
                for (int z = 0; z < 2; ++z) {
                    pg8::Gemm g{z == 0 ? MEMN : WV, z == 0 ? WK : MEMN, 4096, 4096, 1024}; pg8::StaticOrder S; S.init(4096, 4096, G, bid);
                    pg8::EpiProj<0, false> E{0x7fffffff, 0, z == 0 ? KB : VT, 4096, nullptr, nullptr, 0};
#ifndef DIS_G0
                    pg8::gemm_phase<pg8::EpiProj<0, false>, pg8::StaticOrder, true, true>(L, g, S, E);
#endif
                }
            }
            const bf16* Bt; int N;
            if (kind == K_XQ) { Bt = WQ + (size_t)l * 1024 * 1024; N = 1024; }
            else if ((l & 1) == 0) { Bt = WIN + (size_t)li * 2048 * 1024; N = 2048; }
            else { Bt = CIN + (size_t)li * 3072 * 1024; N = 3072; }
            pg8::Gemm g{HB, Bt, M, N, 1024}; pg8::StaticOrder S; S.init(M, N, G, bid);
#define PG8_LAS __attribute__((address_space(3)))
            const PG8_LAS float* rsl = nullptr; int pm0 = 0;
            if (G == 256) {
                PG8_LAS float* rw = (PG8_LAS float*)(L + 131072); pg8::Unit u0, uu; S.next(0, u0); pm0 = u0.pm; int last = -1;
                for (int i = 0; S.next(i, uu); ++i) { const int slot = (uu.pm - pm0) >> 3; if (slot != last && slot >= 0 && slot < 8) { if (tid < 256) rw[slot * 256 + tid] = pg8::row_rstd(SSQ, uu.pm * 256 + tid); last = slot; } }
                asm volatile("s_waitcnt vmcnt(0) lgkmcnt(0)" ::: "memory"); __syncthreads(); rsl = rw;
            }
            pg8::EpiProj<0, true> E{N == 3072 ? 4 : 0x7fffffff, 1024, BIG, N == 3072 ? 2048 : N, SSQ, rsl, pm0};
#ifndef DIS_G1
            pg8::gemm_phase<pg8::EpiProj<0, true>, pg8::StaticOrder, true, true>(L, g, S, E);
#endif
            if (kind == K_XQ) {
                asm volatile("s_waitcnt vmcnt(0)" ::: "memory"); __syncthreads();
                pg8::Unit xu;
                for (int i = 0; S.next(i, xu); ++i) { const int tm = xu.pm, h = xu.pn, b = tm >> 4;
#ifndef DIS_XAT
                    xat::unit(L, BIG + (size_t)tm * 256 * 1024 + h * 256, KB + (size_t)b * 256 * 4096 + l * 1024 + h * 256, VT + (size_t)(l * 1024 + h * 256) * 4096 + b * 256, MIX + (size_t)tm * 256 * 1024 + h * 256);
#endif
                }
            }
        }
        else if (kind == K_UP) {
            pg8::Gemm g{HB, W1 + (size_t)l * 4096 * 1024, M, 4096, 1024}; pg8::StaticOrder S; S.init(M, 4096, G, bid);
            const PG8_LAS float* rsl = nullptr; int pm0 = 0;
            if (G == 256) {
                PG8_LAS float* rw = (PG8_LAS float*)(L + 131072); pg8::Unit u0, uu; S.next(0, u0); pm0 = u0.pm; int last = -1;
                for (int i = 0; S.next(i, uu); ++i) { const int slot = (uu.pm - pm0) >> 3; if (slot != last && slot >= 0 && slot < 8) { if (tid < 256) rw[slot * 256 + tid] = pg8::row_rstd(SSQ, uu.pm * 256 + tid); last = slot; } }
                asm volatile("s_waitcnt vmcnt(0) lgkmcnt(0)" ::: "memory"); __syncthreads(); rsl = rw;
            }
            pg8::EpiProj<1, true> E{0x7fffffff, 0, BIG, 4096, SSQ, rsl, pm0};
#ifndef DIS_G2
            pg8::gemm_phase<pg8::EpiProj<1, true>, pg8::StaticOrder, true, true>(L, g, S, E);
#endif
        }
        else if (kind == K_MIXOUT || kind == K_XO || kind == K_DOWN) {
            const bf16* A; const bf16* Bt; int K = 1024;
            if (kind == K_MIXOUT) { A = MIX; Bt = ((l & 1) == 0 ? WOUT : COUT) + (size_t)li * 1024 * 1024; }
            else if (kind == K_XO) { A = MIX; Bt = WO + (size_t)l * 1024 * 1024; }
            else { A = BIG; Bt = W2 + (size_t)l * 1024 * 4096; K = 4096; }
            pg8::Gemm g{A, Bt, M, 1024, K}; pg8::StaticOrder S; S.init(M, 1024, G, bid);
            pg8::EpiResid E{HB, SSQ};
#ifndef DIS_G3
            pg8::gemm_phase<pg8::EpiResid, pg8::StaticOrder, true, true>(L, g, S, E);
#endif
        }
        else if (kind == K_ATTN) {
            const LAS float* tab = (const LAS float*)(L + TAB_OFF); int cur_h = -1;
            for (int item = bid; item < 256; item += G) {
                const int it2 = (item & 7) * 32 + (item >> 3), b = it2 >> 4, h = (it2 >> 2) & 3, sq = it2 & 3;
                if (h != cur_h) { __syncthreads(); { LAS float* tw = (LAS float*)(L + TAB_OFF); const float t0v = TAB[h * TABN + tid]; const float t1v = TAB[h * TABN + (tid < TABN - 512 ? tid + 512 : tid)]; tw[tid] = t0v; if (tid < TABN - 512) tw[tid + 512] = t1v; } cur_h = h; asm volatile("s_waitcnt vmcnt(0) lgkmcnt(0)" ::: "memory"); __syncthreads(); }
                for (int qi = 0; qi < 4; ++qi) {
                    const int qb = qi == 0 ? 15 - sq : qi == 1 ? 8 + sq : qi == 2 ? 7 - sq : sq;
                    for (int vh = 0; vh < 4; ++vh) { const int mp = vh >> 1, j = vh & 1;
#ifndef DIS_ATTN
                        attn_body::attn_unit<8>(b, qb, (const attn_body::bf16*)(BIG + h * 128 + mp * 64), (const attn_body::bf16*)(BIG + 512 + h * 128 + mp * 64), (const attn_body::bf16*)(BIG + 1024 + h * 128 + j * 64),
                                                (attn_body::bf16*)(ORAW + mp * 512 + h * 128 + j * 64), tab, (char*)lds);
#endif
                        asm volatile("s_waitcnt vmcnt(0)" ::: "memory");
                    }
                    __syncthreads();
                    { int lane_ = threadIdx.x & 63; asm volatile("" : "+v"(lane_));
                      const float lam = LAM[li], post = 1.0f - (li == 0 ? LAMBDA_INIT0 : LAMBDA_INIT2);
                      const f32x4* gp = (const f32x4*)(ARGIN(I_SUBLN) + li * 128 + (lane_ & 15) * 8); const f32x4 ga = gp[0], gb = gp[1];
                      const size_t rowbase = (size_t)b * SEQ + (size_t)qb * 256 + wid * 32 + (lane_ >> 4); const int cofs = h * 128 + (lane_ & 15) * 8;
                      v4u aa[8], cc[8];
#pragma unroll
                      for (int it = 0; it < 8; ++it) { const size_t row = rowbase + it * 4; aa[it] = *(const v4u*)(ORAW + row * 1024 + cofs); cc[it] = *(const v4u*)(ORAW + row * 1024 + 512 + cofs); }
#pragma unroll
                      for (int it = 0; it < 8; ++it) { const size_t row = rowbase + it * 4; const v4u a = aa[it], c = cc[it];
                        float v[8] = {bf_lo(a.x) - lam * bf_lo(c.x), bf_hi(a.x) - lam * bf_hi(c.x), bf_lo(a.y) - lam * bf_lo(c.y), bf_hi(a.y) - lam * bf_hi(c.y),
                                      bf_lo(a.z) - lam * bf_lo(c.z), bf_hi(a.z) - lam * bf_hi(c.z), bf_lo(a.w) - lam * bf_lo(c.w), bf_hi(a.w) - lam * bf_hi(c.w)};
                        float sv = 0.f;
#pragma unroll
                        for (int e = 0; e < 8; ++e) sv += v[e] * v[e];
                        sv += __shfl_xor(sv, 1); sv += __shfl_xor(sv, 2); sv += __shfl_xor(sv, 4); sv += __shfl_xor(sv, 8);
                        const float r = __builtin_amdgcn_rsqf(sv * (1.0f / 128.0f) + EPS) * post;
                        v4u o; o.x = pk2(v[0] * r * ga[0], v[1] * r * ga[1]); o.y = pk2(v[2] * r * ga[2], v[3] * r * ga[3]); o.z = pk2(v[4] * r * gb[0], v[5] * r * gb[1]); o.w = pk2(v[6] * r * gb[2], v[7] * r * gb[3]);
                        *(v4u*)(MIX + row * 1024 + cofs) = o; }
                    }
                }
            }
#ifndef DIS_POOL
            { const int w = 2 << (lane >> 4);
              for (int task = gw; task < M / 32; task += NGW) {
                const int row0 = task * 32, t0 = row0 & (SEQ - 1);
                const bf16* up = BIG + (size_t)row0 * 2048 + 1536 + lane * 8; bf16* op = MIX + (size_t)row0 * 1024 + 512 + lane * 8;
                float sum[8];
#pragma unroll
                for (int e = 0; e < 8; ++e) sum[e] = 0.f;
                if (t0 > 0) for (int jj = 1; jj <= w; ++jj) {   const v4u q = *(const v4u*)(up - (size_t)jj * 2048);
                    sum[0] += bf_lo(q.x); sum[1] += bf_hi(q.x); sum[2] += bf_lo(q.y); sum[3] += bf_hi(q.y); sum[4] += bf_lo(q.z); sum[5] += bf_hi(q.z); sum[6] += bf_lo(q.w); sum[7] += bf_hi(q.w); }
                for (int i0 = 0; i0 < 32; i0 += 4) {
                    v4u qq[4], oo[4];
#pragma unroll
                    for (int k = 0; k < 4; ++k) { qq[k] = *(const v4u*)(up + (size_t)(i0 + k) * 2048); oo[k] = *(const v4u*)(up + ((long)(i0 + k) - w) * 2048); }
#pragma unroll
                    for (int k = 0; k < 4; ++k) { const int i = i0 + k; const v4u q = qq[k], o = oo[k];
                    float cur[8] = {bf_lo(q.x), bf_hi(q.x), bf_lo(q.y), bf_hi(q.y), bf_lo(q.z), bf_hi(q.z), bf_lo(q.w), bf_hi(q.w)};
#pragma unroll
                    for (int e = 0; e < 8; ++e) sum[e] += cur[e];
                    const int t = t0 + i;
                    if (t - w >= 0) {
                        sum[0] -= bf_lo(o.x); sum[1] -= bf_hi(o.x); sum[2] -= bf_lo(o.y); sum[3] -= bf_hi(o.y); sum[4] -= bf_lo(o.z); sum[5] -= bf_hi(o.z); sum[6] -= bf_lo(o.w); sum[7] -= bf_hi(o.w); }
                    const float rc = 1.0f / (float)((t + 1) < w ? (t + 1) : w);
                    v4u r; r.x = pk2(sum[0] * rc - cur[0], sum[1] * rc - cur[1]); r.y = pk2(sum[2] * rc - cur[2], sum[3] * rc - cur[3]); r.z = pk2(sum[4] * rc - cur[4], sum[5] * rc - cur[5]); r.w = pk2(sum[6] * rc - cur[6], sum[7] * rc - cur[7]);
                    *(v4u*)(op + (size_t)i * 1024) = r; }
                }
              } }
#endif
        }
        else if (kind == K_CONV) {
#ifndef DIS_CONV
            for (int task = gw; task < (M / 32) * 2; task += NGW) {
                const int row0 = (task >> 1) * 32, t0 = row0 & (SEQ - 1), ch = (task & 1) * 512 + lane * 8;
                const float* cw = ARGIN(I_CW) + (size_t)li * 3 * 1024 + ch;
                float w0[8], w1[8], w2[8];
#pragma unroll
                for (int e = 0; e < 8; ++e) { w0[e] = cw[e]; w1[e] = cw[1024 + e]; w2[e] = cw[2048 + e]; }
                const bf16* pp = BIG + (size_t)row0 * 2048 + ch; bf16* op = MIX + (size_t)row0 * 1024 + ch;
                float z1[8], z2[8];
#pragma unroll
                for (int e = 0; e < 8; ++e) { z1[e] = 0.f; z2[e] = 0.f; }
                if (t0 > 0) {
                    const v4u q1 = *(const v4u*)(pp - 2048 + 1024), q2 = *(const v4u*)(pp - 2 * 2048 + 1024);
                    z1[0] = bf_lo(q1.x); z1[1] = bf_hi(q1.x); z1[2] = bf_lo(q1.y); z1[3] = bf_hi(q1.y); z1[4] = bf_lo(q1.z); z1[5] = bf_hi(q1.z); z1[6] = bf_lo(q1.w); z1[7] = bf_hi(q1.w);
                    z2[0] = bf_lo(q2.x); z2[1] = bf_hi(q2.x); z2[2] = bf_lo(q2.y); z2[3] = bf_hi(q2.y); z2[4] = bf_lo(q2.z); z2[5] = bf_hi(q2.z); z2[6] = bf_lo(q2.w); z2[7] = bf_hi(q2.w);
                }
                for (int i0 = 0; i0 < 32; i0 += 8) {
                    v4u bqq[8], zqq[8];
#pragma unroll
                    for (int k = 0; k < 8; ++k) { bqq[k] = __builtin_nontemporal_load((const v4u*)(pp + (size_t)(i0 + k) * 2048)); zqq[k] = __builtin_nontemporal_load((const v4u*)(pp + (size_t)(i0 + k) * 2048 + 1024)); }
#pragma unroll
                    for (int k = 0; k < 8; ++k) { const int i = i0 + k; const v4u bq = bqq[k], zq = zqq[k];
                    const float bb[8] = {bf_lo(bq.x), bf_hi(bq.x), bf_lo(bq.y), bf_hi(bq.y), bf_lo(bq.z), bf_hi(bq.z), bf_lo(bq.w), bf_hi(bq.w)};
                    const float z[8] = {bf_lo(zq.x), bf_hi(zq.x), bf_lo(zq.y), bf_hi(zq.y), bf_lo(zq.z), bf_hi(zq.z), bf_lo(zq.w), bf_hi(zq.w)};
                    float y[8];
#pragma unroll
                    for (int e = 0; e < 8; ++e) { y[e] = bb[e] * (z2[e] * w0[e] + z1[e] * w1[e] + z[e] * w2[e]); z2[e] = z1[e]; z1[e] = z[e]; }
                    v4u r; r.x = pk2(y[0], y[1]); r.y = pk2(y[2], y[3]); r.z = pk2(y[4], y[5]); r.w = pk2(y[6], y[7]);
                    *(v4u*)(op + (size_t)i * 1024) = r; }
                }
            }
#endif
        }
        else {
            const f32x4* gr = (const f32x4*)(ARGIN(I_FING) + lane * 8);
            const f32x4 g0 = gr[0], g1 = gr[1], g2 = gr[128], g3 = gr[129];
            for (int row0 = gw; row0 < M; row0 += 2 * NGW) {
                v4u h0[2], h1[2];
#pragma unroll
                for (int k = 0; k < 2; ++k) { const bf16* hp = HB + (size_t)(row0 + k * NGW) * DM + lane * 8; h0[k] = *(const v4u*)(hp); h1[k] = *(const v4u*)(hp + 512); }
#pragma unroll
                for (int k = 0; k < 2; ++k) { float* op = out + (size_t)(row0 + k * NGW) * DM + lane * 8;
                    const f32x4 a0 = {bf_lo(h0[k].x), bf_hi(h0[k].x), bf_lo(h0[k].y), bf_hi(h0[k].y)}, a1 = {bf_lo(h0[k].z), bf_hi(h0[k].z), bf_lo(h0[k].w), bf_hi(h0[k].w)};
                    const f32x4 a2 = {bf_lo(h1[k].x), bf_hi(h1[k].x), bf_lo(h1[k].y), bf_hi(h1[k].y)}, a3 = {bf_lo(h1[k].z), bf_hi(h1[k].z), bf_lo(h1[k].w), bf_hi(h1[k].w)};
                    float sq = ((a0[0] * a0[0] + a0[1] * a0[1]) + (a0[2] * a0[2] + a0[3] * a0[3])) + ((a1[0] * a1[0] + a1[1] * a1[1]) + (a1[2] * a1[2] + a1[3] * a1[3]))
                             + ((a2[0] * a2[0] + a2[1] * a2[1]) + (a2[2] * a2[2] + a2[3] * a2[3])) + ((a3[0] * a3[0] + a3[1] * a3[1]) + (a3[2] * a3[2] + a3[3] * a3[3]));
                    const float r = __builtin_amdgcn_rsqf(wave_sum(sq) * (1.f / DM) + EPS);
                    *(f32x4*)(op) = a0 * r * g0; *(f32x4*)(op + 4) = a1 * r * g1; *(f32x4*)(op + 512) = a2 * r * g2; *(f32x4*)(op + 516) = a3 * r * g3; }
            }
        }
        if (ph + 1 < ph_hi) { XcdBarrier xb_; xb_.bar = (unsigned*)ws; xb_.x = xb_xcc_id(); xb_.st = (volatile LAS unsigned*)(L + XB_ST_OFF); xcd_barrier(xb_); }
    }
}


#ifndef N_LAUNCH_MODE
#define N_LAUNCH_MODE 1
#endif
extern "C" void kernel_launch(void* const* d_in, const int* in_sizes, int n_in, void* d_out, int out_size, void* d_ws, size_t ws_size, hipStream_t stream) {
    static int grid = 0;
    if (grid == 0) {
        if (n_in != 25 || in_sizes[0] != M * DM || out_size != M * DM || ws_size < WS_END) { fprintf(stderr, "kernel_launch: unexpected shapes (n_in %d, in0 %d, out %d, ws %zu); nothing launched\n", n_in, n_in > 0 ? in_sizes[0] : -1, out_size, ws_size); grid = -1; return; }
        int dev = 0, cus = 0, per_cu = 0;
        hipGetDevice(&dev); hipDeviceGetAttribute(&cus, hipDeviceAttributeMultiprocessorCount, dev);
        if (hipFuncSetAttribute((const void*)trunk_fwd, hipFuncAttributeMaxDynamicSharedMemorySize, LDS_BYTES) != hipSuccess) { fprintf(stderr, "kernel_launch: hipFuncSetAttribute failed\n"); grid = -1; return; }
        if (hipOccupancyMaxActiveBlocksPerMultiprocessor(&per_cu, (const void*)trunk_fwd, NWAVES * 64, LDS_BYTES) != hipSuccess || per_cu < 1) { fprintf(stderr, "kernel_launch: occupancy query gave %d\n", per_cu); per_cu = 1; }
        (void)hipGetLastError();
        grid = cus;
    }
    if (grid < 0) return;
    Args a{};
    for (int i = 0; i < 25; ++i) a.in[i] = (const float*)d_in[i];
    a.out = (float*)d_out; a.ws = (unsigned char*)d_ws;
#if N_LAUNCH_MODE == 1
    a.lo = 0; a.hi = NPHASE;
    { void* kargs[] = {&a}; hipError_t e = hipLaunchCooperativeKernel((const void*)trunk_fwd, dim3(grid), dim3(NWAVES * 64), kargs, LDS_BYTES, stream);
      if (e != hipSuccess) fprintf(stderr, "cooperative launch failed: %s (grid %d)\n", hipGetErrorString(e), grid); }
#elif N_LAUNCH_MODE == 0
    for (int p = 0; p < NPHASE; ++p) { a.lo = p; a.hi = p + 1; void* kargs[] = {&a};
        hipError_t e = hipLaunchCooperativeKernel((const void*)trunk_fwd, dim3(grid), dim3(NWAVES * 64), kargs, LDS_BYTES, stream);
        if (e != hipSuccess) { fprintf(stderr, "launch %d failed: %s (grid %d)\n", p, hipGetErrorString(e), grid); break; } }
#endif
}
```
